# Optimizing an MI355X kernel written in HIP

```python
import jax, jax.numpy as jnp
from jax import lax
import numpy as np

D_MODEL = 1024
BATCH = 8
SEQ = 2048
DEPTH = 2
DEC_BATCH = 32
DEC_SEQ = 1
PAST_LEN = 16384
PAGE_SIZE = 128

D_INNER = D_MODEL
SSM_HEAD_DIM = 64
SSM_HEADS = D_INNER // SSM_HEAD_DIM
SSM_GROUPS = 2
SSM_HPG = SSM_HEADS // SSM_GROUPS
D_STATE = 128
CONV_WIDTH = 4
CONV_DIM = D_INNER + 2 * SSM_GROUPS * D_STATE
SSD_CHUNK = 128
MLA_HEADS = 8
QK_NOPE = 64
QK_ROPE = 32
V_HEAD = 64
Q_LORA = 384
KV_LORA = 256
ROPE_THETA = 10000.0
Q_BLOCK = 128
ATTN_SCALE = (QK_NOPE + QK_ROPE) ** -0.5
PEER_HEADS = 8
N_KEYS = 128
N_EXPERTS = N_KEYS * N_KEYS
PEER_D_KEY = 256
PEER_TOPK = 16
PEER_BLOCK = 128
EPS = 1e-6

_SIZES = (D_MODEL, D_MODEL, D_INNER, CONV_DIM, SSM_HEADS, Q_LORA, KV_LORA, QK_ROPE)
IN_DIM = sum(_SIZES)
SPLIT_POINTS = tuple(int(s) for s in np.cumsum(_SIZES)[:-1])

kernel_name = "hybrid_ssd_mla_peer_step"


def rmsnorm(x, w):
    xf = x.astype(jnp.float32)
    xf = xf * lax.rsqrt(jnp.mean(xf * xf, axis=-1, keepdims=True) + EPS)
    return (xf * w.astype(jnp.float32)).astype(x.dtype)


def rope(x, pos):
    half = x.shape[-1] // 2
    inv = ROPE_THETA ** (-jnp.arange(half, dtype=jnp.float32) / half)
    ang = pos.astype(jnp.float32)[:, None] * inv[None, :]
    shape = (1, ang.shape[0]) + (1,) * (x.ndim - 3) + (half,)
    cos = jnp.cos(ang).reshape(shape)
    sin = jnp.sin(ang).reshape(shape)
    xf = x.astype(jnp.float32)
    x1, x2 = xf[..., :half], xf[..., half:]
    return jnp.concatenate([x1 * cos - x2 * sin, x1 * sin + x2 * cos], axis=-1).astype(x.dtype)


def causal_conv(xbc, prev, w, b):
    L = xbc.shape[1]
    xpad = jnp.concatenate([prev.astype(xbc.dtype), xbc], axis=1)
    out = b
    for k in range(CONV_WIDTH):
        out = out + xpad[:, k:k + L] * w[k]
    return jax.nn.silu(out), xpad[:, L:]


def ssd_scan(xh, dt, A, Bm, Cm, h0):
    b, L = xh.shape[:2]
    cl = SSD_CHUNK if L % SSD_CHUNK == 0 else L
    nc = L // cl
    f32 = jnp.float32
    x_c = xh.astype(f32).reshape((b, nc, cl) + xh.shape[2:])
    dt_c = dt.astype(f32).reshape((b, nc, cl) + dt.shape[2:])
    B_c = Bm.astype(f32).reshape((b, nc, cl) + Bm.shape[2:])
    C_c = Cm.astype(f32).reshape((b, nc, cl) + Cm.shape[2:])
    a_cs = jnp.cumsum(dt_c * A.astype(f32), axis=2)
    seg = a_cs[:, :, :, None] - a_cs[:, :, None, :]
    causal = (jnp.arange(cl)[:, None] >= jnp.arange(cl)[None, :])[None, None, :, :, None, None]
    Lmat = jnp.exp(jnp.where(causal, seg, -jnp.inf))
    xdt = x_c * dt_c[..., None]
    CB = jnp.einsum('bclgn,bcsgn->bclsg', C_c, B_c)
    y_diag = jnp.einsum('bclsg,bclsge,bcsgep->bclgep', CB, Lmat, xdt)
    decay_to_end = jnp.exp(a_cs[:, :, -1:] - a_cs)
    chunk_states = jnp.einsum('bclgn,bclge,bclgep->bcgepn', B_c, decay_to_end, xdt)
    chunk_decay = jnp.exp(a_cs[:, :, -1])

    def step(h, inp):
        dec, st = inp
        return dec[..., None, None] * h + st, h

    h_final, h_prev = lax.scan(step, h0.astype(f32),
                               (jnp.moveaxis(chunk_decay, 1, 0), jnp.moveaxis(chunk_states, 1, 0)))
    h_prev = jnp.moveaxis(h_prev, 0, 1)
    y_off = jnp.einsum('bclgn,bcgepn,bclge->bclgep', C_c, h_prev, jnp.exp(a_cs))
    y = (y_diag + y_off).reshape(xh.shape)
    return y.astype(xh.dtype), h_final.astype(h0.dtype)


def ssd_branch(z, xbc_raw, dt_raw, h0, conv_prev, conv_w, conv_b, dt_bias, a_log, d_skip, ssm_norm, w_ssm_proj):
    b, L = z.shape[:2]
    xbc, conv_new = causal_conv(xbc_raw, conv_prev, conv_w, conv_b)
    xs = xbc[..., :D_INNER]
    Bm = xbc[..., D_INNER:D_INNER + SSM_GROUPS * D_STATE].reshape(b, L, SSM_GROUPS, D_STATE)
    Cm = xbc[..., D_INNER + SSM_GROUPS * D_STATE:].reshape(b, L, SSM_GROUPS, D_STATE)
    xh = xs.reshape(b, L, SSM_GROUPS, SSM_HPG, SSM_HEAD_DIM)
    dt = jax.nn.softplus(dt_raw + dt_bias).reshape(b, L, SSM_GROUPS, SSM_HPG)
    A = -jnp.exp(a_log).reshape(SSM_GROUPS, SSM_HPG)
    y, h_new = ssd_scan(xh, dt, A, Bm, Cm, h0)
    y = y + d_skip.reshape(SSM_GROUPS, SSM_HPG)[..., None] * xh
    y = y.reshape(b, L, D_INNER) * jax.nn.silu(z)
    y = rmsnorm(y.reshape(b, L, SSM_GROUPS, D_INNER // SSM_GROUPS),
                ssm_norm.reshape(SSM_GROUPS, D_INNER // SSM_GROUPS)).reshape(b, L, D_INNER)
    return y @ w_ssm_proj, h_new, conv_new


def mla_attention(q_lat, q_pe, kv, kr, q_pos, k_pos):
    b, L = q_lat.shape[:2]
    blk = Q_BLOCK if L % Q_BLOCK == 0 else L
    nb = L // blk

    def to_blocks(a):
        return jnp.moveaxis(a.reshape((b, nb, blk) + a.shape[2:]), 1, 0)

    def one(args):
        ql, qp, qpos = args
        s = (jnp.einsum('bqhr,btr->bhqt', ql, kv) + jnp.einsum('bqhd,btd->bhqt', qp, kr)).astype(jnp.float32) * ATTN_SCALE
        mask = k_pos[None, :] <= qpos[:, None]
        p = jax.nn.softmax(jnp.where(mask, s, -jnp.inf), axis=-1).astype(kv.dtype)
        return jnp.einsum('bhqt,btr->bqhr', p, kv)

    o = lax.map(one, (to_blocks(q_lat), to_blocks(q_pe), q_pos.reshape(nb, blk)))
    return jnp.moveaxis(o, 0, 1).reshape(b, L, MLA_HEADS, KV_LORA)


def mla_branch(c_q, c_kv, kr_raw, pos, past_lat, past_kr, q_norm, w_qb, kv_norm, w_kvb, w_mla_proj):
    b, L = c_q.shape[:2]
    q = (rmsnorm(c_q, q_norm) @ w_qb).reshape(b, L, MLA_HEADS, QK_NOPE + QK_ROPE)
    q_nope = q[..., :QK_NOPE]
    q_pe = rope(q[..., QK_NOPE:], pos)
    lat = rmsnorm(c_kv, kv_norm)
    kpe = rope(kr_raw[:, :, None, :], pos)[:, :, 0]
    wkv = w_kvb.reshape(KV_LORA, MLA_HEADS, QK_NOPE + V_HEAD)
    w_kb, w_vb = wkv[..., :QK_NOPE], wkv[..., QK_NOPE:]
    q_lat = jnp.einsum('blhd,rhd->blhr', q_nope, w_kb)
    if past_lat is None:
        kv_all, kr_all, k_pos = lat, kpe, pos
    else:
        kv_all = jnp.concatenate([past_lat.astype(lat.dtype), lat], axis=1)
        kr_all = jnp.concatenate([past_kr.astype(kpe.dtype), kpe], axis=1)
        k_pos = jnp.arange(past_lat.shape[1] + L, dtype=jnp.int32)
    o_lat = mla_attention(q_lat, q_pe, kv_all, kr_all, pos, k_pos)
    o = jnp.einsum('blhr,rhv->blhv', o_lat, w_vb).reshape(b, L, MLA_HEADS * V_HEAD)
    return o @ w_mla_proj, lat, kpe


def peer(h, wq, keys, u, v):
    b, L, D = h.shape
    n = b * L
    blk = PEER_BLOCK if n % PEER_BLOCK == 0 else n
    half = PEER_D_KEY // 2

    def one(tb):
        q = (tb @ wq).reshape(blk, PEER_HEADS, PEER_D_KEY)
        s1 = jnp.einsum('thd,hkd->thk', q[..., :half], keys[:, 0])
        s2 = jnp.einsum('thd,hkd->thk', q[..., half:], keys[:, 1])
        sc1, i1 = lax.top_k(s1, PEER_TOPK)
        sc2, i2 = lax.top_k(s2, PEER_TOPK)
        cand = (sc1[..., :, None] + sc2[..., None, :]).reshape(blk, PEER_HEADS, PEER_TOPK * PEER_TOPK)
        cidx = (i1[..., :, None] * N_KEYS + i2[..., None, :]).reshape(blk, PEER_HEADS, PEER_TOPK * PEER_TOPK)
        sc, sel = lax.top_k(cand, PEER_TOPK)
        idx = jnp.take_along_axis(cidx, sel, axis=-1)
        g = jax.nn.softmax(sc.astype(jnp.float32), axis=-1)
        act = jax.nn.gelu(jnp.einsum('thkd,td->thk', u[idx], tb), approximate=False)
        wgt = (g * act.astype(jnp.float32)).astype(tb.dtype)
        return jnp.einsum('thk,thkd->td', wgt, v[idx])

    out = lax.map(one, h.reshape(n // blk, blk, D))
    return out.reshape(b, L, D)


def trunk_layer(x, pos, h0, conv_prev, past_lat, past_kr, p):
    (norm_mix, w_in, b_gate, conv_w, conv_b, dt_bias, a_log, d_skip, ssm_norm, w_ssm_proj,
     q_norm, w_qb, kv_norm, w_kvb, w_mla_proj, w_out, norm_ffn, peer_wq, peer_keys, peer_u, peer_v) = p
    h = rmsnorm(x, norm_mix)
    proj = h @ w_in
    gate_a, gate_b, z, xbc, dt_raw, c_q, c_kv, kr_raw = jnp.split(proj, SPLIT_POINTS, axis=-1)
    ya, h_new, conv_new = ssd_branch(z, xbc, dt_raw, h0, conv_prev, conv_w, conv_b, dt_bias, a_log,
                                     d_skip, ssm_norm, w_ssm_proj)
    yb, lat_new, kr_new = mla_branch(c_q, c_kv, kr_raw, pos, past_lat, past_kr, q_norm, w_qb, kv_norm,
                                     w_kvb, w_mla_proj)
    ga = jax.nn.sigmoid(gate_a + b_gate[:D_MODEL])
    gb = jax.nn.sigmoid(gate_b + b_gate[D_MODEL:])
    x = x + (ga * ya + gb * yb) @ w_out
    x = x + peer(rmsnorm(x, norm_ffn), peer_wq, peer_keys, peer_u, peer_v)
    return x, h_new, conv_new, lat_new, kr_new


def setup_inputs(seed: int = 0) -> dict:
    key = jax.random.key(seed)
    ks = jax.random.split(key, 40)
    f32 = jnp.float32
    n_pages = PAST_LEN // PAGE_SIZE
    n_used = DEC_BATCH * n_pages
    n_pool = n_used + max(1, n_used // 4)
    nrm = lambda k, s, sc: jax.random.normal(k, s, f32) * sc
    gain = lambda k, s: 1.0 + 0.02 * jax.random.normal(k, s, f32)
    dt0 = jnp.exp(jax.random.uniform(ks[10], (DEPTH, SSM_HEADS), f32, np.log(1e-3), np.log(1e-1)))
    return {
        "x_prompt": nrm(ks[0], (BATCH, SEQ, D_MODEL), 1.0),
        "x_sample": nrm(ks[1], (DEC_BATCH, DEC_SEQ, D_MODEL), 1.0),
        "cache_latent": nrm(ks[2], (DEPTH, n_pool, PAGE_SIZE, KV_LORA), 1.0),
        "cache_krope": nrm(ks[3], (DEPTH, n_pool, PAGE_SIZE, QK_ROPE), 1.0),
        "state_ssm": nrm(ks[4], (DEPTH, DEC_BATCH, SSM_GROUPS, SSM_HPG, SSM_HEAD_DIM, D_STATE), 0.1),
        "state_conv": nrm(ks[5], (DEPTH, DEC_BATCH, CONV_WIDTH - 1, CONV_DIM), 1.0),
        "page_table": jax.random.permutation(ks[6], n_pool)[:n_used].reshape(DEC_BATCH, n_pages).astype(jnp.int32),
        "norm_mix": gain(ks[7], (DEPTH, D_MODEL)),
        "w_in": nrm(ks[8], (DEPTH, D_MODEL, IN_DIM), D_MODEL ** -0.5),
        "b_gate": nrm(ks[9], (DEPTH, 2 * D_MODEL), 0.02),
        "conv_w": nrm(ks[11], (DEPTH, CONV_WIDTH, CONV_DIM), CONV_WIDTH ** -0.5),
        "conv_b": nrm(ks[12], (DEPTH, CONV_DIM), 0.02),
        "dt_bias": dt0 + jnp.log(-jnp.expm1(-dt0)),
        "a_log": jnp.log(jax.random.uniform(ks[13], (DEPTH, SSM_HEADS), f32, 1.0, 16.0)),
        "d_skip": gain(ks[14], (DEPTH, SSM_HEADS)),
        "ssm_norm": gain(ks[15], (DEPTH, D_INNER)),
        "w_ssm_proj": nrm(ks[16], (DEPTH, D_INNER, D_MODEL), D_INNER ** -0.5),
        "q_norm": gain(ks[17], (DEPTH, Q_LORA)),
        "w_qb": nrm(ks[18], (DEPTH, Q_LORA, MLA_HEADS * (QK_NOPE + QK_ROPE)), Q_LORA ** -0.5),
        "kv_norm": gain(ks[19], (DEPTH, KV_LORA)),
        "w_kvb": nrm(ks[20], (DEPTH, KV_LORA, MLA_HEADS * (QK_NOPE + V_HEAD)), KV_LORA ** -0.5),
        "w_mla_proj": nrm(ks[21], (DEPTH, MLA_HEADS * V_HEAD, D_MODEL), (MLA_HEADS * V_HEAD) ** -0.5),
        "w_out": nrm(ks[22], (DEPTH, D_MODEL, D_MODEL), D_MODEL ** -0.5),
        "norm_ffn": gain(ks[23], (DEPTH, D_MODEL)),
        "peer_wq": nrm(ks[24], (DEPTH, D_MODEL, PEER_HEADS * PEER_D_KEY), D_MODEL ** -0.5),
        "peer_keys": nrm(ks[25], (DEPTH, PEER_HEADS, 2, N_KEYS, PEER_D_KEY // 2), (PEER_D_KEY // 2) ** -0.5),
        "peer_u": nrm(ks[26], (DEPTH, N_EXPERTS, D_MODEL), D_MODEL ** -0.5),
        "peer_v": nrm(ks[27], (DEPTH, N_EXPERTS, D_MODEL), 0.1),
        "norm_final": gain(ks[28], (D_MODEL,)),
    }


def reference(x_prompt, x_sample, cache_latent, cache_krope, state_ssm, state_conv, page_table,
              norm_mix, w_in, b_gate, conv_w, conv_b, dt_bias, a_log, d_skip, ssm_norm, w_ssm_proj,
              q_norm, w_qb, kv_norm, w_kvb, w_mla_proj, w_out, norm_ffn, peer_wq, peer_keys,
              peer_u, peer_v, norm_final):
    bp, sp = x_prompt.shape[:2]
    bs, ss = x_sample.shape[:2]
    past_len = page_table.shape[1] * cache_latent.shape[2]
    pos_p = jnp.arange(sp, dtype=jnp.int32)
    pos_s = past_len + jnp.arange(ss, dtype=jnp.int32)
    h0_p = jnp.zeros((bp, SSM_GROUPS, SSM_HPG, SSM_HEAD_DIM, D_STATE), x_prompt.dtype)
    conv0_p = jnp.zeros((bp, CONV_WIDTH - 1, CONV_DIM), x_prompt.dtype)
    xp, xs = x_prompt, x_sample
    lat_p, kr_p, ssm_p, conv_p = [], [], [], []
    lat_s, kr_s, ssm_s, conv_s = [], [], [], []
    for l in range(DEPTH):
        p = (norm_mix[l], w_in[l], b_gate[l], conv_w[l], conv_b[l], dt_bias[l], a_log[l], d_skip[l],
             ssm_norm[l], w_ssm_proj[l], q_norm[l], w_qb[l], kv_norm[l], w_kvb[l], w_mla_proj[l],
             w_out[l], norm_ffn[l], peer_wq[l], peer_keys[l], peer_u[l], peer_v[l])
        past_lat = cache_latent[l][page_table].reshape(bs, past_len, KV_LORA)
        past_kr = cache_krope[l][page_table].reshape(bs, past_len, QK_ROPE)
        xp, hp, cp, lp, kp = trunk_layer(xp, pos_p, h0_p, conv0_p, None, None, p)
        xs, hs, cs, lsn, ksn = trunk_layer(xs, pos_s, state_ssm[l], state_conv[l], past_lat, past_kr, p)
        lat_p.append(lp); kr_p.append(kp); ssm_p.append(hp); conv_p.append(cp)
        lat_s.append(lsn); kr_s.append(ksn); ssm_s.append(hs); conv_s.append(cs)
    y_prompt = rmsnorm(xp, norm_final)
    y_sample = rmsnorm(xs, norm_final)
    return (y_prompt, y_sample,
            jnp.stack(lat_p), jnp.stack(kr_p), jnp.stack(ssm_p), jnp.stack(conv_p),
            jnp.stack(lat_s), jnp.stack(kr_s), jnp.stack(ssm_s), jnp.stack(conv_s))
```

```cpp
#include <hip/hip_runtime.h>
#include <stdint.h>

#define DM 1024
#define NB 8
#define SEQ 2048
#define NPT (NB * SEQ)
#define NS 32
#define NT (NPT + NS)
#define TP 16512
#define DEPTH 2
#define PAST 16384
#define PAGE 128
#define NPAGES 128
#define NPOOL 5120
#define DIN 5296
#define OFF_GA 0
#define OFF_GB 1024
#define OFF_Z 2048
#define OFF_XBC 3072
#define OFF_DT 4608
#define OFF_CQ 4624
#define OFF_CKV 5008
#define OFF_KR 5264
#define CONVD 1536
#define QL 384
#define KVL 256
#define NEXP 16384
#define EPSF 1e-6f
#define ATT_SCALE 0.10206207261596577f

#define O_YP 0
#define O_YS (O_YP + NPT * DM)
#define O_LATP (O_YS + NS * DM)
#define O_KRP (O_LATP + DEPTH * NPT * KVL)
#define O_SSMP (O_KRP + DEPTH * NPT * 32)
#define O_CONVP (O_SSMP + DEPTH * NB * 16 * 64 * 128)
#define O_LATS (O_CONVP + DEPTH * NB * 3 * CONVD)
#define O_KRS (O_LATS + DEPTH * NS * KVL)
#define O_SSMS (O_KRS + DEPTH * NS * 32)
#define O_CONVS (O_SSMS + DEPTH * NS * 16 * 64 * 128)

struct P {
    const float *x_prompt, *x_sample, *cache_lat, *cache_kr, *state_ssm, *state_conv;
    const int* page_table;
    const float *norm_mix, *w_in, *b_gate, *conv_w, *conv_b, *dt_bias, *a_log, *d_skip, *ssm_norm, *w_ssm_proj;
    const float *q_norm, *w_qb, *kv_norm, *w_kvb, *w_mla_proj, *w_out, *norm_ffn, *peer_wq, *peer_keys, *peer_u, *peer_v, *norm_final;
    float* out;
    float *xres, *h, *proj, *xbc, *dt, *yraw, *yn, *ya, *qn, *q, *lat, *kpe, *kv, *o, *yb, *mix, *pq, *sc, *gate, *part, *qlat, *rope;
    int* idx;
};

__device__ __forceinline__ float wave_sum(float v) {
#pragma unroll
    for (int o = 32; o > 0; o >>= 1) v += __shfl_xor(v, o);
    return v;
}
__device__ __forceinline__ float wave_max(float v) {
#pragma unroll
    for (int o = 32; o > 0; o >>= 1) v = fmaxf(v, __shfl_xor(v, o));
    return v;
}
__device__ __forceinline__ float silu_f(float x) { return x / (1.f + expf(-x)); }
__device__ __forceinline__ float sigmoid_f(float x) { return 1.f / (1.f + expf(-x)); }

__global__ void k_rope_table(float* rope) {
    int i = blockIdx.x * blockDim.x + threadIdx.x;
    if (i >= 2049 * 16) return;
    int p = i / 16, j = i % 16;
    float pos = (p == 2048) ? 16384.f : (float)p;
    float inv = powf(10000.f, -(float)j / 16.f);
    float ang = pos * inv;
    rope[i] = (float)cos((double)ang);
    rope[2049 * 16 + i] = (float)sin((double)ang);
}

__global__ void k_copy_x(P p) {
    size_t i = (size_t)blockIdx.x * blockDim.x + threadIdx.x;
    size_t n = (size_t)TP * DM;
    for (; i < n; i += (size_t)gridDim.x * blockDim.x) {
        size_t t = i / DM;
        float v = 0.f;
        if (t < NPT) v = p.x_prompt[i];
        else if (t < NT) v = p.x_sample[i - (size_t)NPT * DM];
        p.xres[i] = v;
    }
}

__global__ void k_rmsnorm(const float* in, int ldi, const float* w, float* out, int ldo, int D, int rows) {
    int row = blockIdx.x * 4 + (threadIdx.x >> 6);
    int lane = threadIdx.x & 63;
    if (row >= rows) return;
    const float* x = in + (size_t)row * ldi;
    float s = 0.f;
    for (int c = lane; c < D; c += 64) { float v = x[c]; s += v * v; }
    s = wave_sum(s);
    float r = rsqrtf(s / (float)D + EPSF);
    for (int c = lane; c < D; c += 64) out[(size_t)row * ldo + c] = x[c] * r * w[c];
}

__global__ void __launch_bounds__(256) k_gemm_f32(const float* A, int lda, const float* B, int ldb, float* C, int ldc,
                                                   int M, int N, int K, int accumulate) {
    __shared__ float sA[16][64 + 4];
    __shared__ float sB[16][64 + 4];
    int tx = threadIdx.x & 15, ty = threadIdx.x >> 4;
    int m0 = blockIdx.y * 64, n0 = blockIdx.x * 64;
    float acc[4][4];
#pragma unroll
    for (int i = 0; i < 4; ++i)
#pragma unroll
        for (int j = 0; j < 4; ++j) acc[i][j] = 0.f;
    for (int k0 = 0; k0 < K; k0 += 16) {
        {
            int r = threadIdx.x >> 2, kk = (threadIdx.x & 3) * 4;
            const float* ap = A + (size_t)(m0 + r) * lda + k0 + kk;
            float4 v = *(const float4*)ap;
            sA[kk + 0][r] = v.x; sA[kk + 1][r] = v.y; sA[kk + 2][r] = v.z; sA[kk + 3][r] = v.w;
        }
        {
            int kk = threadIdx.x >> 4, c = (threadIdx.x & 15) * 4;
#pragma unroll
            for (int j = 0; j < 4; ++j) {
                int n = n0 + c + j;
                sB[kk][c + j] = (n < N) ? B[(size_t)(k0 + kk) * ldb + n] : 0.f;
            }
        }
        __syncthreads();
#pragma unroll
        for (int kk = 0; kk < 16; ++kk) {
            float a[4], b[4];
#pragma unroll
            for (int i = 0; i < 4; ++i) a[i] = sA[kk][ty * 4 + i];
#pragma unroll
            for (int j = 0; j < 4; ++j) b[j] = sB[kk][tx * 4 + j];
#pragma unroll
            for (int i = 0; i < 4; ++i)
#pragma unroll
                for (int j = 0; j < 4; ++j) acc[i][j] += a[i] * b[j];
        }
        __syncthreads();
    }
#pragma unroll
    for (int i = 0; i < 4; ++i) {
        int m = m0 + ty * 4 + i;
#pragma unroll
        for (int j = 0; j < 4; ++j) {
            int n = n0 + tx * 4 + j;
            if (n < N) {
                float* cp = C + (size_t)m * ldc + n;
                *cp = accumulate ? (*cp + acc[i][j]) : acc[i][j];
            }
        }
    }
}

__global__ void k_conv(P p, int layer) {
    size_t i = (size_t)blockIdx.x * blockDim.x + threadIdx.x;
    if (i >= (size_t)NT * CONVD) return;
    int t = (int)(i / CONVD), c = (int)(i % CONVD);
    const float* cw = p.conv_w + (size_t)layer * 4 * CONVD;
    float acc = p.conv_b[layer * CONVD + c];
    float raw = p.proj[(size_t)t * DIN + OFF_XBC + c];
    if (t < NPT) {
        int b = t / SEQ, l = t % SEQ;
#pragma unroll
        for (int k = 0; k < 4; ++k) {
            int ls = l + k - 3;
            if (ls >= 0) acc += p.proj[(size_t)(t + k - 3) * DIN + OFF_XBC + c] * cw[k * CONVD + c];
        }
        if (l >= SEQ - 3) p.out[O_CONVP + ((size_t)(layer * NB + b) * 3 + (l - (SEQ - 3))) * CONVD + c] = raw;
    } else {
        int bs = t - NPT;
        const float* prev = p.state_conv + ((size_t)(layer * NS + bs) * 3) * CONVD;
#pragma unroll
        for (int k = 0; k < 3; ++k) acc += prev[k * CONVD + c] * cw[k * CONVD + c];
        acc += raw * cw[3 * CONVD + c];
        float* oc = p.out + O_CONVS + ((size_t)(layer * NS + bs) * 3) * CONVD;
        oc[0 * CONVD + c] = prev[1 * CONVD + c];
        oc[1 * CONVD + c] = prev[2 * CONVD + c];
        oc[2 * CONVD + c] = raw;
    }
    p.xbc[(size_t)t * CONVD + c] = silu_f(acc);
}
__global__ void k_dt(P p, int layer) {
    int i = blockIdx.x * blockDim.x + threadIdx.x;
    if (i >= NT * 16) return;
    int t = i / 16, e = i % 16;
    float x = p.proj[(size_t)t * DIN + OFF_DT + e] + p.dt_bias[layer * 16 + e];
    float sp = (x > 20.f) ? x : log1pf(expf(x));
    p.dt[i] = sp;
}

__global__ void __launch_bounds__(256) k_ssd_seq(P p, int layer) {
    int seq = blockIdx.x / 16, e = blockIdx.x % 16, g = e / 8;
    int pp = threadIdx.x >> 2, nq = threadIdx.x & 3;
    float A = -expf(p.a_log[layer * 16 + e]);
    float Dk = p.d_skip[layer * 16 + e];
    float s[32];
    int t0, L;
    float* hout;
    if (seq < NB) {
        t0 = seq * SEQ; L = SEQ;
#pragma unroll
        for (int j = 0; j < 32; ++j) s[j] = 0.f;
        hout = p.out + O_SSMP + (((size_t)(layer * NB + seq) * 16 + e) * 64 + pp) * 128 + nq * 32;
    } else {
        int bs = seq - NB;
        t0 = NPT + bs; L = 1;
        const float* h0 = p.state_ssm + (((size_t)(layer * NS + bs) * 16 + e) * 64 + pp) * 128 + nq * 32;
#pragma unroll
        for (int j = 0; j < 32; ++j) s[j] = h0[j];
        hout = p.out + O_SSMS + (((size_t)(layer * NS + bs) * 16 + e) * 64 + pp) * 128 + nq * 32;
    }
    for (int l = 0; l < L; ++l) {
        int t = t0 + l;
        float dt = p.dt[t * 16 + e];
        float dA = expf(dt * A);
        const float* xr = p.xbc + (size_t)t * CONVD;
        float xv = xr[e * 64 + pp];
        float xdt = xv * dt;
        const float4* Bp = (const float4*)(xr + 1024 + g * 128 + nq * 32);
        const float4* Cp = (const float4*)(xr + 1280 + g * 128 + nq * 32);
        float ys = 0.f;
#pragma unroll
        for (int j4 = 0; j4 < 8; ++j4) {
            float4 b = Bp[j4], c = Cp[j4];
            s[j4 * 4 + 0] = s[j4 * 4 + 0] * dA + xdt * b.x; ys += c.x * s[j4 * 4 + 0];
            s[j4 * 4 + 1] = s[j4 * 4 + 1] * dA + xdt * b.y; ys += c.y * s[j4 * 4 + 1];
            s[j4 * 4 + 2] = s[j4 * 4 + 2] * dA + xdt * b.z; ys += c.z * s[j4 * 4 + 2];
            s[j4 * 4 + 3] = s[j4 * 4 + 3] * dA + xdt * b.w; ys += c.w * s[j4 * 4 + 3];
        }
        ys += __shfl_xor(ys, 1);
        ys += __shfl_xor(ys, 2);
        if (nq == 0) p.yraw[(size_t)t * DM + e * 64 + pp] = ys + Dk * xv;
    }
#pragma unroll
    for (int j = 0; j < 32; ++j) hout[j] = s[j];
}

__global__ void k_gate_norm(P p, int layer) {
    int w = blockIdx.x * 4 + (threadIdx.x >> 6);
    int lane = threadIdx.x & 63;
    if (w >= NT * 2) return;
    int t = w >> 1, g = w & 1;
    float v[8];
    float ss = 0.f;
#pragma unroll
    for (int j = 0; j < 8; ++j) {
        int c = g * 512 + j * 64 + lane;
        float y = p.yraw[(size_t)t * DM + c];
        float z = p.proj[(size_t)t * DIN + OFF_Z + c];
        v[j] = y * silu_f(z);
        ss += v[j] * v[j];
    }
    ss = wave_sum(ss);
    float r = rsqrtf(ss / 512.f + EPSF);
#pragma unroll
    for (int j = 0; j < 8; ++j) {
        int c = g * 512 + j * 64 + lane;
        p.yn[(size_t)t * DM + c] = v[j] * r * p.ssm_norm[layer * DM + c];
    }
}

__global__ void k_mla_post(P p, int layer) {
    int t = blockIdx.x * 4 + (threadIdx.x >> 6);
    int lane = threadIdx.x & 63;
    if (t >= NT) return;
    int pi = (t < NPT) ? (t % SEQ) : 2048;
    const float* cs = p.rope + pi * 16;
    const float* sn = p.rope + 2049 * 16 + pi * 16;
#pragma unroll
    for (int r = 0; r < 2; ++r) {
        int id = lane + r * 64;
        int hh = id >> 4, j = id & 15;
        float* qp = p.q + (size_t)t * 768 + hh * 96 + 64;
        float x1 = qp[j], x2 = qp[16 + j];
        qp[j] = x1 * cs[j] - x2 * sn[j];
        qp[16 + j] = x1 * sn[j] + x2 * cs[j];
    }
    if (lane < 16) {
        const float* kr = p.proj + (size_t)t * DIN + OFF_KR;
        float x1 = kr[lane], x2 = kr[16 + lane];
        float o1 = x1 * cs[lane] - x2 * sn[lane];
        float o2 = x1 * sn[lane] + x2 * cs[lane];
        p.kpe[(size_t)t * 32 + lane] = o1;
        p.kpe[(size_t)t * 32 + 16 + lane] = o2;
        float* ok = (t < NPT) ? (p.out + O_KRP + ((size_t)layer * NPT + t) * 32) : (p.out + O_KRS + ((size_t)layer * NS + (t - NPT)) * 32);
        ok[lane] = o1; ok[16 + lane] = o2;
    }
    float* ol = (t < NPT) ? (p.out + O_LATP + ((size_t)layer * NPT + t) * KVL) : (p.out + O_LATS + ((size_t)layer * NS + (t - NPT)) * KVL);
#pragma unroll
    for (int r = 0; r < 4; ++r) ol[lane + r * 64] = p.lat[(size_t)t * KVL + lane + r * 64];
}

__global__ void __launch_bounds__(64) k_attn_prompt(P p) {
    int gid = blockIdx.x * 64 + threadIdx.x;
    int qi = gid % SEQ, bh = gid / SEQ;
    int h = bh % 8, b = bh / 8;
    int tq = b * SEQ + qi;
    float q[96];
    const float* qp = p.q + (size_t)tq * 768 + h * 96;
#pragma unroll
    for (int d = 0; d < 96; ++d) q[d] = qp[d] * ATT_SCALE;
    float acc[64];
#pragma unroll
    for (int d = 0; d < 64; ++d) acc[d] = 0.f;
    float m = -INFINITY, l = 0.f;
    int kmax = __shfl(qi, 63);
    for (int kk = 0; kk <= kmax; ++kk) {
        int tk = b * SEQ + kk;
        const float4* kn = (const float4*)(p.kv + (size_t)tk * 1024 + h * 128);
        const float4* kr = (const float4*)(p.kpe + (size_t)tk * 32);
        float s = 0.f;
#pragma unroll
        for (int d4 = 0; d4 < 16; ++d4) { float4 k4 = kn[d4]; s += q[d4 * 4] * k4.x + q[d4 * 4 + 1] * k4.y + q[d4 * 4 + 2] * k4.z + q[d4 * 4 + 3] * k4.w; }
#pragma unroll
        for (int d4 = 0; d4 < 8; ++d4) { float4 k4 = kr[d4]; s += q[64 + d4 * 4] * k4.x + q[64 + d4 * 4 + 1] * k4.y + q[64 + d4 * 4 + 2] * k4.z + q[64 + d4 * 4 + 3] * k4.w; }
        if (kk <= qi) {
            float mn = fmaxf(m, s);
            float corr = expf(m - mn);
            float pe = expf(s - mn);
            l = l * corr + pe;
            const float4* vp = (const float4*)(p.kv + (size_t)tk * 1024 + h * 128 + 64);
#pragma unroll
            for (int d4 = 0; d4 < 16; ++d4) {
                float4 v4 = vp[d4];
                acc[d4 * 4 + 0] = acc[d4 * 4 + 0] * corr + pe * v4.x;
                acc[d4 * 4 + 1] = acc[d4 * 4 + 1] * corr + pe * v4.y;
                acc[d4 * 4 + 2] = acc[d4 * 4 + 2] * corr + pe * v4.z;
                acc[d4 * 4 + 3] = acc[d4 * 4 + 3] * corr + pe * v4.w;
            }
            m = mn;
        }
    }
    float inv = 1.f / l;
    float* op = p.o + (size_t)tq * 512 + h * 64;
#pragma unroll
    for (int d = 0; d < 64; ++d) op[d] = acc[d] * inv;
}

__global__ void k_qlat(P p, int layer) {
    int bs = blockIdx.x / 8, h = blockIdx.x % 8;
    int r = threadIdx.x;
    const float* qp = p.q + (size_t)(NPT + bs) * 768 + h * 96;
    const float* w = p.w_kvb + (size_t)layer * 256 * 1024 + (size_t)r * 1024 + h * 128;
    float s = 0.f;
    for (int d = 0; d < 64; ++d) s += qp[d] * w[d];
    p.qlat[((size_t)bs * 8 + h) * 256 + r] = s * ATT_SCALE;
}
__global__ void __launch_bounds__(256) k_decode_part(P p, int layer) {
    __shared__ float sq[8][288];
    __shared__ float ss[8][128];
    __shared__ float sm[8], sl[8];
    int bs = blockIdx.x / 129, ch = blockIdx.x % 129;
    int tid = threadIdx.x, lane = tid & 63, wv = tid >> 6;
    for (int i = tid; i < 8 * 288; i += 256) {
        int h = i / 288, d = i % 288;
        sq[h][d] = (d < 256) ? p.qlat[((size_t)bs * 8 + h) * 256 + d] : p.q[(size_t)(NPT + bs) * 768 + h * 96 + 64 + (d - 256)] * ATT_SCALE;
    }
    __syncthreads();
    int nkeys = (ch < 128) ? 128 : 1;
    const float* latb; const float* krb;
    if (ch < 128) {
        int pg = p.page_table[bs * NPAGES + ch];
        latb = p.cache_lat + ((size_t)layer * NPOOL + pg) * PAGE * KVL;
        krb = p.cache_kr + ((size_t)layer * NPOOL + pg) * PAGE * 32;
    } else {
        latb = p.lat + (size_t)(NPT + bs) * KVL;
        krb = p.kpe + (size_t)(NPT + bs) * 32;
    }
    for (int k = wv; k < nkeys; k += 4) {
        float4 kv4 = *(const float4*)(latb + (size_t)k * KVL + lane * 4);
        float kr = (lane < 32) ? krb[(size_t)k * 32 + lane] : 0.f;
        float sh[8];
#pragma unroll
        for (int h = 0; h < 8; ++h) {
            float s = sq[h][lane * 4] * kv4.x + sq[h][lane * 4 + 1] * kv4.y + sq[h][lane * 4 + 2] * kv4.z + sq[h][lane * 4 + 3] * kv4.w;
            if (lane < 32) s += sq[h][256 + lane] * kr;
            sh[h] = wave_sum(s);
        }
        if (lane == 0) {
#pragma unroll
            for (int h = 0; h < 8; ++h) ss[h][k] = sh[h];
        }
    }
    __syncthreads();
    for (int hh = 0; hh < 2; ++hh) {
        int h = wv * 2 + hh;
        float v0 = (lane < nkeys) ? ss[h][lane] : -INFINITY;
        float v1 = (lane + 64 < nkeys) ? ss[h][lane + 64] : -INFINITY;
        float m = wave_max(fmaxf(v0, v1));
        float p0 = (lane < nkeys) ? expf(v0 - m) : 0.f;
        float p1 = (lane + 64 < nkeys) ? expf(v1 - m) : 0.f;
        float l = wave_sum(p0 + p1);
        if (lane < nkeys) ss[h][lane] = p0;
        if (lane + 64 < nkeys) ss[h][lane + 64] = p1;
        if (lane == 0) { sm[h] = m; sl[h] = l; }
    }
    __syncthreads();
    float acc[8];
#pragma unroll
    for (int h = 0; h < 8; ++h) acc[h] = 0.f;
    for (int k = 0; k < nkeys; ++k) {
        float v = latb[(size_t)k * KVL + tid];
#pragma unroll
        for (int h = 0; h < 8; ++h) acc[h] += ss[h][k] * v;
    }
    float* pp = p.part + ((size_t)bs * 129 + ch) * 8 * 258;
#pragma unroll
    for (int h = 0; h < 8; ++h) pp[h * 258 + 2 + tid] = acc[h];
    if (tid < 8) { pp[tid * 258 + 0] = sm[tid]; pp[tid * 258 + 1] = sl[tid]; }
}
__global__ void __launch_bounds__(256) k_decode_comb(P p, int layer) {
    __shared__ float sw[129];
    __shared__ float so[256];
    __shared__ float sL;
    int bs = blockIdx.x / 8, h = blockIdx.x % 8, tid = threadIdx.x;
    const float* pb = p.part + (size_t)bs * 129 * 8 * 258 + h * 258;
    if (tid < 64) {
        float m = -INFINITY;
        for (int c = tid; c < 129; c += 64) m = fmaxf(m, pb[(size_t)c * 8 * 258]);
        m = wave_max(m);
        float l = 0.f;
        for (int c = tid; c < 129; c += 64) {
            float w = expf(pb[(size_t)c * 8 * 258] - m);
            sw[c] = w;
            l += w * pb[(size_t)c * 8 * 258 + 1];
        }
        l = wave_sum(l);
        if (tid == 0) sL = l;
    }
    __syncthreads();
    float a = 0.f;
    for (int c = 0; c < 129; ++c) a += sw[c] * pb[(size_t)c * 8 * 258 + 2 + tid];
    so[tid] = a / sL;
    __syncthreads();
    if (tid < 64) {
        const float* w = p.w_kvb + (size_t)layer * 256 * 1024 + h * 128 + 64 + tid;
        float s = 0.f;
        for (int r = 0; r < 256; ++r) s += so[r] * w[(size_t)r * 1024];
        p.o[(size_t)(NPT + bs) * 512 + h * 64 + tid] = s;
    }
}

__global__ void k_mix(P p, int layer) {
    size_t i = (size_t)blockIdx.x * blockDim.x + threadIdx.x;
    if (i >= (size_t)NT * DM) return;
    int t = (int)(i / DM), c = (int)(i % DM);
    float ga = sigmoid_f(p.proj[(size_t)t * DIN + OFF_GA + c] + p.b_gate[layer * 2048 + c]);
    float gb = sigmoid_f(p.proj[(size_t)t * DIN + OFF_GB + c] + p.b_gate[layer * 2048 + 1024 + c]);
    p.mix[i] = ga * p.ya[i] + gb * p.yb[i];
}

__global__ void __launch_bounds__(128) k_peer_scores(P p, int layer) {
    __shared__ float sq[128];
    int t = blockIdx.x / 16, hh = blockIdx.x % 16, k = threadIdx.x;
    sq[k] = p.pq[(size_t)t * 2048 + hh * 128 + k];
    __syncthreads();
    const float4* kp = (const float4*)(p.peer_keys + ((size_t)(layer * 16 + hh) * 128 + k) * 128);
    float s = 0.f;
#pragma unroll 8
    for (int d4 = 0; d4 < 32; ++d4) { float4 v = kp[d4]; s += sq[d4 * 4] * v.x + sq[d4 * 4 + 1] * v.y + sq[d4 * 4 + 2] * v.z + sq[d4 * 4 + 3] * v.w; }
    p.sc[(size_t)t * 2048 + hh * 128 + k] = s;
}
__device__ __forceinline__ void wave_argmax(float& v, int& i) {
#pragma unroll
    for (int o = 32; o > 0; o >>= 1) {
        float ov = __shfl_xor(v, o);
        int oi = __shfl_xor(i, o);
        if (ov > v || (ov == v && oi < i)) { v = ov; i = oi; }
    }
}
__global__ void __launch_bounds__(256) k_peer_topk(P p) {
    int w = blockIdx.x * 4 + (threadIdx.x >> 6);
    int lane = threadIdx.x & 63;
    if (w >= NT * 8) return;
    int t = w / 8, h = w % 8;
    float topv0 = 0.f, topv1 = 0.f;
    int topi0 = 0, topi1 = 0;
#pragma unroll
    for (int half = 0; half < 2; ++half) {
        const float* sp = p.sc + (size_t)t * 2048 + (h * 2 + half) * 128;
        float a0 = sp[lane], a1 = sp[lane + 64];
        float tv = 0.f; int ti = 0;
        for (int r = 0; r < 16; ++r) {
            float v; int i;
            if (a0 >= a1) { v = a0; i = lane; } else { v = a1; i = lane + 64; }
            wave_argmax(v, i);
            if (i == lane) a0 = -INFINITY;
            if (i == lane + 64) a1 = -INFINITY;
            if (lane == r) { tv = v; ti = i; }
        }
        if (half == 0) { topv0 = tv; topi0 = ti; } else { topv1 = tv; topi1 = ti; }
    }
    float cv0, cv1, cv2, cv3;
    {
        float va = __shfl(topv0, lane >> 2);
        int b0 = (lane & 3) * 4;
        cv0 = va + __shfl(topv1, b0 + 0);
        cv1 = va + __shfl(topv1, b0 + 1);
        cv2 = va + __shfl(topv1, b0 + 2);
        cv3 = va + __shfl(topv1, b0 + 3);
    }
    float selv = 0.f; int selc = 0;
    for (int r = 0; r < 16; ++r) {
        float v = cv0; int c = lane * 4;
        if (cv1 > v) { v = cv1; c = lane * 4 + 1; }
        if (cv2 > v) { v = cv2; c = lane * 4 + 2; }
        if (cv3 > v) { v = cv3; c = lane * 4 + 3; }
        wave_argmax(v, c);
        if (c == lane * 4 + 0) cv0 = -INFINITY;
        if (c == lane * 4 + 1) cv1 = -INFINITY;
        if (c == lane * 4 + 2) cv2 = -INFINITY;
        if (c == lane * 4 + 3) cv3 = -INFINITY;
        if (lane == r) { selv = v; selc = c; }
    }
    float mx = __shfl(selv, 0);
    float e = (lane < 16) ? expf(selv - mx) : 0.f;
    float sum = wave_sum(e);
    int ia = __shfl(topi0, selc >> 4);
    int ib = __shfl(topi1, selc & 15);
    if (lane < 16) {
        p.idx[(size_t)t * 128 + h * 16 + lane] = ia * 128 + ib;
        p.gate[(size_t)t * 128 + h * 16 + lane] = e / sum;
    }
}
__global__ void __launch_bounds__(256) k_peer_experts(P p, int layer) {
    __shared__ float sh[1024];
    __shared__ float sw[128];
    __shared__ int si[128];
    int t = blockIdx.x, tid = threadIdx.x, lane = tid & 63, wv = tid >> 6;
    for (int i = tid; i < 1024; i += 256) sh[i] = p.h[(size_t)t * DM + i];
    if (tid < 128) si[tid] = p.idx[(size_t)t * 128 + tid];
    __syncthreads();
    const float* U = p.peer_u + (size_t)layer * NEXP * DM;
    const float* V = p.peer_v + (size_t)layer * NEXP * DM;
    for (int k = wv; k < 128; k += 4) {
        const float4* up = (const float4*)(U + (size_t)si[k] * DM);
        float s = 0.f;
#pragma unroll
        for (int r = 0; r < 4; ++r) {
            float4 u4 = up[r * 64 + lane];
            int d = (r * 64 + lane) * 4;
            s += u4.x * sh[d] + u4.y * sh[d + 1] + u4.z * sh[d + 2] + u4.w * sh[d + 3];
        }
        s = wave_sum(s);
        if (lane == 0) {
            float act = 0.5f * s * (1.f + erff(s * 0.70710678118654752f));
            sw[k] = p.gate[(size_t)t * 128 + k] * act;
        }
    }
    __syncthreads();
    float4 acc = make_float4(0.f, 0.f, 0.f, 0.f);
    for (int k = 0; k < 128; ++k) {
        float4 v4 = *(const float4*)(V + (size_t)si[k] * DM + tid * 4);
        float w = sw[k];
        acc.x += w * v4.x; acc.y += w * v4.y; acc.z += w * v4.z; acc.w += w * v4.w;
    }
    float4* xp = (float4*)(p.xres + (size_t)t * DM + tid * 4);
    float4 xv = *xp;
    xv.x += acc.x; xv.y += acc.y; xv.z += acc.z; xv.w += acc.w;
    *xp = xv;
}

static inline float* carve(char*& cur, size_t nfloats) {
    float* r = (float*)cur;
    cur += ((nfloats * 4 + 255) / 256) * 256;
    return r;
}
static void gemm(hipStream_t s, const float* A, int lda, const float* B, int ldb, float* C, int ldc, int M, int N, int K, int acc) {
    dim3 g((N + 63) / 64, M / 64);
    k_gemm_f32<<<g, 256, 0, s>>>(A, lda, B, ldb, C, ldc, M, N, K, acc);
}

extern "C" void kernel_launch(void* const* d_in, const int* in_sizes, int n_in,
                              void* d_out, int out_size, void* d_ws, size_t ws_size,
                              hipStream_t stream) {
    P p{};
    p.x_prompt = (const float*)d_in[0]; p.x_sample = (const float*)d_in[1];
    p.cache_lat = (const float*)d_in[2]; p.cache_kr = (const float*)d_in[3];
    p.state_ssm = (const float*)d_in[4]; p.state_conv = (const float*)d_in[5];
    p.page_table = (const int*)d_in[6];
    p.norm_mix = (const float*)d_in[7]; p.w_in = (const float*)d_in[8]; p.b_gate = (const float*)d_in[9];
    p.conv_w = (const float*)d_in[10]; p.conv_b = (const float*)d_in[11]; p.dt_bias = (const float*)d_in[12];
    p.a_log = (const float*)d_in[13]; p.d_skip = (const float*)d_in[14]; p.ssm_norm = (const float*)d_in[15];
    p.w_ssm_proj = (const float*)d_in[16]; p.q_norm = (const float*)d_in[17]; p.w_qb = (const float*)d_in[18];
    p.kv_norm = (const float*)d_in[19]; p.w_kvb = (const float*)d_in[20]; p.w_mla_proj = (const float*)d_in[21];
    p.w_out = (const float*)d_in[22]; p.norm_ffn = (const float*)d_in[23]; p.peer_wq = (const float*)d_in[24];
    p.peer_keys = (const float*)d_in[25]; p.peer_u = (const float*)d_in[26]; p.peer_v = (const float*)d_in[27];
    p.norm_final = (const float*)d_in[28];
    p.out = (float*)d_out;
    char* cur = (char*)d_ws;
    p.xres = carve(cur, (size_t)TP * DM);
    p.h = carve(cur, (size_t)TP * DM);
    p.proj = carve(cur, (size_t)TP * DIN);
    p.xbc = carve(cur, (size_t)TP * CONVD);
    p.dt = carve(cur, (size_t)TP * 16);
    p.yraw = carve(cur, (size_t)TP * DM);
    p.yn = carve(cur, (size_t)TP * DM);
    p.ya = carve(cur, (size_t)TP * DM);
    p.qn = carve(cur, (size_t)TP * QL);
    p.q = carve(cur, (size_t)TP * 768);
    p.lat = carve(cur, (size_t)TP * KVL);
    p.kpe = carve(cur, (size_t)TP * 32);
    p.kv = carve(cur, (size_t)TP * 1024);
    p.o = carve(cur, (size_t)TP * 512);
    p.yb = carve(cur, (size_t)TP * DM);
    p.mix = carve(cur, (size_t)TP * DM);
    p.pq = carve(cur, (size_t)TP * 2048);
    p.sc = carve(cur, (size_t)TP * 2048);
    p.gate = carve(cur, (size_t)TP * 128);
    p.part = carve(cur, (size_t)NS * 129 * 8 * 258);
    p.qlat = carve(cur, (size_t)NS * 8 * 256);
    p.rope = carve(cur, (size_t)2 * 2049 * 16);
    p.idx = (int*)carve(cur, (size_t)TP * 128);

    hipMemsetAsync(d_ws, 0, (size_t)(cur - (char*)d_ws), stream);

    k_rope_table<<<(2049 * 16 + 255) / 256, 256, 0, stream>>>(p.rope);
    k_copy_x<<<2048, 256, 0, stream>>>(p);

    for (int l = 0; l < DEPTH; ++l) {
        k_rmsnorm<<<TP / 4, 256, 0, stream>>>(p.xres, DM, p.norm_mix + l * DM, p.h, DM, DM, TP);
        gemm(stream, p.h, DM, p.w_in + (size_t)l * DM * DIN, DIN, p.proj, DIN, TP, DIN, DM, 0);
        k_conv<<<(int)(((size_t)NT * CONVD + 255) / 256), 256, 0, stream>>>(p, l);
        k_dt<<<(NT * 16 + 255) / 256, 256, 0, stream>>>(p, l);
        k_ssd_seq<<<(NB + NS) * 16, 256, 0, stream>>>(p, l);
        k_gate_norm<<<(NT * 2 + 3) / 4, 256, 0, stream>>>(p, l);
        gemm(stream, p.yn, DM, p.w_ssm_proj + (size_t)l * DM * DM, DM, p.ya, DM, TP, DM, DM, 0);
        k_rmsnorm<<<TP / 4, 256, 0, stream>>>(p.proj + OFF_CQ, DIN, p.q_norm + l * QL, p.qn, QL, QL, TP);
        gemm(stream, p.qn, QL, p.w_qb + (size_t)l * QL * 768, 768, p.q, 768, TP, 768, QL, 0);
        k_rmsnorm<<<TP / 4, 256, 0, stream>>>(p.proj + OFF_CKV, DIN, p.kv_norm + l * KVL, p.lat, KVL, KVL, TP);
        k_mla_post<<<(NT + 3) / 4, 256, 0, stream>>>(p, l);
        gemm(stream, p.lat, KVL, p.w_kvb + (size_t)l * KVL * 1024, 1024, p.kv, 1024, TP, 1024, KVL, 0);
        k_attn_prompt<<<NB * 8 * SEQ / 64, 64, 0, stream>>>(p);
        k_qlat<<<NS * 8, 256, 0, stream>>>(p, l);
        k_decode_part<<<NS * 129, 256, 0, stream>>>(p, l);
        k_decode_comb<<<NS * 8, 256, 0, stream>>>(p, l);
        gemm(stream, p.o, 512, p.w_mla_proj + (size_t)l * 512 * DM, DM, p.yb, DM, TP, DM, 512, 0);
        k_mix<<<(int)(((size_t)NT * DM + 255) / 256), 256, 0, stream>>>(p, l);
        gemm(stream, p.mix, DM, p.w_out + (size_t)l * DM * DM, DM, p.xres, DM, TP, DM, DM, 1);
        k_rmsnorm<<<TP / 4, 256, 0, stream>>>(p.xres, DM, p.norm_ffn + l * DM, p.h, DM, DM, TP);
        gemm(stream, p.h, DM, p.peer_wq + (size_t)l * DM * 2048, 2048, p.pq, 2048, TP, 2048, DM, 0);
        k_peer_scores<<<NT * 16, 128, 0, stream>>>(p, l);
        k_peer_topk<<<(NT * 8 + 3) / 4, 256, 0, stream>>>(p);
        k_peer_experts<<<NT, 256, 0, stream>>>(p, l);
    }
    k_rmsnorm<<<(NT + 3) / 4, 256, 0, stream>>>(p.xres, DM, p.norm_final, p.out + O_YP, DM, DM, NT);
}
```

```cpp
#include <hip/hip_runtime.h>
#include <stdint.h>

#define DM 1024
#define NB 8
#define SEQ 2048
#define NPT (NB * SEQ)
#define NS 32
#define NT (NPT + NS)
#define TP 16512
#define DEPTH 2
#define PAST 16384
#define PAGE 128
#define NPAGES 128
#define NPOOL 5120
#define DIN 5296
#define OFF_GA 0
#define OFF_GB 1024
#define OFF_Z 2048
#define OFF_XBC 3072
#define OFF_DT 4608
#define OFF_CQ 4624
#define OFF_CKV 5008
#define OFF_KR 5264
#define CONVD 1536
#define QL 384
#define KVL 256
#define NEXP 16384
#define EPSF 1e-6f
#define ATT_SCALE 0.10206207261596577f

#define O_YP 0
#define O_YS (O_YP + NPT * DM)
#define O_LATP (O_YS + NS * DM)
#define O_KRP (O_LATP + DEPTH * NPT * KVL)
#define O_SSMP (O_KRP + DEPTH * NPT * 32)
#define O_CONVP (O_SSMP + DEPTH * NB * 16 * 64 * 128)
#define O_LATS (O_CONVP + DEPTH * NB * 3 * CONVD)
#define O_KRS (O_LATS + DEPTH * NS * KVL)
#define O_SSMS (O_KRS + DEPTH * NS * 32)
#define O_CONVS (O_SSMS + DEPTH * NS * 16 * 64 * 128)

struct P {
    const float *x_prompt, *x_sample, *cache_lat, *cache_kr, *state_ssm, *state_conv;
    const int* page_table;
    const float *norm_mix, *w_in, *b_gate, *conv_w, *conv_b, *dt_bias, *a_log, *d_skip, *ssm_norm, *w_ssm_proj;
    const float *q_norm, *w_qb, *kv_norm, *w_kvb, *w_mla_proj, *w_out, *norm_ffn, *peer_wq, *peer_keys, *peer_u, *peer_v, *norm_final;
    float* out;
    float *xres, *h, *proj, *xbc, *dt, *yraw, *yn, *ya, *qn, *q, *lat, *kpe, *kv, *o, *yb, *mix, *pq, *sc, *gate, *part, *qlat, *rope;
    int* idx;
    unsigned* bar;
};

#define XB_TMO      128
#define XB_XCNT(j)  (256  + 64 * (j))
#define XB_XSUB(j)  (1280 + 64 * (j))
#define XB_XGEN(j)  (2304 + 64 * (j))
#define XB_TOP      3328
#define XB_TOPGEN   3392
#define XCD_BAR_WORDS 3456
#define XB_SPIN_CAP (1u << 18)
#define LAS __attribute__((address_space(3)))

__device__ __forceinline__ unsigned xb_ld(unsigned* p)              { return __hip_atomic_load(p, __ATOMIC_RELAXED, __HIP_MEMORY_SCOPE_AGENT); }
__device__ __forceinline__ unsigned xb_add(unsigned* p, unsigned v) { return __hip_atomic_fetch_add(p, v, __ATOMIC_RELAXED, __HIP_MEMORY_SCOPE_AGENT); }
__device__ __forceinline__ unsigned xb_xcc_id() { return (unsigned)__builtin_amdgcn_s_getreg((3 << 11) | 20) & 0xFu; }
#define XB_SPIN(cond, bar) do { unsigned _sp = 0; while (cond) { __builtin_amdgcn_s_sleep(1); \
    if ((++_sp & 255u) == 0u) { if (xb_ld(&(bar)[XB_TMO])) break; if (_sp > XB_SPIN_CAP) { atomicAdd(&(bar)[XB_TMO], 1u); break; } } } } while (0)

struct XcdBarrier {
    unsigned* bar; unsigned x;
    volatile LAS unsigned* st;
};

__device__ __forceinline__ XcdBarrier xcd_barrier_post(unsigned* bar, volatile LAS unsigned* st) {
    XcdBarrier b; b.bar = bar; b.x = xb_xcc_id(); b.st = st;
    if (threadIdx.x == 0) (void)xb_add(&bar[XB_XCNT(b.x)], 1u);
    return b;
}
__device__ __forceinline__ void xcd_barrier_complete(unsigned* bar, unsigned x, unsigned& nloc, unsigned& nx) {
    const unsigned G = gridDim.x * gridDim.y * gridDim.z;
    unsigned sum, cnt, mine, sp = 0u;
    for (;;) {
        sum = 0u; cnt = 0u; mine = 0u;
#pragma unroll
        for (unsigned j = 0; j < 16; ++j) { const unsigned c = xb_ld(&bar[XB_XCNT(j)]); sum += c; cnt += (c > 0u) ? 1u : 0u; mine = (j == x) ? c : mine; }
        if (sum == G) break;
        __builtin_amdgcn_s_sleep(1);
        if ((++sp & 255u) == 0u) { if (xb_ld(&bar[XB_TMO])) break; if (sp > XB_SPIN_CAP) { atomicAdd(&bar[XB_TMO], 1u); break; } }
    }
    nloc = mine > 0u ? mine : 1u; nx = cnt > 0u ? cnt : 1u;
}

__device__ __forceinline__ void xcd_barrier(const XcdBarrier& b) {
    asm volatile("s_waitcnt vmcnt(0)" ::: "memory");
    __syncthreads();
    if (threadIdx.x == 0) {
        unsigned* bar = b.bar;
        __builtin_amdgcn_s_waitcnt(0);
        unsigned nloc = b.st[0], nx = b.st[1];
        if (nloc == 0u) { xcd_barrier_complete(bar, b.x, nloc, nx); b.st[0] = nloc; b.st[1] = nx; }
        const unsigned old = xb_add(&bar[XB_XSUB(b.x)], 1u);
        const unsigned gen = old / nloc;
        if (old + 1u == (gen + 1u) * nloc) {
            __builtin_amdgcn_fence(__ATOMIC_RELEASE, "agent");
            asm volatile("s_waitcnt vmcnt(0)" ::: "memory");
            const unsigned og = xb_add(&bar[XB_TOP], 1u);
            const unsigned tg = og / nx;
            if (og + 1u == (tg + 1u) * nx) xb_add(&bar[XB_TOPGEN], 1u);
            else XB_SPIN(xb_ld(&bar[XB_TOPGEN]) == tg, bar);
            __builtin_amdgcn_fence(__ATOMIC_ACQUIRE, "agent");
            xb_add(&bar[XB_XGEN(b.x)], 1u);
            asm volatile("s_waitcnt vmcnt(0)" ::: "memory");
        } else {
            XB_SPIN(xb_ld(&bar[XB_XGEN(b.x)]) == gen, bar);
            __builtin_amdgcn_fence(__ATOMIC_ACQUIRE, "agent");
            asm volatile("s_waitcnt vmcnt(0)" ::: "memory");
        }
    }
    __syncthreads();
}


__device__ __forceinline__ float wave_sum(float v) {
#pragma unroll
    for (int o = 32; o > 0; o >>= 1) v += __shfl_xor(v, o);
    return v;
}
__device__ __forceinline__ float wave_max(float v) {
#pragma unroll
    for (int o = 32; o > 0; o >>= 1) v = fmaxf(v, __shfl_xor(v, o));
    return v;
}
__device__ __forceinline__ float silu_f(float x) { return x / (1.f + expf(-x)); }
__device__ __forceinline__ float sigmoid_f(float x) { return 1.f / (1.f + expf(-x)); }


__device__ __forceinline__ int opaque_v(int x) { asm volatile("" : "+v"(x)); return x; }
__device__ __forceinline__ int opaque_s(int x) { asm volatile("" : "+s"(x)); return x; }
#define NTHR 256
#define VB_LOOP(n) for (int vb = bid_; vb < (n); vb += gridDim.x)

__device__ __forceinline__ void ph_rope_table(const P& p) {
    const int tid_ = opaque_v((int)threadIdx.x); const int bid_ = opaque_s((int)blockIdx.x); (void)tid_; (void)bid_;
    for (int i = bid_ * NTHR + tid_; i < 2049 * 16; i += gridDim.x * NTHR) {
        int pi = i / 16, j = i % 16;
        float pos = (pi == 2048) ? 16384.f : (float)pi;
        float inv = powf(10000.f, -(float)j / 16.f);
        float ang = pos * inv;
        p.rope[i] = (float)cos((double)ang);
        p.rope[2049 * 16 + i] = (float)sin((double)ang);
    }
}
__device__ __forceinline__ void ph_copy_x(const P& p) {
    const int tid_ = opaque_v((int)threadIdx.x); const int bid_ = opaque_s((int)blockIdx.x); (void)tid_; (void)bid_;
    size_t n = (size_t)TP * DM;
    for (size_t i = (size_t)bid_ * NTHR + tid_; i < n; i += (size_t)gridDim.x * NTHR) {
        size_t t = i / DM;
        float v = 0.f;
        if (t < NPT) v = p.x_prompt[i];
        else if (t < NT) v = p.x_sample[i - (size_t)NPT * DM];
        p.xres[i] = v;
    }
}
__device__ __forceinline__ void ph_rmsnorm(const float* in, int ldi, const float* w, float* out, int ldo, int D, int rows) {
    const int tid_ = opaque_v((int)threadIdx.x); const int bid_ = opaque_s((int)blockIdx.x); (void)tid_; (void)bid_;
    VB_LOOP((rows + 3) / 4) {
        int row = vb * 4 + (tid_ >> 6);
        int lane = tid_ & 63;
        if (row < rows) {
            const float* x = in + (size_t)row * ldi;
            float s = 0.f;
            for (int c = lane; c < D; c += 64) { float v = x[c]; s += v * v; }
            s = wave_sum(s);
            float r = rsqrtf(s / (float)D + EPSF);
            for (int c = lane; c < D; c += 64) out[(size_t)row * ldo + c] = x[c] * r * w[c];
        }
    }
}
__device__ __forceinline__ void ph_gemm(const float* A, int lda, const float* B, int ldb, float* C, int ldc, int M, int N, int K, int accumulate) {
    const int tid_ = opaque_v((int)threadIdx.x); const int bid_ = opaque_s((int)blockIdx.x); (void)tid_; (void)bid_;
    __shared__ float sA[16][64 + 4];
    __shared__ float sB[16][64 + 4];
    int nbx = (N + 63) / 64, nby = M / 64;
    int tx = tid_ & 15, ty = tid_ >> 4;
    VB_LOOP(nbx * nby) {
        int m0 = (vb / nbx) * 64, n0 = (vb % nbx) * 64;
        float acc[4][4];
#pragma unroll
        for (int i = 0; i < 4; ++i)
#pragma unroll
            for (int j = 0; j < 4; ++j) acc[i][j] = 0.f;
        for (int k0 = 0; k0 < K; k0 += 16) {
            {
                int r = tid_ >> 2, kk = (tid_ & 3) * 4;
                const float* ap = A + (size_t)(m0 + r) * lda + k0 + kk;
                float4 v = *(const float4*)ap;
                sA[kk + 0][r] = v.x; sA[kk + 1][r] = v.y; sA[kk + 2][r] = v.z; sA[kk + 3][r] = v.w;
            }
            {
                int kk = tid_ >> 4, c = (tid_ & 15) * 4;
#pragma unroll
                for (int j = 0; j < 4; ++j) {
                    int n = n0 + c + j;
                    sB[kk][c + j] = (n < N) ? B[(size_t)(k0 + kk) * ldb + n] : 0.f;
                }
            }
            __syncthreads();
#pragma unroll
            for (int kk = 0; kk < 16; ++kk) {
                float a[4], b[4];
#pragma unroll
                for (int i = 0; i < 4; ++i) a[i] = sA[kk][ty * 4 + i];
#pragma unroll
                for (int j = 0; j < 4; ++j) b[j] = sB[kk][tx * 4 + j];
#pragma unroll
                for (int i = 0; i < 4; ++i)
#pragma unroll
                    for (int j = 0; j < 4; ++j) acc[i][j] += a[i] * b[j];
            }
            __syncthreads();
        }
#pragma unroll
        for (int i = 0; i < 4; ++i) {
            int m = m0 + ty * 4 + i;
#pragma unroll
            for (int j = 0; j < 4; ++j) {
                int n = n0 + tx * 4 + j;
                if (n < N) {
                    float* cp = C + (size_t)m * ldc + n;
                    *cp = accumulate ? (*cp + acc[i][j]) : acc[i][j];
                }
            }
        }
    }
}
__device__ __forceinline__ void ph_conv(const P& p, int layer) {
    const int tid_ = opaque_v((int)threadIdx.x); const int bid_ = opaque_s((int)blockIdx.x); (void)tid_; (void)bid_;
    const size_t n = (size_t)NT * CONVD;
    for (size_t i = (size_t)bid_ * NTHR + tid_; i < n; i += (size_t)gridDim.x * NTHR) {
        int t = (int)(i / CONVD), c = (int)(i % CONVD);
        const float* cw = p.conv_w + (size_t)layer * 4 * CONVD;
        float acc = p.conv_b[layer * CONVD + c];
        float raw = p.proj[(size_t)t * DIN + OFF_XBC + c];
        if (t < NPT) {
            int b = t / SEQ, l = t % SEQ;
#pragma unroll
            for (int k = 0; k < 4; ++k) {
                int ls = l + k - 3;
                if (ls >= 0) acc += p.proj[(size_t)(t + k - 3) * DIN + OFF_XBC + c] * cw[k * CONVD + c];
            }
            if (l >= SEQ - 3) p.out[O_CONVP + ((size_t)(layer * NB + b) * 3 + (l - (SEQ - 3))) * CONVD + c] = raw;
        } else {
            int bs = t - NPT;
            const float* prev = p.state_conv + ((size_t)(layer * NS + bs) * 3) * CONVD;
#pragma unroll
            for (int k = 0; k < 3; ++k) acc += prev[k * CONVD + c] * cw[k * CONVD + c];
            acc += raw * cw[3 * CONVD + c];
            float* oc = p.out + O_CONVS + ((size_t)(layer * NS + bs) * 3) * CONVD;
            oc[0 * CONVD + c] = prev[1 * CONVD + c];
            oc[1 * CONVD + c] = prev[2 * CONVD + c];
            oc[2 * CONVD + c] = raw;
        }
        p.xbc[(size_t)t * CONVD + c] = silu_f(acc);
    }
}
__device__ __forceinline__ void ph_dt(const P& p, int layer) {
    const int tid_ = opaque_v((int)threadIdx.x); const int bid_ = opaque_s((int)blockIdx.x); (void)tid_; (void)bid_;
    for (int i = bid_ * NTHR + tid_; i < NT * 16; i += gridDim.x * NTHR) {
        int t = i / 16, e = i % 16;
        float x = p.proj[(size_t)t * DIN + OFF_DT + e] + p.dt_bias[layer * 16 + e];
        p.dt[i] = (x > 20.f) ? x : log1pf(expf(x));
    }
}
__device__ __forceinline__ void ph_ssd_seq(const P& p, int layer) {
    const int tid_ = opaque_v((int)threadIdx.x); const int bid_ = opaque_s((int)blockIdx.x); (void)tid_; (void)bid_;
    VB_LOOP((NB + NS) * 16) {
        int seq = vb / 16, e = vb % 16, g = e / 8;
        int pp = tid_ >> 2, nq = tid_ & 3;
        float A = -expf(p.a_log[layer * 16 + e]);
        float Dk = p.d_skip[layer * 16 + e];
        float s[32];
        int t0, L;
        float* hout;
        if (seq < NB) {
            t0 = seq * SEQ; L = SEQ;
#pragma unroll
            for (int j = 0; j < 32; ++j) s[j] = 0.f;
            hout = p.out + O_SSMP + (((size_t)(layer * NB + seq) * 16 + e) * 64 + pp) * 128 + nq * 32;
        } else {
            int bs = seq - NB;
            t0 = NPT + bs; L = 1;
            const float* h0 = p.state_ssm + (((size_t)(layer * NS + bs) * 16 + e) * 64 + pp) * 128 + nq * 32;
#pragma unroll
            for (int j = 0; j < 32; ++j) s[j] = h0[j];
            hout = p.out + O_SSMS + (((size_t)(layer * NS + bs) * 16 + e) * 64 + pp) * 128 + nq * 32;
        }
        for (int l = 0; l < L; ++l) {
            int t = t0 + l;
            float dt = p.dt[t * 16 + e];
            float dA = expf(dt * A);
            const float* xr = p.xbc + (size_t)t * CONVD;
            float xv = xr[e * 64 + pp];
            float xdt = xv * dt;
            const float4* Bp = (const float4*)(xr + 1024 + g * 128 + nq * 32);
            const float4* Cp = (const float4*)(xr + 1280 + g * 128 + nq * 32);
            float ys = 0.f;
#pragma unroll
            for (int j4 = 0; j4 < 8; ++j4) {
                float4 b = Bp[j4], c = Cp[j4];
                s[j4 * 4 + 0] = s[j4 * 4 + 0] * dA + xdt * b.x; ys += c.x * s[j4 * 4 + 0];
                s[j4 * 4 + 1] = s[j4 * 4 + 1] * dA + xdt * b.y; ys += c.y * s[j4 * 4 + 1];
                s[j4 * 4 + 2] = s[j4 * 4 + 2] * dA + xdt * b.z; ys += c.z * s[j4 * 4 + 2];
                s[j4 * 4 + 3] = s[j4 * 4 + 3] * dA + xdt * b.w; ys += c.w * s[j4 * 4 + 3];
            }
            ys += __shfl_xor(ys, 1);
            ys += __shfl_xor(ys, 2);
            if (nq == 0) p.yraw[(size_t)t * DM + e * 64 + pp] = ys + Dk * xv;
        }
#pragma unroll
        for (int j = 0; j < 32; ++j) hout[j] = s[j];
    }
}
__device__ __forceinline__ void ph_gate_norm(const P& p, int layer) {
    const int tid_ = opaque_v((int)threadIdx.x); const int bid_ = opaque_s((int)blockIdx.x); (void)tid_; (void)bid_;
    VB_LOOP((NT * 2 + 3) / 4) {
        int w = vb * 4 + (tid_ >> 6);
        int lane = tid_ & 63;
        if (w < NT * 2) {
            int t = w >> 1, g = w & 1;
            float v[8];
            float ss = 0.f;
#pragma unroll
            for (int j = 0; j < 8; ++j) {
                int c = g * 512 + j * 64 + lane;
                float y = p.yraw[(size_t)t * DM + c];
                float z = p.proj[(size_t)t * DIN + OFF_Z + c];
                v[j] = y * silu_f(z);
                ss += v[j] * v[j];
            }
            ss = wave_sum(ss);
            float r = rsqrtf(ss / 512.f + EPSF);
#pragma unroll
            for (int j = 0; j < 8; ++j) {
                int c = g * 512 + j * 64 + lane;
                p.yn[(size_t)t * DM + c] = v[j] * r * p.ssm_norm[layer * DM + c];
            }
        }
    }
}
__device__ __forceinline__ void ph_mla_post(const P& p, int layer) {
    const int tid_ = opaque_v((int)threadIdx.x); const int bid_ = opaque_s((int)blockIdx.x); (void)tid_; (void)bid_;
    VB_LOOP((NT + 3) / 4) {
        int t = vb * 4 + (tid_ >> 6);
        int lane = tid_ & 63;
        if (t < NT) {
            int pi = (t < NPT) ? (t % SEQ) : 2048;
            const float* cs = p.rope + pi * 16;
            const float* sn = p.rope + 2049 * 16 + pi * 16;
#pragma unroll
            for (int r = 0; r < 2; ++r) {
                int id = lane + r * 64;
                int hh = id >> 4, j = id & 15;
                float* qp = p.q + (size_t)t * 768 + hh * 96 + 64;
                float x1 = qp[j], x2 = qp[16 + j];
                qp[j] = x1 * cs[j] - x2 * sn[j];
                qp[16 + j] = x1 * sn[j] + x2 * cs[j];
            }
            if (lane < 16) {
                const float* kr = p.proj + (size_t)t * DIN + OFF_KR;
                float x1 = kr[lane], x2 = kr[16 + lane];
                float o1 = x1 * cs[lane] - x2 * sn[lane];
                float o2 = x1 * sn[lane] + x2 * cs[lane];
                p.kpe[(size_t)t * 32 + lane] = o1;
                p.kpe[(size_t)t * 32 + 16 + lane] = o2;
                float* ok = (t < NPT) ? (p.out + O_KRP + ((size_t)layer * NPT + t) * 32) : (p.out + O_KRS + ((size_t)layer * NS + (t - NPT)) * 32);
                ok[lane] = o1; ok[16 + lane] = o2;
            }
            float* ol = (t < NPT) ? (p.out + O_LATP + ((size_t)layer * NPT + t) * KVL) : (p.out + O_LATS + ((size_t)layer * NS + (t - NPT)) * KVL);
#pragma unroll
            for (int r = 0; r < 4; ++r) ol[lane + r * 64] = p.lat[(size_t)t * KVL + lane + r * 64];
        }
    }
}
__device__ __forceinline__ void ph_attn_prompt(const P& p) {
    const int tid_ = opaque_v((int)threadIdx.x); const int bid_ = opaque_s((int)blockIdx.x); (void)tid_; (void)bid_;
    VB_LOOP(NB * 8 * SEQ / 256) {
        int gid = vb * 256 + tid_;
        int qi = gid % SEQ, bh = gid / SEQ;
        int h = bh % 8, b = bh / 8;
        int tq = b * SEQ + qi;
        float q[96];
        const float* qp = p.q + (size_t)tq * 768 + h * 96;
#pragma unroll
        for (int d = 0; d < 96; ++d) q[d] = qp[d] * ATT_SCALE;
        float acc[64];
#pragma unroll
        for (int d = 0; d < 64; ++d) acc[d] = 0.f;
        float m = -INFINITY, l = 0.f;
        int kmax = __shfl(qi, 63);
        for (int kk = 0; kk <= kmax; ++kk) {
            int tk = b * SEQ + kk;
            const float4* kn = (const float4*)(p.kv + (size_t)tk * 1024 + h * 128);
            const float4* kr = (const float4*)(p.kpe + (size_t)tk * 32);
            float s = 0.f;
#pragma unroll
            for (int d4 = 0; d4 < 16; ++d4) { float4 k4 = kn[d4]; s += q[d4 * 4] * k4.x + q[d4 * 4 + 1] * k4.y + q[d4 * 4 + 2] * k4.z + q[d4 * 4 + 3] * k4.w; }
#pragma unroll
            for (int d4 = 0; d4 < 8; ++d4) { float4 k4 = kr[d4]; s += q[64 + d4 * 4] * k4.x + q[64 + d4 * 4 + 1] * k4.y + q[64 + d4 * 4 + 2] * k4.z + q[64 + d4 * 4 + 3] * k4.w; }
            if (kk <= qi) {
                float mn = fmaxf(m, s);
                float corr = expf(m - mn);
                float pe = expf(s - mn);
                l = l * corr + pe;
                const float4* vp = (const float4*)(p.kv + (size_t)tk * 1024 + h * 128 + 64);
#pragma unroll
                for (int d4 = 0; d4 < 16; ++d4) {
                    float4 v4 = vp[d4];
                    acc[d4 * 4 + 0] = acc[d4 * 4 + 0] * corr + pe * v4.x;
                    acc[d4 * 4 + 1] = acc[d4 * 4 + 1] * corr + pe * v4.y;
                    acc[d4 * 4 + 2] = acc[d4 * 4 + 2] * corr + pe * v4.z;
                    acc[d4 * 4 + 3] = acc[d4 * 4 + 3] * corr + pe * v4.w;
                }
                m = mn;
            }
        }
        float inv = 1.f / l;
        float* op = p.o + (size_t)tq * 512 + h * 64;
#pragma unroll
        for (int d = 0; d < 64; ++d) op[d] = acc[d] * inv;
    }
}
__device__ __forceinline__ void ph_qlat(const P& p, int layer) {
    const int tid_ = opaque_v((int)threadIdx.x); const int bid_ = opaque_s((int)blockIdx.x); (void)tid_; (void)bid_;
    VB_LOOP(NS * 8) {
        int bs = vb / 8, h = vb % 8;
        int r = tid_;
        const float* qp = p.q + (size_t)(NPT + bs) * 768 + h * 96;
        const float* w = p.w_kvb + (size_t)layer * 256 * 1024 + (size_t)r * 1024 + h * 128;
        float s = 0.f;
        for (int d = 0; d < 64; ++d) s += qp[d] * w[d];
        p.qlat[((size_t)bs * 8 + h) * 256 + r] = s * ATT_SCALE;
    }
}
__device__ __forceinline__ void ph_decode_part(const P& p, int layer) {
    const int tid_ = opaque_v((int)threadIdx.x); const int bid_ = opaque_s((int)blockIdx.x); (void)tid_; (void)bid_;
    __shared__ float sq[8][288];
    __shared__ float ss[8][128];
    __shared__ float sm[8], sl[8];
    VB_LOOP(NS * 129) {
        int bs = vb / 129, ch = vb % 129;
        int tid = tid_, lane = tid & 63, wv = tid >> 6;
        for (int i = tid; i < 8 * 288; i += 256) {
            int h = i / 288, d = i % 288;
            sq[h][d] = (d < 256) ? p.qlat[((size_t)bs * 8 + h) * 256 + d] : p.q[(size_t)(NPT + bs) * 768 + h * 96 + 64 + (d - 256)] * ATT_SCALE;
        }
        __syncthreads();
        int nkeys = (ch < 128) ? 128 : 1;
        const float* latb; const float* krb;
        if (ch < 128) {
            int pg = p.page_table[bs * NPAGES + ch];
            latb = p.cache_lat + ((size_t)layer * NPOOL + pg) * PAGE * KVL;
            krb = p.cache_kr + ((size_t)layer * NPOOL + pg) * PAGE * 32;
        } else {
            latb = p.lat + (size_t)(NPT + bs) * KVL;
            krb = p.kpe + (size_t)(NPT + bs) * 32;
        }
        for (int k = wv; k < nkeys; k += 4) {
            float4 kv4 = *(const float4*)(latb + (size_t)k * KVL + lane * 4);
            float kr = (lane < 32) ? krb[(size_t)k * 32 + lane] : 0.f;
            float sh[8];
#pragma unroll
            for (int h = 0; h < 8; ++h) {
                float s = sq[h][lane * 4] * kv4.x + sq[h][lane * 4 + 1] * kv4.y + sq[h][lane * 4 + 2] * kv4.z + sq[h][lane * 4 + 3] * kv4.w;
                if (lane < 32) s += sq[h][256 + lane] * kr;
                sh[h] = wave_sum(s);
            }
            if (lane == 0) {
#pragma unroll
                for (int h = 0; h < 8; ++h) ss[h][k] = sh[h];
            }
        }
        __syncthreads();
        for (int hh = 0; hh < 2; ++hh) {
            int h = wv * 2 + hh;
            float v0 = (lane < nkeys) ? ss[h][lane] : -INFINITY;
            float v1 = (lane + 64 < nkeys) ? ss[h][lane + 64] : -INFINITY;
            float m = wave_max(fmaxf(v0, v1));
            float p0 = (lane < nkeys) ? expf(v0 - m) : 0.f;
            float p1 = (lane + 64 < nkeys) ? expf(v1 - m) : 0.f;
            float l = wave_sum(p0 + p1);
            if (lane < nkeys) ss[h][lane] = p0;
            if (lane + 64 < nkeys) ss[h][lane + 64] = p1;
            if (lane == 0) { sm[h] = m; sl[h] = l; }
        }
        __syncthreads();
        float acc[8];
#pragma unroll
        for (int h = 0; h < 8; ++h) acc[h] = 0.f;
        for (int k = 0; k < nkeys; ++k) {
            float v = latb[(size_t)k * KVL + tid];
#pragma unroll
            for (int h = 0; h < 8; ++h) acc[h] += ss[h][k] * v;
        }
        float* pp = p.part + ((size_t)bs * 129 + ch) * 8 * 258;
#pragma unroll
        for (int h = 0; h < 8; ++h) pp[h * 258 + 2 + tid] = acc[h];
        if (tid < 8) { pp[tid * 258 + 0] = sm[tid]; pp[tid * 258 + 1] = sl[tid]; }
        __syncthreads();
    }
}
__device__ __forceinline__ void ph_decode_comb(const P& p, int layer) {
    const int tid_ = opaque_v((int)threadIdx.x); const int bid_ = opaque_s((int)blockIdx.x); (void)tid_; (void)bid_;
    __shared__ float sw[129];
    __shared__ float so[256];
    __shared__ float sL;
    VB_LOOP(NS * 8) {
        int bs = vb / 8, h = vb % 8, tid = tid_;
        const float* pb = p.part + (size_t)bs * 129 * 8 * 258 + h * 258;
        if (tid < 64) {
            float m = -INFINITY;
            for (int c = tid; c < 129; c += 64) m = fmaxf(m, pb[(size_t)c * 8 * 258]);
            m = wave_max(m);
            float l = 0.f;
            for (int c = tid; c < 129; c += 64) {
                float w = expf(pb[(size_t)c * 8 * 258] - m);
                sw[c] = w;
                l += w * pb[(size_t)c * 8 * 258 + 1];
            }
            l = wave_sum(l);
            if (tid == 0) sL = l;
        }
        __syncthreads();
        float a = 0.f;
        for (int c = 0; c < 129; ++c) a += sw[c] * pb[(size_t)c * 8 * 258 + 2 + tid];
        so[tid] = a / sL;
        __syncthreads();
        if (tid < 64) {
            const float* w = p.w_kvb + (size_t)layer * 256 * 1024 + h * 128 + 64 + tid;
            float s = 0.f;
            for (int r = 0; r < 256; ++r) s += so[r] * w[(size_t)r * 1024];
            p.o[(size_t)(NPT + bs) * 512 + h * 64 + tid] = s;
        }
        __syncthreads();
    }
}
__device__ __forceinline__ void ph_mix(const P& p, int layer) {
    const int tid_ = opaque_v((int)threadIdx.x); const int bid_ = opaque_s((int)blockIdx.x); (void)tid_; (void)bid_;
    const size_t n = (size_t)NT * DM;
    for (size_t i = (size_t)bid_ * NTHR + tid_; i < n; i += (size_t)gridDim.x * NTHR) {
        int t = (int)(i / DM), c = (int)(i % DM);
        float ga = sigmoid_f(p.proj[(size_t)t * DIN + OFF_GA + c] + p.b_gate[layer * 2048 + c]);
        float gb = sigmoid_f(p.proj[(size_t)t * DIN + OFF_GB + c] + p.b_gate[layer * 2048 + 1024 + c]);
        p.mix[i] = ga * p.ya[i] + gb * p.yb[i];
    }
}
__device__ __forceinline__ void ph_peer_scores(const P& p, int layer) {
    const int tid_ = opaque_v((int)threadIdx.x); const int bid_ = opaque_s((int)blockIdx.x); (void)tid_; (void)bid_;
    __shared__ float sq[256];
    VB_LOOP(NT * 8) {
        int t = vb / 8, hh = (vb % 8) * 2 + (tid_ >> 7), k = tid_ & 127;
        sq[tid_] = p.pq[(size_t)t * 2048 + hh * 128 + k];
        __syncthreads();
        const float* sqq = sq + (tid_ >> 7) * 128;
        const float4* kp = (const float4*)(p.peer_keys + ((size_t)(layer * 16 + hh) * 128 + k) * 128);
        float s = 0.f;
#pragma unroll 8
        for (int d4 = 0; d4 < 32; ++d4) { float4 v = kp[d4]; s += sqq[d4 * 4] * v.x + sqq[d4 * 4 + 1] * v.y + sqq[d4 * 4 + 2] * v.z + sqq[d4 * 4 + 3] * v.w; }
        p.sc[(size_t)t * 2048 + hh * 128 + k] = s;
        __syncthreads();
    }
}
__device__ __forceinline__ void wave_argmax(float& v, int& i) {
#pragma unroll
    for (int o = 32; o > 0; o >>= 1) {
        float ov = __shfl_xor(v, o);
        int oi = __shfl_xor(i, o);
        if (ov > v || (ov == v && oi < i)) { v = ov; i = oi; }
    }
}
__device__ __forceinline__ void ph_peer_topk(const P& p) {
    const int tid_ = opaque_v((int)threadIdx.x); const int bid_ = opaque_s((int)blockIdx.x); (void)tid_; (void)bid_;
    VB_LOOP((NT * 8 + 3) / 4) {
        int w = vb * 4 + (tid_ >> 6);
        int lane = tid_ & 63;
        if (w < NT * 8) {
            int t = w / 8, h = w % 8;
            float topv0 = 0.f, topv1 = 0.f;
            int topi0 = 0, topi1 = 0;
#pragma unroll
            for (int half = 0; half < 2; ++half) {
                const float* sp = p.sc + (size_t)t * 2048 + (h * 2 + half) * 128;
                float a0 = sp[lane], a1 = sp[lane + 64];
                float tv = 0.f; int ti = 0;
                for (int r = 0; r < 16; ++r) {
                    float v; int i;
                    if (a0 >= a1) { v = a0; i = lane; } else { v = a1; i = lane + 64; }
                    wave_argmax(v, i);
                    if (i == lane) a0 = -INFINITY;
                    if (i == lane + 64) a1 = -INFINITY;
                    if (lane == r) { tv = v; ti = i; }
                }
                if (half == 0) { topv0 = tv; topi0 = ti; } else { topv1 = tv; topi1 = ti; }
            }
            float cv0, cv1, cv2, cv3;
            {
                float va = __shfl(topv0, lane >> 2);
                int b0 = (lane & 3) * 4;
                cv0 = va + __shfl(topv1, b0 + 0);
                cv1 = va + __shfl(topv1, b0 + 1);
                cv2 = va + __shfl(topv1, b0 + 2);
                cv3 = va + __shfl(topv1, b0 + 3);
            }
            float selv = 0.f; int selc = 0;
            for (int r = 0; r < 16; ++r) {
                float v = cv0; int c = lane * 4;
                if (cv1 > v) { v = cv1; c = lane * 4 + 1; }
                if (cv2 > v) { v = cv2; c = lane * 4 + 2; }
                if (cv3 > v) { v = cv3; c = lane * 4 + 3; }
                wave_argmax(v, c);
                if (c == lane * 4 + 0) cv0 = -INFINITY;
                if (c == lane * 4 + 1) cv1 = -INFINITY;
                if (c == lane * 4 + 2) cv2 = -INFINITY;
                if (c == lane * 4 + 3) cv3 = -INFINITY;
                if (lane == r) { selv = v; selc = c; }
            }
            float mx = __shfl(selv, 0);
            float e = (lane < 16) ? expf(selv - mx) : 0.f;
            float sum = wave_sum(e);
            int ia = __shfl(topi0, selc >> 4);
            int ib = __shfl(topi1, selc & 15);
            if (lane < 16) {
                p.idx[(size_t)t * 128 + h * 16 + lane] = ia * 128 + ib;
                p.gate[(size_t)t * 128 + h * 16 + lane] = e / sum;
            }
        }
    }
}
__device__ __forceinline__ void ph_peer_experts(const P& p, int layer) {
    const int tid_ = opaque_v((int)threadIdx.x); const int bid_ = opaque_s((int)blockIdx.x); (void)tid_; (void)bid_;
    __shared__ float sh[1024];
    __shared__ float sw[128];
    __shared__ int si[128];
    VB_LOOP(NT) {
        int t = vb, tid = tid_, lane = tid & 63, wv = tid >> 6;
        for (int i = tid; i < 1024; i += 256) sh[i] = p.h[(size_t)t * DM + i];
        if (tid < 128) si[tid] = p.idx[(size_t)t * 128 + tid];
        __syncthreads();
        const float* U = p.peer_u + (size_t)layer * NEXP * DM;
        const float* V = p.peer_v + (size_t)layer * NEXP * DM;
        for (int k = wv; k < 128; k += 4) {
            const float4* up = (const float4*)(U + (size_t)si[k] * DM);
            float s = 0.f;
#pragma unroll
            for (int r = 0; r < 4; ++r) {
                float4 u4 = up[r * 64 + lane];
                int d = (r * 64 + lane) * 4;
                s += u4.x * sh[d] + u4.y * sh[d + 1] + u4.z * sh[d + 2] + u4.w * sh[d + 3];
            }
            s = wave_sum(s);
            if (lane == 0) {
                float act = 0.5f * s * (1.f + erff(s * 0.70710678118654752f));
                sw[k] = p.gate[(size_t)t * 128 + k] * act;
            }
        }
        __syncthreads();
        float4 acc = make_float4(0.f, 0.f, 0.f, 0.f);
        for (int k = 0; k < 128; ++k) {
            float4 v4 = *(const float4*)(V + (size_t)si[k] * DM + tid * 4);
            float w = sw[k];
            acc.x += w * v4.x; acc.y += w * v4.y; acc.z += w * v4.z; acc.w += w * v4.w;
        }
        float4* xp = (float4*)(p.xres + (size_t)t * DM + tid * 4);
        float4 xv = *xp;
        xv.x += acc.x; xv.y += acc.y; xv.z += acc.z; xv.w += acc.w;
        *xp = xv;
        __syncthreads();
    }
}

#define BAR() xcd_barrier(bar)

__global__ void __launch_bounds__(256, 2) k_fwd(P p) {
    __shared__ uint4 xb_words;
    if (threadIdx.x == 0) xb_words = make_uint4(0u, 0u, 0u, 0u);
    __syncthreads();
    XcdBarrier bar = xcd_barrier_post(p.bar, (volatile LAS unsigned*)&xb_words);

    ph_rope_table(p);
    ph_copy_x(p);
    BAR();
#pragma unroll 1
    for (int l = 0; l < DEPTH; ++l) {
        ph_rmsnorm(p.xres, DM, p.norm_mix + l * DM, p.h, DM, DM, TP);
        BAR();
        ph_gemm(p.h, DM, p.w_in + (size_t)l * DM * DIN, DIN, p.proj, DIN, TP, DIN, DM, 0);
        BAR();
        ph_conv(p, l);
        ph_dt(p, l);
        ph_rmsnorm(p.proj + OFF_CQ, DIN, p.q_norm + l * QL, p.qn, QL, QL, TP);
        ph_rmsnorm(p.proj + OFF_CKV, DIN, p.kv_norm + l * KVL, p.lat, KVL, KVL, TP);
        BAR();
        ph_ssd_seq(p, l);
        ph_gemm(p.qn, QL, p.w_qb + (size_t)l * QL * 768, 768, p.q, 768, TP, 768, QL, 0);
        ph_gemm(p.lat, KVL, p.w_kvb + (size_t)l * KVL * 1024, 1024, p.kv, 1024, TP, 1024, KVL, 0);
        BAR();
        ph_mla_post(p, l);
        ph_gate_norm(p, l);
        BAR();
        ph_attn_prompt(p);
        ph_qlat(p, l);
        ph_gemm(p.yn, DM, p.w_ssm_proj + (size_t)l * DM * DM, DM, p.ya, DM, TP, DM, DM, 0);
        BAR();
        ph_decode_part(p, l);
        BAR();
        ph_decode_comb(p, l);
        BAR();
        ph_gemm(p.o, 512, p.w_mla_proj + (size_t)l * 512 * DM, DM, p.yb, DM, TP, DM, 512, 0);
        BAR();
        ph_mix(p, l);
        BAR();
        ph_gemm(p.mix, DM, p.w_out + (size_t)l * DM * DM, DM, p.xres, DM, TP, DM, DM, 1);
        BAR();
        ph_rmsnorm(p.xres, DM, p.norm_ffn + l * DM, p.h, DM, DM, TP);
        BAR();
        ph_gemm(p.h, DM, p.peer_wq + (size_t)l * DM * 2048, 2048, p.pq, 2048, TP, 2048, DM, 0);
        BAR();
        ph_peer_scores(p, l);
        BAR();
        ph_peer_topk(p);
        BAR();
        ph_peer_experts(p, l);
        BAR();
    }
    ph_rmsnorm(p.xres, DM, p.norm_final, p.out + O_YP, DM, DM, NT);
}

static inline float* carve(char*& cur, size_t nfloats) {
    float* r = (float*)cur;
    cur += ((nfloats * 4 + 255) / 256) * 256;
    return r;
}

extern "C" void kernel_launch(void* const* d_in, const int* in_sizes, int n_in,
                              void* d_out, int out_size, void* d_ws, size_t ws_size,
                              hipStream_t stream) {
    P p{};
    p.x_prompt = (const float*)d_in[0]; p.x_sample = (const float*)d_in[1];
    p.cache_lat = (const float*)d_in[2]; p.cache_kr = (const float*)d_in[3];
    p.state_ssm = (const float*)d_in[4]; p.state_conv = (const float*)d_in[5];
    p.page_table = (const int*)d_in[6];
    p.norm_mix = (const float*)d_in[7]; p.w_in = (const float*)d_in[8]; p.b_gate = (const float*)d_in[9];
    p.conv_w = (const float*)d_in[10]; p.conv_b = (const float*)d_in[11]; p.dt_bias = (const float*)d_in[12];
    p.a_log = (const float*)d_in[13]; p.d_skip = (const float*)d_in[14]; p.ssm_norm = (const float*)d_in[15];
    p.w_ssm_proj = (const float*)d_in[16]; p.q_norm = (const float*)d_in[17]; p.w_qb = (const float*)d_in[18];
    p.kv_norm = (const float*)d_in[19]; p.w_kvb = (const float*)d_in[20]; p.w_mla_proj = (const float*)d_in[21];
    p.w_out = (const float*)d_in[22]; p.norm_ffn = (const float*)d_in[23]; p.peer_wq = (const float*)d_in[24];
    p.peer_keys = (const float*)d_in[25]; p.peer_u = (const float*)d_in[26]; p.peer_v = (const float*)d_in[27];
    p.norm_final = (const float*)d_in[28];
    p.out = (float*)d_out;
    char* cur = (char*)d_ws;
    p.bar = (unsigned*)carve(cur, XCD_BAR_WORDS);
    p.xres = carve(cur, (size_t)TP * DM);
    p.h = carve(cur, (size_t)TP * DM);
    p.proj = carve(cur, (size_t)TP * DIN);
    p.xbc = carve(cur, (size_t)TP * CONVD);
    p.dt = carve(cur, (size_t)TP * 16);
    p.yraw = carve(cur, (size_t)TP * DM);
    p.yn = carve(cur, (size_t)TP * DM);
    p.ya = carve(cur, (size_t)TP * DM);
    p.qn = carve(cur, (size_t)TP * QL);
    p.q = carve(cur, (size_t)TP * 768);
    p.lat = carve(cur, (size_t)TP * KVL);
    p.kpe = carve(cur, (size_t)TP * 32);
    p.kv = carve(cur, (size_t)TP * 1024);
    p.o = carve(cur, (size_t)TP * 512);
    p.yb = carve(cur, (size_t)TP * DM);
    p.mix = carve(cur, (size_t)TP * DM);
    p.pq = carve(cur, (size_t)TP * 2048);
    p.sc = carve(cur, (size_t)TP * 2048);
    p.gate = carve(cur, (size_t)TP * 128);
    p.part = carve(cur, (size_t)NS * 129 * 8 * 258);
    p.qlat = carve(cur, (size_t)NS * 8 * 256);
    p.rope = carve(cur, (size_t)2 * 2049 * 16);
    p.idx = (int*)carve(cur, (size_t)TP * 128);

    (void)hipMemsetAsync(d_ws, 0, (size_t)(cur - (char*)d_ws), stream);

    static int grid = 0;
    if (!grid) {
        int dev = 0, cus = 0, per_cu = 0;
        (void)hipGetDevice(&dev);
        (void)hipDeviceGetAttribute(&cus, hipDeviceAttributeMultiprocessorCount, dev);
        (void)hipOccupancyMaxActiveBlocksPerMultiprocessor(&per_cu, k_fwd, 256, 0);
        if (per_cu > 2) per_cu = 2;
        if (per_cu < 1) per_cu = 1;
        grid = cus * per_cu;
    }
    k_fwd<<<grid, 256, 0, stream>>>(p);
}
```

```cpp
#include <hip/hip_runtime.h>
#include <stdint.h>

#define DM 1024
#define NB 8
#define SEQ 2048
#define NPT (NB * SEQ)
#define NS 32
#define NT (NPT + NS)
#define TP 16512
#define DEPTH 2
#define PAST 16384
#define PAGE 128
#define NPAGES 128
#define NPOOL 5120
#define DIN 5296
#define OFF_GA 0
#define OFF_GB 1024
#define OFF_Z 2048
#define OFF_XBC 3072
#define OFF_DT 4608
#define OFF_CQ 4624
#define OFF_CKV 5008
#define OFF_KR 5264
#define CONVD 1536
#define QL 384
#define KVL 256
#define NEXP 16384
#define EPSF 1e-6f
#define ATT_SCALE 0.10206207261596577f

#define O_YP 0
#define O_YS (O_YP + NPT * DM)
#define O_LATP (O_YS + NS * DM)
#define O_KRP (O_LATP + DEPTH * NPT * KVL)
#define O_SSMP (O_KRP + DEPTH * NPT * 32)
#define O_CONVP (O_SSMP + DEPTH * NB * 16 * 64 * 128)
#define O_LATS (O_CONVP + DEPTH * NB * 3 * CONVD)
#define O_KRS (O_LATS + DEPTH * NS * KVL)
#define O_SSMS (O_KRS + DEPTH * NS * 32)
#define O_CONVS (O_SSMS + DEPTH * NS * 16 * 64 * 128)

struct P {
    const float *x_prompt, *x_sample, *cache_lat, *cache_kr, *state_ssm, *state_conv;
    const int* page_table;
    const float *norm_mix, *w_in, *b_gate, *conv_w, *conv_b, *dt_bias, *a_log, *d_skip, *ssm_norm, *w_ssm_proj;
    const float *q_norm, *w_qb, *kv_norm, *w_kvb, *w_mla_proj, *w_out, *norm_ffn, *peer_wq, *peer_keys, *peer_u, *peer_v, *norm_final;
    float* out;
    float *xres, *h, *proj, *xbc, *dt, *yraw, *yn, *ya, *qn, *q, *lat, *kpe, *kv, *o, *yb, *mix, *pq, *sc, *gate, *part, *qlat, *rope;
    int* idx;
    unsigned* bar;
    unsigned short *hb, *ynb, *qnb, *latb, *ob, *mixb, *qb, *kn, *kpeb, *vT, *xbcb;
    unsigned short *wt_in, *wt_ssm, *wt_qb, *wt_kvb, *wt_mla, *wt_out, *wt_pq, *wqb, *keysb, *ub, *vb;
};

#define XB_TMO      128
#define XB_XCNT(j)  (256  + 64 * (j))
#define XB_XSUB(j)  (1280 + 64 * (j))
#define XB_XGEN(j)  (2304 + 64 * (j))
#define XB_TOP      3328
#define XB_TOPGEN   3392
#define XCD_BAR_WORDS 3456
#define XB_SPIN_CAP (1u << 18)
#define LAS __attribute__((address_space(3)))

__device__ __forceinline__ unsigned xb_ld(unsigned* p)              { return __hip_atomic_load(p, __ATOMIC_RELAXED, __HIP_MEMORY_SCOPE_AGENT); }
__device__ __forceinline__ unsigned xb_add(unsigned* p, unsigned v) { return __hip_atomic_fetch_add(p, v, __ATOMIC_RELAXED, __HIP_MEMORY_SCOPE_AGENT); }
__device__ __forceinline__ unsigned xb_xcc_id() { return (unsigned)__builtin_amdgcn_s_getreg((3 << 11) | 20) & 0xFu; }
#define XB_SPIN(cond, bar) do { unsigned _sp = 0; while (cond) { __builtin_amdgcn_s_sleep(1); \
    if ((++_sp & 255u) == 0u) { if (xb_ld(&(bar)[XB_TMO])) break; if (_sp > XB_SPIN_CAP) { atomicAdd(&(bar)[XB_TMO], 1u); break; } } } } while (0)

struct XcdBarrier {
    unsigned* bar; unsigned x;
    volatile LAS unsigned* st;
};

__device__ __forceinline__ XcdBarrier xcd_barrier_post(unsigned* bar, volatile LAS unsigned* st) {
    XcdBarrier b; b.bar = bar; b.x = xb_xcc_id(); b.st = st;
    if (threadIdx.x == 0) (void)xb_add(&bar[XB_XCNT(b.x)], 1u);
    return b;
}
__device__ __forceinline__ void xcd_barrier_complete(unsigned* bar, unsigned x, unsigned& nloc, unsigned& nx) {
    const unsigned G = gridDim.x * gridDim.y * gridDim.z;
    unsigned sum, cnt, mine, sp = 0u;
    for (;;) {
        sum = 0u; cnt = 0u; mine = 0u;
#pragma unroll
        for (unsigned j = 0; j < 16; ++j) { const unsigned c = xb_ld(&bar[XB_XCNT(j)]); sum += c; cnt += (c > 0u) ? 1u : 0u; mine = (j == x) ? c : mine; }
        if (sum == G) break;
        __builtin_amdgcn_s_sleep(1);
        if ((++sp & 255u) == 0u) { if (xb_ld(&bar[XB_TMO])) break; if (sp > XB_SPIN_CAP) { atomicAdd(&bar[XB_TMO], 1u); break; } }
    }
    nloc = mine > 0u ? mine : 1u; nx = cnt > 0u ? cnt : 1u;
}

__device__ __forceinline__ void xcd_barrier(const XcdBarrier& b) {
    asm volatile("s_waitcnt vmcnt(0)" ::: "memory");
    __syncthreads();
    if (threadIdx.x == 0) {
        unsigned* bar = b.bar;
        __builtin_amdgcn_s_waitcnt(0);
        unsigned nloc = b.st[0], nx = b.st[1];
        if (nloc == 0u) { xcd_barrier_complete(bar, b.x, nloc, nx); b.st[0] = nloc; b.st[1] = nx; }
        const unsigned old = xb_add(&bar[XB_XSUB(b.x)], 1u);
        const unsigned gen = old / nloc;
        if (old + 1u == (gen + 1u) * nloc) {
            __builtin_amdgcn_fence(__ATOMIC_RELEASE, "agent");
            asm volatile("s_waitcnt vmcnt(0)" ::: "memory");
            const unsigned og = xb_add(&bar[XB_TOP], 1u);
            const unsigned tg = og / nx;
            if (og + 1u == (tg + 1u) * nx) xb_add(&bar[XB_TOPGEN], 1u);
            else XB_SPIN(xb_ld(&bar[XB_TOPGEN]) == tg, bar);
            __builtin_amdgcn_fence(__ATOMIC_ACQUIRE, "agent");
            xb_add(&bar[XB_XGEN(b.x)], 1u);
            asm volatile("s_waitcnt vmcnt(0)" ::: "memory");
        } else {
            XB_SPIN(xb_ld(&bar[XB_XGEN(b.x)]) == gen, bar);
            __builtin_amdgcn_fence(__ATOMIC_ACQUIRE, "agent");
            asm volatile("s_waitcnt vmcnt(0)" ::: "memory");
        }
    }
    __syncthreads();
}


__device__ __forceinline__ float wave_sum(float v) {
#pragma unroll
    for (int o = 32; o > 0; o >>= 1) v += __shfl_xor(v, o);
    return v;
}
__device__ __forceinline__ float wave_max(float v) {
#pragma unroll
    for (int o = 32; o > 0; o >>= 1) v = fmaxf(v, __shfl_xor(v, o));
    return v;
}
__device__ __forceinline__ float silu_f(float x) { return x / (1.f + expf(-x)); }
__device__ __forceinline__ float sigmoid_f(float x) { return 1.f / (1.f + expf(-x)); }


__device__ __forceinline__ int opaque_v(int x) { asm volatile("" : "+v"(x)); return x; }
__device__ __forceinline__ int opaque_s(int x) { asm volatile("" : "+s"(x)); return x; }
#define NTHR 256
#define VB_LOOP(n) for (int vb = bid_; vb < (n); vb += gridDim.x)


typedef unsigned short bf16_t;
using bf16x8 = __attribute__((ext_vector_type(8))) short;
using f32x4 = __attribute__((ext_vector_type(4))) float;
typedef __attribute__((ext_vector_type(2))) __bf16 bf16x2_t;
__device__ __forceinline__ bf16_t f2bf(float f) { __bf16 h = (__bf16)f; return __builtin_bit_cast(unsigned short, h); }
__device__ __forceinline__ unsigned pack_bf16(float a, float b) { bf16x2_t r; r[0] = (__bf16)a; r[1] = (__bf16)b; return __builtin_bit_cast(unsigned, r); }
__device__ __forceinline__ float bf2f(bf16_t h) { return __uint_as_float(((unsigned)h) << 16); }

__device__ __forceinline__ int lds_byte(int r, int c) {
    int st = (r >> 4) * 2 + (c >> 5), rr = r & 15, cc = c & 31, ob = rr * 64 + cc * 2;
    return st * 1024 + (ob ^ (((ob >> 9) & 1) << 5));
}
__device__ __forceinline__ void stage_rc(int b, int& R, int& C) {
    int st = b / 1024, sb = b % 1024, swz = sb ^ (((sb >> 9) & 1) << 5);
    R = (st >> 1) * 16 + swz / 64; C = (st & 1) * 32 + (swz % 64) / 2;
}
__device__ __forceinline__ void stage_tile(const bf16_t* base, int ld, int row0, int k0, char* dst, int tid) {
#pragma unroll
    for (int i = 0; i < 4; ++i) {
        int b = tid * 16 + i * 4096;
        int R, C; stage_rc(b, R, C);
        const bf16_t* src = base + (size_t)(row0 + R) * ld + k0 + C;
        __builtin_amdgcn_global_load_lds((const unsigned*)src, (unsigned*)(dst + b), 16, 0, 0);
    }
}
template <class Epi>
__device__ __forceinline__ void gemm_bf16(const bf16_t* A, int lda, const bf16_t* Bt, int ldb, int mtiles, int ntiles, int K, char* smem, Epi epi, int vb0 = 0) {
    const int tid = opaque_v((int)threadIdx.x);
    int bid0 = (int)blockIdx.x - vb0;
    while (bid0 < 0) bid0 += (int)gridDim.x;
    const int bid = opaque_s(__builtin_amdgcn_readfirstlane(bid0));
    const int wid = tid >> 6, lane = tid & 63, wm = wid >> 1, wn = wid & 1, fr = lane & 15, fq = lane >> 4;
    const int nk = K / 64;
    for (int vb = bid; vb < mtiles * ntiles; vb += gridDim.x) {
        const int m0 = (vb / ntiles) * 128, n0 = (vb % ntiles) * 128;
        f32x4 acc[4][4];
#pragma unroll
        for (int i = 0; i < 4; ++i)
#pragma unroll
            for (int j = 0; j < 4; ++j) acc[i][j] = f32x4{0.f, 0.f, 0.f, 0.f};
        stage_tile(A, lda, m0, 0, smem, tid);
        stage_tile(Bt, ldb, n0, 0, smem + 16384, tid);
        for (int kt = 0; kt < nk; ++kt) {
            asm volatile("s_waitcnt vmcnt(0)" ::: "memory");
            __syncthreads();
            if (kt + 1 < nk) {
                char* nb = smem + ((kt + 1) & 1) * 32768;
                stage_tile(A, lda, m0, (kt + 1) * 64, nb, tid);
                stage_tile(Bt, ldb, n0, (kt + 1) * 64, nb + 16384, tid);
            }
            const char* ab = smem + (kt & 1) * 32768;
            const char* bb = ab + 16384;
#pragma unroll
            for (int s = 0; s < 2; ++s) {
                bf16x8 a[4], b[4];
#pragma unroll
                for (int i = 0; i < 4; ++i) a[i] = *reinterpret_cast<const bf16x8*>(ab + lds_byte(wm * 64 + i * 16 + fr, s * 32 + fq * 8));
#pragma unroll
                for (int j = 0; j < 4; ++j) b[j] = *reinterpret_cast<const bf16x8*>(bb + lds_byte(wn * 64 + j * 16 + fr, s * 32 + fq * 8));
#pragma unroll
                for (int i = 0; i < 4; ++i)
#pragma unroll
                    for (int j = 0; j < 4; ++j) acc[i][j] = __builtin_amdgcn_mfma_f32_16x16x32_bf16(a[i], b[j], acc[i][j], 0, 0, 0);
            }
        }
#pragma unroll
        for (int i = 0; i < 4; ++i)
#pragma unroll
            for (int j = 0; j < 4; ++j)
#pragma unroll
                for (int r = 0; r < 4; ++r) epi(m0 + wm * 64 + i * 16 + fq * 4 + r, n0 + wn * 64 + j * 16 + fr, acc[i][j][r]);
        __syncthreads();
    }
}
struct EpiStore { float* C; int ldc; int N; __device__ __forceinline__ void operator()(int m, int n, float v) const { if (n < N) C[(size_t)m * ldc + n] = v; } };
struct EpiAccum { float* C; int ldc; __device__ __forceinline__ void operator()(int m, int n, float v) const { C[(size_t)m * ldc + n] += v; } };

__device__ __forceinline__ void ph_convert_plain(const float* src, bf16_t* dst, size_t n) {
    const int tid = opaque_v((int)threadIdx.x); const int bid = opaque_s((int)blockIdx.x);
    for (size_t i = ((size_t)bid * NTHR + tid) * 4; i < n; i += (size_t)gridDim.x * NTHR * 4) {
        float4 v = *(const float4*)(src + i);
        ushort4 o; o.x = f2bf(v.x); o.y = f2bf(v.y); o.z = f2bf(v.z); o.w = f2bf(v.w);
        *(ushort4*)(dst + i) = o;
    }
}
struct EpiStoreBf { bf16_t* C; int ldc; __device__ __forceinline__ void operator()(int m, int n, float v) const { C[(size_t)m * ldc + n] = f2bf(v); } };
__device__ __forceinline__ void ph_convert_w(const float* W, int K, int N, int Npad, bf16_t* Bt, char* smem) {
    const int tid = opaque_v((int)threadIdx.x); const int bid = opaque_s((int)blockIdx.x);
    float (*t)[65] = (float (*)[65])smem;
    int tk = K / 64, tn = Npad / 64;
    for (int vb = bid; vb < tk * tn; vb += gridDim.x) {
        int k0 = (vb % tk) * 64, n0 = (vb / tk) * 64;
        for (int i = tid; i < 64 * 64; i += NTHR) {
            int kk = i >> 6, nn = i & 63;
            t[kk][nn] = (n0 + nn < N) ? W[(size_t)(k0 + kk) * N + n0 + nn] : 0.f;
        }
        __syncthreads();
        for (int i = tid; i < 64 * 64; i += NTHR) {
            int nn = i >> 6, kk = i & 63;
            Bt[(size_t)(n0 + nn) * K + k0 + kk] = f2bf(t[kk][nn]);
        }
        __syncthreads();
    }
}

__device__ __forceinline__ void ph_rope_table(const P& p) {
    const int tid_ = opaque_v((int)threadIdx.x); const int bid_ = opaque_s((int)blockIdx.x); (void)tid_; (void)bid_;
    for (int i = bid_ * NTHR + tid_; i < 2049 * 16; i += gridDim.x * NTHR) {
        int pi = i / 16, j = i % 16;
        float pos = (pi == 2048) ? 16384.f : (float)pi;
        float inv = powf(10000.f, -(float)j / 16.f);
        float ang = pos * inv;
        p.rope[i] = (float)cos((double)ang);
        p.rope[2049 * 16 + i] = (float)sin((double)ang);
    }
}
__device__ __forceinline__ void ph_copy_x(const P& p) {
    const int tid_ = opaque_v((int)threadIdx.x); const int bid_ = opaque_s((int)blockIdx.x); (void)tid_; (void)bid_;
    size_t n = (size_t)TP * DM;
    for (size_t i = (size_t)bid_ * NTHR + tid_; i < n; i += (size_t)gridDim.x * NTHR) {
        size_t t = i / DM;
        float v = 0.f;
        if (t < NPT) v = p.x_prompt[i];
        else if (t < NT) v = p.x_sample[i - (size_t)NPT * DM];
        p.xres[i] = v;
    }
}
__device__ __forceinline__ void ph_rmsnorm(const float* in, int ldi, const float* w, float* out, int ldo, bf16_t* outb, int ldob, int D, int rows) {
    const int tid_ = opaque_v((int)threadIdx.x); const int bid_ = opaque_s((int)blockIdx.x); (void)tid_; (void)bid_;
    VB_LOOP((rows + 3) / 4) {
        int row = vb * 4 + (tid_ >> 6);
        int lane = tid_ & 63;
        if (row < rows) {
            const float* x = in + (size_t)row * ldi;
            float s = 0.f;
            for (int c = lane; c < D; c += 64) { float v = x[c]; s += v * v; }
            s = wave_sum(s);
            float r = rsqrtf(s / (float)D + EPSF);
            for (int c = lane; c < D; c += 64) {
                float v = x[c] * r * w[c];
                if (out) out[(size_t)row * ldo + c] = v;
                if (outb) outb[(size_t)row * ldob + c] = f2bf(v);
            }
        }
    }
}
__device__ __forceinline__ void ph_conv(const P& p, int layer) {
    const int tid_ = opaque_v((int)threadIdx.x); const int bid_ = opaque_s((int)blockIdx.x); (void)tid_; (void)bid_;
    const size_t n = (size_t)NT * CONVD;
    for (size_t i = (size_t)bid_ * NTHR + tid_; i < n; i += (size_t)gridDim.x * NTHR) {
        int t = (int)(i / CONVD), c = (int)(i % CONVD);
        const float* cw = p.conv_w + (size_t)layer * 4 * CONVD;
        float acc = p.conv_b[layer * CONVD + c];
        float raw = p.proj[(size_t)t * DIN + OFF_XBC + c];
        if (t < NPT) {
            int b = t / SEQ, l = t % SEQ;
#pragma unroll
            for (int k = 0; k < 4; ++k) {
                int ls = l + k - 3;
                if (ls >= 0) acc += p.proj[(size_t)(t + k - 3) * DIN + OFF_XBC + c] * cw[k * CONVD + c];
            }
            if (l >= SEQ - 3) p.out[O_CONVP + ((size_t)(layer * NB + b) * 3 + (l - (SEQ - 3))) * CONVD + c] = raw;
        } else {
            int bs = t - NPT;
            const float* prev = p.state_conv + ((size_t)(layer * NS + bs) * 3) * CONVD;
#pragma unroll
            for (int k = 0; k < 3; ++k) acc += prev[k * CONVD + c] * cw[k * CONVD + c];
            acc += raw * cw[3 * CONVD + c];
            float* oc = p.out + O_CONVS + ((size_t)(layer * NS + bs) * 3) * CONVD;
            oc[0 * CONVD + c] = prev[1 * CONVD + c];
            oc[1 * CONVD + c] = prev[2 * CONVD + c];
            oc[2 * CONVD + c] = raw;
        }
        const float sv = silu_f(acc);
        p.xbc[(size_t)t * CONVD + c] = sv;
        p.xbcb[(size_t)t * CONVD + c] = f2bf(sv);
    }
}
__device__ __forceinline__ void ph_dt(const P& p, int layer) {
    const int tid_ = opaque_v((int)threadIdx.x); const int bid_ = opaque_s((int)blockIdx.x); (void)tid_; (void)bid_;
    for (int i = bid_ * NTHR + tid_; i < NT * 16; i += gridDim.x * NTHR) {
        int t = i / 16, e = i % 16;
        float x = p.proj[(size_t)t * DIN + OFF_DT + e] + p.dt_bias[layer * 16 + e];
        p.dt[i] = (x > 20.f) ? x : log1pf(expf(x));
    }
}
__device__ __forceinline__ void ph_ssd_seq(const P& p, int layer) {
    const int tid_ = opaque_v((int)threadIdx.x); const int bid_ = opaque_s((int)blockIdx.x); (void)tid_; (void)bid_;
    VB_LOOP(NS * 16) {
        int seq = NB + vb / 16, e = vb % 16, g = e / 8;
        int pp = tid_ >> 2, nq = tid_ & 3;
        float A = -expf(p.a_log[layer * 16 + e]);
        float Dk = p.d_skip[layer * 16 + e];
        float s[32];
        int t0, L;
        float* hout;
        if (seq < NB) {
            t0 = seq * SEQ; L = SEQ;
#pragma unroll
            for (int j = 0; j < 32; ++j) s[j] = 0.f;
            hout = p.out + O_SSMP + (((size_t)(layer * NB + seq) * 16 + e) * 64 + pp) * 128 + nq * 32;
        } else {
            int bs = seq - NB;
            t0 = NPT + bs; L = 1;
            const float* h0 = p.state_ssm + (((size_t)(layer * NS + bs) * 16 + e) * 64 + pp) * 128 + nq * 32;
#pragma unroll
            for (int j = 0; j < 32; ++j) s[j] = h0[j];
            hout = p.out + O_SSMS + (((size_t)(layer * NS + bs) * 16 + e) * 64 + pp) * 128 + nq * 32;
        }
        for (int l = 0; l < L; ++l) {
            int t = t0 + l;
            float dt = p.dt[t * 16 + e];
            float dA = expf(dt * A);
            const float* xr = p.xbc + (size_t)t * CONVD;
            float xv = xr[e * 64 + pp];
            float xdt = xv * dt;
            const float4* Bp = (const float4*)(xr + 1024 + g * 128 + nq * 32);
            const float4* Cp = (const float4*)(xr + 1280 + g * 128 + nq * 32);
            float ys = 0.f;
#pragma unroll
            for (int j4 = 0; j4 < 8; ++j4) {
                float4 b = Bp[j4], c = Cp[j4];
                s[j4 * 4 + 0] = s[j4 * 4 + 0] * dA + xdt * b.x; ys += c.x * s[j4 * 4 + 0];
                s[j4 * 4 + 1] = s[j4 * 4 + 1] * dA + xdt * b.y; ys += c.y * s[j4 * 4 + 1];
                s[j4 * 4 + 2] = s[j4 * 4 + 2] * dA + xdt * b.z; ys += c.z * s[j4 * 4 + 2];
                s[j4 * 4 + 3] = s[j4 * 4 + 3] * dA + xdt * b.w; ys += c.w * s[j4 * 4 + 3];
            }
            ys += __shfl_xor(ys, 1);
            ys += __shfl_xor(ys, 2);
            if (nq == 0) p.yraw[(size_t)t * DM + e * 64 + pp] = ys + Dk * xv;
        }
#pragma unroll
        for (int j = 0; j < 32; ++j) hout[j] = s[j];
    }
}
__device__ __forceinline__ void ph_gate_norm(const P& p, int layer) {
    const int tid_ = opaque_v((int)threadIdx.x); const int bid_ = opaque_s((int)blockIdx.x); (void)tid_; (void)bid_;
    VB_LOOP((NT * 2 + 3) / 4) {
        int w = vb * 4 + (tid_ >> 6);
        int lane = tid_ & 63;
        if (w < NT * 2) {
            int t = w >> 1, g = w & 1;
            float v[8];
            float ss = 0.f;
#pragma unroll
            for (int j = 0; j < 8; ++j) {
                int c = g * 512 + j * 64 + lane;
                float y = p.yraw[(size_t)t * DM + c];
                float z = p.proj[(size_t)t * DIN + OFF_Z + c];
                v[j] = y * silu_f(z);
                ss += v[j] * v[j];
            }
            ss = wave_sum(ss);
            float r = rsqrtf(ss / 512.f + EPSF);
#pragma unroll
            for (int j = 0; j < 8; ++j) {
                int c = g * 512 + j * 64 + lane;
                p.ynb[(size_t)t * DM + c] = f2bf(v[j] * r * p.ssm_norm[layer * DM + c]);
            }
        }
    }
}
__device__ __forceinline__ void ph_mla_post(const P& p, int layer) {
    const int tid_ = opaque_v((int)threadIdx.x); const int bid_ = opaque_s((int)blockIdx.x); (void)tid_; (void)bid_;
    VB_LOOP((NT + 3) / 4) {
        int t = vb * 4 + (tid_ >> 6);
        int lane = tid_ & 63;
        if (t < NT) {
            int pi = (t < NPT) ? (t % SEQ) : 2048;
            const float* cs = p.rope + pi * 16;
            const float* sn = p.rope + 2049 * 16 + pi * 16;
            const float qsc = ATT_SCALE * 1.4426950408889634f;
#pragma unroll
            for (int r = 0; r < 2; ++r) {
                int id = lane + r * 64;
                int hh = id >> 4, j = id & 15;
                float* qp = p.q + (size_t)t * 768 + hh * 96 + 64;
                float x1 = qp[j], x2 = qp[16 + j];
                float o1 = x1 * cs[j] - x2 * sn[j];
                float o2 = x1 * sn[j] + x2 * cs[j];
                qp[j] = o1;
                qp[16 + j] = o2;
                p.qb[(size_t)t * 768 + hh * 96 + 64 + j] = f2bf(o1 * qsc);
                p.qb[(size_t)t * 768 + hh * 96 + 80 + j] = f2bf(o2 * qsc);
            }
#pragma unroll
            for (int r = 0; r < 8; ++r) {
                int id = lane + r * 64;
                int hh = id >> 6, d = id & 63;
                p.qb[(size_t)t * 768 + hh * 96 + d] = f2bf(p.q[(size_t)t * 768 + hh * 96 + d] * qsc);
            }
            if (lane < 16) {
                const float* kr = p.proj + (size_t)t * DIN + OFF_KR;
                float x1 = kr[lane], x2 = kr[16 + lane];
                float o1 = x1 * cs[lane] - x2 * sn[lane];
                float o2 = x1 * sn[lane] + x2 * cs[lane];
                p.kpe[(size_t)t * 32 + lane] = o1;
                p.kpe[(size_t)t * 32 + 16 + lane] = o2;
                p.kpeb[(size_t)t * 32 + lane] = f2bf(o1);
                p.kpeb[(size_t)t * 32 + 16 + lane] = f2bf(o2);
                float* ok = (t < NPT) ? (p.out + O_KRP + ((size_t)layer * NPT + t) * 32) : (p.out + O_KRS + ((size_t)layer * NS + (t - NPT)) * 32);
                ok[lane] = o1; ok[16 + lane] = o2;
            }
            float* ol = (t < NPT) ? (p.out + O_LATP + ((size_t)layer * NPT + t) * KVL) : (p.out + O_LATS + ((size_t)layer * NS + (t - NPT)) * KVL);
#pragma unroll
            for (int r = 0; r < 4; ++r) ol[lane + r * 64] = p.lat[(size_t)t * KVL + lane + r * 64];
        }
    }
}

#define A_KRS 208
#define A_VRS 144
#define A_KBYTES (64 * A_KRS)
#define A_BUF (64 * A_KRS + 64 * A_VRS)
struct EpiKV { bf16_t* kn; bf16_t* vT; __device__ __forceinline__ void operator()(int m, int n, float v) const {
    int h = n >> 7, j = n & 127;
    if (j < 64) kn[(size_t)m * 512 + h * 64 + j] = f2bf(v);
    else if (m < NPT) vT[((size_t)((m >> 11) * 8 + h) * 64 + (j - 64)) * SEQ + (m & (SEQ - 1))] = f2bf(v);
} };
__device__ __forceinline__ void ph_attn(const P& p, char* smem) {
    const int tid = opaque_v((int)threadIdx.x); const int bid = opaque_s((int)blockIdx.x);
    const int wid = tid >> 6, lane = tid & 63, fr = lane & 15, fq = lane >> 4;
    const int G = (int)gridDim.x;
    for (int rnd = 0;; ++rnd) {
        int o = rnd * G + ((rnd & 1) ? (G - 1 - bid) : bid);
        if (rnd * G >= 1024) break;
        if (o >= 1024) continue;
        const int qblk = 15 - (o >> 6), bh = o & 63, b = bh >> 3, h = bh & 7;
        const int q0w = qblk * 128 + wid * 32;
        const size_t tok0 = (size_t)b * SEQ;
        bf16x8 qf[2][3];
#pragma unroll
        for (int qt = 0; qt < 2; ++qt)
#pragma unroll
            for (int s3 = 0; s3 < 3; ++s3)
                qf[qt][s3] = *reinterpret_cast<const bf16x8*>(p.qb + (tok0 + q0w + qt * 16 + fr) * 768 + h * 96 + s3 * 32 + fq * 8);
        f32x4 oacc[2][4];
        float mrun[2], lrun[2];
#pragma unroll
        for (int qt = 0; qt < 2; ++qt) {
            mrun[qt] = -INFINITY; lrun[qt] = 0.f;
#pragma unroll
            for (int mt = 0; mt < 4; ++mt) oacc[qt][mt] = f32x4{0.f, 0.f, 0.f, 0.f};
        }
        const int nkb = 2 * qblk + 2;
        uint4 stg0, stg1, stg2, stg3, stg4;
#define A_ISSUE(kb_) do { const size_t key0 = (size_t)(kb_) * 64; \
            { int c = tid; int row = c >> 3, ch = c & 7; stg0 = *reinterpret_cast<const uint4*>(p.kn + (tok0 + key0 + row) * 512 + h * 64 + ch * 8); } \
            { int c = tid + 256; int row = c >> 3, ch = c & 7; stg1 = *reinterpret_cast<const uint4*>(p.kn + (tok0 + key0 + row) * 512 + h * 64 + ch * 8); } \
            { int c = tid; int row = c >> 2, ch = c & 3; stg2 = *reinterpret_cast<const uint4*>(p.kpeb + (tok0 + key0 + row) * 32 + ch * 8); } \
            { int c = tid; int row = c >> 3, ch = c & 7; stg3 = *reinterpret_cast<const uint4*>(p.vT + ((size_t)(b * 8 + h) * 64 + row) * SEQ + key0 + ch * 8); } \
            { int c = tid + 256; int row = c >> 3, ch = c & 7; stg4 = *reinterpret_cast<const uint4*>(p.vT + ((size_t)(b * 8 + h) * 64 + row) * SEQ + key0 + ch * 8); } \
        } while (0)
#define A_COMMIT(buf_) do { char* buf = (buf_); \
            { int c = tid; int row = c >> 3, ch = c & 7; *reinterpret_cast<uint4*>(buf + row * A_KRS + ch * 16) = stg0; } \
            { int c = tid + 256; int row = c >> 3, ch = c & 7; *reinterpret_cast<uint4*>(buf + row * A_KRS + ch * 16) = stg1; } \
            { int c = tid; int row = c >> 2, ch = c & 3; *reinterpret_cast<uint4*>(buf + row * A_KRS + 128 + ch * 16) = stg2; } \
            { int c = tid; int row = c >> 3, ch = c & 7; *reinterpret_cast<uint4*>(buf + A_KBYTES + row * A_VRS + ch * 16) = stg3; } \
            { int c = tid + 256; int row = c >> 3, ch = c & 7; *reinterpret_cast<uint4*>(buf + A_KBYTES + row * A_VRS + ch * 16) = stg4; } \
        } while (0)
        A_ISSUE(0);
        A_COMMIT(smem);
        __syncthreads();
        for (int kb = 0; kb < nkb; ++kb) {
            const char* kbuf = smem + (kb & 1) * A_BUF;
            const char* vbuf = kbuf + A_KBYTES;
            if (kb + 1 < nkb) A_ISSUE(kb + 1);
#pragma unroll
            for (int kh = 0; kh < 2; ++kh) {
                const int k0 = kb * 64 + kh * 32;
                if (k0 <= q0w + 31) {
                    f32x4 st[2][2];
#pragma unroll
                    for (int qt = 0; qt < 2; ++qt)
#pragma unroll
                        for (int kt = 0; kt < 2; ++kt) st[qt][kt] = f32x4{0.f, 0.f, 0.f, 0.f};
#pragma unroll
                    for (int s3 = 0; s3 < 3; ++s3)
#pragma unroll
                        for (int kt = 0; kt < 2; ++kt) {
                            bf16x8 kf = *reinterpret_cast<const bf16x8*>(kbuf + (kh * 32 + kt * 16 + fr) * A_KRS + (s3 * 32 + fq * 8) * 2);
#pragma unroll
                            for (int qt = 0; qt < 2; ++qt) st[qt][kt] = __builtin_amdgcn_mfma_f32_16x16x32_bf16(kf, qf[qt][s3], st[qt][kt], 0, 0, 0);
                        }
                    const bool need_mask = (k0 + 31 > q0w);
                    bf16x8 pf[2];
#pragma unroll
                    for (int qt = 0; qt < 2; ++qt) {
                        if (need_mask) {
                            const int qi = q0w + qt * 16 + fr;
#pragma unroll
                            for (int kt = 0; kt < 2; ++kt)
#pragma unroll
                                for (int r = 0; r < 4; ++r)
                                    if (k0 + kt * 16 + fq * 4 + r > qi) st[qt][kt][r] = -INFINITY;
                        }
                        float mx = fmaxf(fmaxf(fmaxf(st[qt][0][0], st[qt][0][1]), fmaxf(st[qt][0][2], st[qt][0][3])),
                                         fmaxf(fmaxf(st[qt][1][0], st[qt][1][1]), fmaxf(st[qt][1][2], st[qt][1][3])));
                        mx = fmaxf(mx, __shfl_xor(mx, 16));
                        mx = fmaxf(mx, __shfl_xor(mx, 32));
                        const float mnew = fmaxf(mrun[qt], mx);
                        const float corr = __builtin_amdgcn_exp2f(mrun[qt] - mnew);
                        float pv[8];
                        float rs = 0.f;
#pragma unroll
                        for (int kt = 0; kt < 2; ++kt)
#pragma unroll
                            for (int r = 0; r < 4; ++r) { pv[kt * 4 + r] = __builtin_amdgcn_exp2f(st[qt][kt][r] - mnew); rs += pv[kt * 4 + r]; }
                        rs += __shfl_xor(rs, 16);
                        rs += __shfl_xor(rs, 32);
                        lrun[qt] = lrun[qt] * corr + rs;
                        mrun[qt] = mnew;
#pragma unroll
                        for (int mt = 0; mt < 4; ++mt) { oacc[qt][mt][0] *= corr; oacc[qt][mt][1] *= corr; oacc[qt][mt][2] *= corr; oacc[qt][mt][3] *= corr; }
                        uint4 pk;
                        pk.x = pack_bf16(pv[0], pv[1]); pk.y = pack_bf16(pv[2], pv[3]); pk.z = pack_bf16(pv[4], pv[5]); pk.w = pack_bf16(pv[6], pv[7]);
                        pf[qt] = __builtin_bit_cast(bf16x8, pk);
                    }
#pragma unroll
                    for (int mt = 0; mt < 4; ++mt) {
                        const char* vp = vbuf + (mt * 16 + fr) * A_VRS + (kh * 32 + fq * 4) * 2;
                        uint2 lo = *reinterpret_cast<const uint2*>(vp);
                        uint2 hi = *reinterpret_cast<const uint2*>(vp + 32);
                        uint4 vv; vv.x = lo.x; vv.y = lo.y; vv.z = hi.x; vv.w = hi.y;
                        bf16x8 vf = __builtin_bit_cast(bf16x8, vv);
#pragma unroll
                        for (int qt = 0; qt < 2; ++qt) oacc[qt][mt] = __builtin_amdgcn_mfma_f32_16x16x32_bf16(vf, pf[qt], oacc[qt][mt], 0, 0, 0);
                    }
                }
            }
            if (kb + 1 < nkb) A_COMMIT(smem + ((kb + 1) & 1) * A_BUF);
            __syncthreads();
        }
#pragma unroll
        for (int qt = 0; qt < 2; ++qt) {
            const float inv = 1.f / lrun[qt];
            bf16_t* op = p.ob + (tok0 + q0w + qt * 16 + fr) * 512 + h * 64 + fq * 4;
#pragma unroll
            for (int mt = 0; mt < 4; ++mt) {
                uint2 w;
                w.x = pack_bf16(oacc[qt][mt][0] * inv, oacc[qt][mt][1] * inv);
                w.y = pack_bf16(oacc[qt][mt][2] * inv, oacc[qt][mt][3] * inv);
                *reinterpret_cast<uint2*>(op + mt * 16) = w;
            }
        }
    }
}
__device__ __forceinline__ void ph_qlat(const P& p, int layer) {
    const int tid_ = opaque_v((int)threadIdx.x); const int bid_ = opaque_s((int)blockIdx.x); (void)tid_; (void)bid_;
    VB_LOOP(NS * 8) {
        int bs = vb / 8, h = vb % 8;
        int r = tid_;
        const float* qp = p.q + (size_t)(NPT + bs) * 768 + h * 96;
        const float* w = p.w_kvb + (size_t)layer * 256 * 1024 + (size_t)r * 1024 + h * 128;
        float s = 0.f;
        for (int d = 0; d < 64; ++d) s += qp[d] * w[d];
        p.qlat[((size_t)bs * 8 + h) * 256 + r] = s * ATT_SCALE;
    }
}
__device__ __forceinline__ void ph_decode_part(const P& p, int layer, char* smem) {
    const int tid_ = opaque_v((int)threadIdx.x); const int bid_ = opaque_s((int)blockIdx.x); (void)tid_; (void)bid_;
    float (*sq)[288] = (float (*)[288])smem;
    float (*ss)[128] = (float (*)[128])(smem + 8 * 288 * 4);
    float* sm = (float*)(smem + 8 * 288 * 4 + 8 * 128 * 4);
    float* sl = sm + 8;
    VB_LOOP(NS * 129) {
        int bs = vb / 129, ch = vb % 129;
        int tid = tid_, lane = tid & 63, wv = tid >> 6;
        for (int i = tid; i < 8 * 288; i += 256) {
            int h = i / 288, d = i % 288;
            sq[h][d] = (d < 256) ? p.qlat[((size_t)bs * 8 + h) * 256 + d] : p.q[(size_t)(NPT + bs) * 768 + h * 96 + 64 + (d - 256)] * ATT_SCALE;
        }
        __syncthreads();
        int nkeys = (ch < 128) ? 128 : 1;
        const float* latb; const float* krb;
        if (ch < 128) {
            int pg = p.page_table[bs * NPAGES + ch];
            latb = p.cache_lat + ((size_t)layer * NPOOL + pg) * PAGE * KVL;
            krb = p.cache_kr + ((size_t)layer * NPOOL + pg) * PAGE * 32;
        } else {
            latb = p.lat + (size_t)(NPT + bs) * KVL;
            krb = p.kpe + (size_t)(NPT + bs) * 32;
        }
        for (int k = wv; k < nkeys; k += 4) {
            float4 kv4 = *(const float4*)(latb + (size_t)k * KVL + lane * 4);
            float kr = (lane < 32) ? krb[(size_t)k * 32 + lane] : 0.f;
            float sh[8];
#pragma unroll
            for (int h = 0; h < 8; ++h) {
                float s = sq[h][lane * 4] * kv4.x + sq[h][lane * 4 + 1] * kv4.y + sq[h][lane * 4 + 2] * kv4.z + sq[h][lane * 4 + 3] * kv4.w;
                if (lane < 32) s += sq[h][256 + lane] * kr;
                sh[h] = wave_sum(s);
            }
            if (lane == 0) {
#pragma unroll
                for (int h = 0; h < 8; ++h) ss[h][k] = sh[h];
            }
        }
        __syncthreads();
        for (int hh = 0; hh < 2; ++hh) {
            int h = wv * 2 + hh;
            float v0 = (lane < nkeys) ? ss[h][lane] : -INFINITY;
            float v1 = (lane + 64 < nkeys) ? ss[h][lane + 64] : -INFINITY;
            float m = wave_max(fmaxf(v0, v1));
            float p0 = (lane < nkeys) ? expf(v0 - m) : 0.f;
            float p1 = (lane + 64 < nkeys) ? expf(v1 - m) : 0.f;
            float l = wave_sum(p0 + p1);
            if (lane < nkeys) ss[h][lane] = p0;
            if (lane + 64 < nkeys) ss[h][lane + 64] = p1;
            if (lane == 0) { sm[h] = m; sl[h] = l; }
        }
        __syncthreads();
        float acc[8];
#pragma unroll
        for (int h = 0; h < 8; ++h) acc[h] = 0.f;
        for (int k = 0; k < nkeys; ++k) {
            float v = latb[(size_t)k * KVL + tid];
#pragma unroll
            for (int h = 0; h < 8; ++h) acc[h] += ss[h][k] * v;
        }
        float* pp = p.part + ((size_t)bs * 129 + ch) * 8 * 258;
#pragma unroll
        for (int h = 0; h < 8; ++h) pp[h * 258 + 2 + tid] = acc[h];
        if (tid < 8) { pp[tid * 258 + 0] = sm[tid]; pp[tid * 258 + 1] = sl[tid]; }
        __syncthreads();
    }
}
__device__ __forceinline__ void ph_decode_comb(const P& p, int layer, char* smem) {
    const int tid_ = opaque_v((int)threadIdx.x); const int bid_ = opaque_s((int)blockIdx.x); (void)tid_; (void)bid_;
    float* sw = (float*)smem;
    float* so = sw + 132;
    float* sLp = so + 256;
    VB_LOOP(NS * 8) {
        int bs = vb / 8, h = vb % 8, tid = tid_;
        const float* pb = p.part + (size_t)bs * 129 * 8 * 258 + h * 258;
        if (tid < 64) {
            float m = -INFINITY;
            for (int c = tid; c < 129; c += 64) m = fmaxf(m, pb[(size_t)c * 8 * 258]);
            m = wave_max(m);
            float l = 0.f;
            for (int c = tid; c < 129; c += 64) {
                float w = expf(pb[(size_t)c * 8 * 258] - m);
                sw[c] = w;
                l += w * pb[(size_t)c * 8 * 258 + 1];
            }
            l = wave_sum(l);
            if (tid == 0) sLp[0] = l;
        }
        __syncthreads();
        float a = 0.f;
        for (int c = 0; c < 129; ++c) a += sw[c] * pb[(size_t)c * 8 * 258 + 2 + tid];
        so[tid] = a / sLp[0];
        __syncthreads();
        if (tid < 64) {
            const float* w = p.w_kvb + (size_t)layer * 256 * 1024 + h * 128 + 64 + tid;
            float s = 0.f;
            for (int r = 0; r < 256; ++r) s += so[r] * w[(size_t)r * 1024];
            p.ob[(size_t)(NPT + bs) * 512 + h * 64 + tid] = f2bf(s);
        }
        __syncthreads();
    }
}
__device__ __forceinline__ void ph_mix(const P& p, int layer) {
    const int tid_ = opaque_v((int)threadIdx.x); const int bid_ = opaque_s((int)blockIdx.x); (void)tid_; (void)bid_;
    const size_t n = (size_t)NT * DM;
    for (size_t i = (size_t)bid_ * NTHR + tid_; i < n; i += (size_t)gridDim.x * NTHR) {
        int t = (int)(i / DM), c = (int)(i % DM);
        float ga = sigmoid_f(p.proj[(size_t)t * DIN + OFF_GA + c] + p.b_gate[layer * 2048 + c]);
        float gb = sigmoid_f(p.proj[(size_t)t * DIN + OFF_GB + c] + p.b_gate[layer * 2048 + 1024 + c]);
        p.mixb[i] = f2bf(ga * p.ya[i] + gb * p.yb[i]);
    }
}
__device__ __forceinline__ void ph_peer_scores(const P& p, int layer, char* smem) {
    const int tid_ = opaque_v((int)threadIdx.x); const int bid_ = opaque_s((int)blockIdx.x); (void)tid_; (void)bid_;
    float* sq = (float*)smem;
    VB_LOOP(NT * 8) {
        int t = vb / 8, hh = (vb % 8) * 2 + (tid_ >> 7), k = tid_ & 127;
        sq[tid_] = p.pq[(size_t)t * 2048 + hh * 128 + k];
        __syncthreads();
        const float* sqq = sq + (tid_ >> 7) * 128;
        const float4* kp = (const float4*)(p.peer_keys + ((size_t)(layer * 16 + hh) * 128 + k) * 128);
        float s = 0.f;
#pragma unroll 8
        for (int d4 = 0; d4 < 32; ++d4) { float4 v = kp[d4]; s += sqq[d4 * 4] * v.x + sqq[d4 * 4 + 1] * v.y + sqq[d4 * 4 + 2] * v.z + sqq[d4 * 4 + 3] * v.w; }
        p.sc[(size_t)t * 2048 + hh * 128 + k] = s;
        __syncthreads();
    }
}
__device__ __forceinline__ void wave_argmax(float& v, int& i) {
#pragma unroll
    for (int o = 32; o > 0; o >>= 1) {
        float ov = __shfl_xor(v, o);
        int oi = __shfl_xor(i, o);
        if (ov > v || (ov == v && oi < i)) { v = ov; i = oi; }
    }
}
__device__ __forceinline__ void ph_peer_topk(const P& p) {
    const int tid_ = opaque_v((int)threadIdx.x); const int bid_ = opaque_s((int)blockIdx.x); (void)tid_; (void)bid_;
    VB_LOOP((NT * 8 + 3) / 4) {
        int w = vb * 4 + (tid_ >> 6);
        int lane = tid_ & 63;
        if (w < NT * 8) {
            int t = w / 8, h = w % 8;
            float topv0 = 0.f, topv1 = 0.f;
            int topi0 = 0, topi1 = 0;
#pragma unroll
            for (int half = 0; half < 2; ++half) {
                const float* sp = p.sc + (size_t)t * 2048 + (h * 2 + half) * 128;
                float a0 = sp[lane], a1 = sp[lane + 64];
                float tv = 0.f; int ti = 0;
                for (int r = 0; r < 16; ++r) {
                    float v; int i;
                    if (a0 >= a1) { v = a0; i = lane; } else { v = a1; i = lane + 64; }
                    wave_argmax(v, i);
                    if (i == lane) a0 = -INFINITY;
                    if (i == lane + 64) a1 = -INFINITY;
                    if (lane == r) { tv = v; ti = i; }
                }
                if (half == 0) { topv0 = tv; topi0 = ti; } else { topv1 = tv; topi1 = ti; }
            }
            float cv0, cv1, cv2, cv3;
            {
                float va = __shfl(topv0, lane >> 2);
                int b0 = (lane & 3) * 4;
                cv0 = va + __shfl(topv1, b0 + 0);
                cv1 = va + __shfl(topv1, b0 + 1);
                cv2 = va + __shfl(topv1, b0 + 2);
                cv3 = va + __shfl(topv1, b0 + 3);
            }
            float selv = 0.f; int selc = 0;
            for (int r = 0; r < 16; ++r) {
                float v = cv0; int c = lane * 4;
                if (cv1 > v) { v = cv1; c = lane * 4 + 1; }
                if (cv2 > v) { v = cv2; c = lane * 4 + 2; }
                if (cv3 > v) { v = cv3; c = lane * 4 + 3; }
                wave_argmax(v, c);
                if (c == lane * 4 + 0) cv0 = -INFINITY;
                if (c == lane * 4 + 1) cv1 = -INFINITY;
                if (c == lane * 4 + 2) cv2 = -INFINITY;
                if (c == lane * 4 + 3) cv3 = -INFINITY;
                if (lane == r) { selv = v; selc = c; }
            }
            float mx = __shfl(selv, 0);
            float e = (lane < 16) ? expf(selv - mx) : 0.f;
            float sum = wave_sum(e);
            int ia = __shfl(topi0, selc >> 4);
            int ib = __shfl(topi1, selc & 15);
            if (lane < 16) {
                p.idx[(size_t)t * 128 + h * 16 + lane] = ia * 128 + ib;
                p.gate[(size_t)t * 128 + h * 16 + lane] = e / sum;
            }
        }
    }
}

__device__ __forceinline__ float dot2bf(unsigned a, unsigned b, float c) {
    return __builtin_amdgcn_fdot2_f32_bf16(__builtin_bit_cast(bf16x2_t, a), __builtin_bit_cast(bf16x2_t, b), c, false);
}
__device__ __forceinline__ float bflo(unsigned d) { return __uint_as_float(d << 16); }
__device__ __forceinline__ float bfhi(unsigned d) { return __uint_as_float(d & 0xffff0000u); }
__device__ __forceinline__ void ph_peer_experts2(const P& p, int layer) {
    const int tid = opaque_v((int)threadIdx.x); const int bid = opaque_s((int)blockIdx.x);
    const int wid = tid >> 6, lane = tid & 63;
    const bf16_t* U = p.ub + (size_t)layer * NEXP * DM;
    const bf16_t* V = p.vb + (size_t)layer * NEXP * DM;
    for (int t = bid * 4 + wid; t < NT; t += (int)gridDim.x * 4) {
        const uint4* hrow = reinterpret_cast<const uint4*>(p.hb + (size_t)t * DM);
        const uint4 h0 = hrow[lane], h1 = hrow[64 + lane];
        const int i0 = p.idx[(size_t)t * 128 + lane], i1 = p.idx[(size_t)t * 128 + 64 + lane];
        const float g0 = p.gate[(size_t)t * 128 + lane], g1 = p.gate[(size_t)t * 128 + 64 + lane];
        float w0 = 0.f, w1 = 0.f;
#pragma unroll 1
        for (int kk = 0; kk < 128; kk += 4) {
            const int iv = (kk < 64) ? i0 : i1;
            uint4 a[4], b[4];
#pragma unroll
            for (int j = 0; j < 4; ++j) {
                const int e = __builtin_amdgcn_readlane(iv, (kk + j) & 63);
                const uint4* row = reinterpret_cast<const uint4*>(U + (size_t)e * DM);
                a[j] = row[lane]; b[j] = row[64 + lane];
            }
#pragma unroll
            for (int j = 0; j < 4; ++j) {
                float sdot = 0.f;
                sdot = dot2bf(a[j].x, h0.x, sdot); sdot = dot2bf(a[j].y, h0.y, sdot); sdot = dot2bf(a[j].z, h0.z, sdot); sdot = dot2bf(a[j].w, h0.w, sdot);
                sdot = dot2bf(b[j].x, h1.x, sdot); sdot = dot2bf(b[j].y, h1.y, sdot); sdot = dot2bf(b[j].z, h1.z, sdot); sdot = dot2bf(b[j].w, h1.w, sdot);
                sdot = wave_sum(sdot);
                const float act = 0.5f * sdot * (1.f + erff(sdot * 0.70710678118654752f));
                if (lane == ((kk + j) & 63)) { if (kk < 64) w0 = g0 * act; else w1 = g1 * act; }
            }
        }
        float acc[16];
#pragma unroll
        for (int i = 0; i < 16; ++i) acc[i] = 0.f;
#pragma unroll 1
        for (int kk = 0; kk < 128; kk += 4) {
            const int iv = (kk < 64) ? i0 : i1;
            const float wv = (kk < 64) ? w0 : w1;
            uint4 a[4], b[4];
            float w[4];
#pragma unroll
            for (int j = 0; j < 4; ++j) {
                const int e = __builtin_amdgcn_readlane(iv, (kk + j) & 63);
                w[j] = __builtin_bit_cast(float, __builtin_amdgcn_readlane(__builtin_bit_cast(int, wv), (kk + j) & 63));
                const uint4* row = reinterpret_cast<const uint4*>(V + (size_t)e * DM);
                a[j] = row[lane]; b[j] = row[64 + lane];
            }
#pragma unroll
            for (int j = 0; j < 4; ++j) {
                acc[0] += w[j] * bflo(a[j].x); acc[1] += w[j] * bfhi(a[j].x); acc[2] += w[j] * bflo(a[j].y); acc[3] += w[j] * bfhi(a[j].y);
                acc[4] += w[j] * bflo(a[j].z); acc[5] += w[j] * bfhi(a[j].z); acc[6] += w[j] * bflo(a[j].w); acc[7] += w[j] * bfhi(a[j].w);
                acc[8] += w[j] * bflo(b[j].x); acc[9] += w[j] * bfhi(b[j].x); acc[10] += w[j] * bflo(b[j].y); acc[11] += w[j] * bfhi(b[j].y);
                acc[12] += w[j] * bflo(b[j].z); acc[13] += w[j] * bfhi(b[j].z); acc[14] += w[j] * bflo(b[j].w); acc[15] += w[j] * bfhi(b[j].w);
            }
        }
        float4* xp = reinterpret_cast<float4*>(p.xres + (size_t)t * DM + lane * 8);
        float4 x0 = xp[0], x1 = xp[1];
        x0.x += acc[0]; x0.y += acc[1]; x0.z += acc[2]; x0.w += acc[3]; x1.x += acc[4]; x1.y += acc[5]; x1.z += acc[6]; x1.w += acc[7];
        xp[0] = x0; xp[1] = x1;
        float4* xq = reinterpret_cast<float4*>(p.xres + (size_t)t * DM + 512 + lane * 8);
        float4 y0 = xq[0], y1 = xq[1];
        y0.x += acc[8]; y0.y += acc[9]; y0.z += acc[10]; y0.w += acc[11]; y1.x += acc[12]; y1.y += acc[13]; y1.z += acc[14]; y1.w += acc[15];
        xq[0] = y0; xq[1] = y1;
    }
}


#define S_RS 272
#define S_XT 0
#define S_HL (64 * S_RS)
#define S_BT (2 * 64 * S_RS)
#define S_ACS (2 * 64 * S_RS + 128 * S_RS)
#define S_DTL (S_ACS + 512)
#define S_WL (S_DTL + 512)
__device__ __forceinline__ void ph_ssd_chunk(const P& p, int layer, char* smem) {
    const int tid = opaque_v((int)threadIdx.x); const int bid = opaque_s((int)blockIdx.x);
    const int wid = tid >> 6, lane = tid & 63, fr = lane & 15, fq = lane >> 4;
    float* acs = reinterpret_cast<float*>(smem + S_ACS);
    float* dtl = reinterpret_cast<float*>(smem + S_DTL);
    float* wl = reinterpret_cast<float*>(smem + S_WL);
    for (int u = bid; u < NB * 16; u += (int)gridDim.x) {
        const int b = u >> 4, e = u & 15, g = e >> 3;
        const float A = -__expf(p.a_log[layer * 16 + e]);
        const float Dk = p.d_skip[layer * 16 + e];
        f32x4 hT[2][4];
#pragma unroll
        for (int i = 0; i < 2; ++i)
#pragma unroll
            for (int pt = 0; pt < 4; ++pt) hT[i][pt] = f32x4{0.f, 0.f, 0.f, 0.f};
#pragma unroll 1
        for (int c = 0; c < 16; ++c) {
            const size_t t0 = (size_t)b * SEQ + c * 128;
            if (wid == 0) {
                const float d0 = p.dt[(t0 + lane) * 16 + e], d1 = p.dt[(t0 + 64 + lane) * 16 + e];
                float s0 = d0 * A, s1 = d1 * A;
#pragma unroll
                for (int o = 1; o < 64; o <<= 1) {
                    float t0s = __shfl_up(s0, o), t1s = __shfl_up(s1, o);
                    if (lane >= o) { s0 += t0s; s1 += t1s; }
                }
                s1 += __shfl(s0, 63);
                const float aend = __shfl(s1, 63);
                acs[lane] = s0; acs[64 + lane] = s1; dtl[lane] = d0; dtl[64 + lane] = d1;
                wl[lane] = d0 * __expf(aend - s0); wl[64 + lane] = d1 * __expf(aend - s1);
            }
#pragma unroll
            for (int i = 0; i < 4; ++i) {
                const int id = tid + 256 * i, l = id & 127, pc = id >> 7;
                const uint4 v = *reinterpret_cast<const uint4*>(p.xbcb + (t0 + l) * CONVD + e * 64 + pc * 8);
                bf16_t* dst = reinterpret_cast<bf16_t*>(smem + S_XT + (pc * 8) * S_RS + l * 2);
                dst[0 * (S_RS / 2)] = (bf16_t)(v.x & 0xffff); dst[1 * (S_RS / 2)] = (bf16_t)(v.x >> 16);
                dst[2 * (S_RS / 2)] = (bf16_t)(v.y & 0xffff); dst[3 * (S_RS / 2)] = (bf16_t)(v.y >> 16);
                dst[4 * (S_RS / 2)] = (bf16_t)(v.z & 0xffff); dst[5 * (S_RS / 2)] = (bf16_t)(v.z >> 16);
                dst[6 * (S_RS / 2)] = (bf16_t)(v.w & 0xffff); dst[7 * (S_RS / 2)] = (bf16_t)(v.w >> 16);
            }
#pragma unroll
            for (int i = 0; i < 8; ++i) {
                const int id = tid + 256 * i, l = id & 127, nc = id >> 7;
                const uint4 v = *reinterpret_cast<const uint4*>(p.xbcb + (t0 + l) * CONVD + 1024 + g * 128 + nc * 8);
                bf16_t* dst = reinterpret_cast<bf16_t*>(smem + S_BT + (nc * 8) * S_RS + l * 2);
                dst[0 * (S_RS / 2)] = (bf16_t)(v.x & 0xffff); dst[1 * (S_RS / 2)] = (bf16_t)(v.x >> 16);
                dst[2 * (S_RS / 2)] = (bf16_t)(v.y & 0xffff); dst[3 * (S_RS / 2)] = (bf16_t)(v.y >> 16);
                dst[4 * (S_RS / 2)] = (bf16_t)(v.z & 0xffff); dst[5 * (S_RS / 2)] = (bf16_t)(v.z >> 16);
                dst[6 * (S_RS / 2)] = (bf16_t)(v.w & 0xffff); dst[7 * (S_RS / 2)] = (bf16_t)(v.w >> 16);
            }
#pragma unroll
            for (int i = 0; i < 2; ++i)
#pragma unroll
                for (int pt = 0; pt < 4; ++pt) {
                    uint2 w2;
                    w2.x = pack_bf16(hT[i][pt][0], hT[i][pt][1]); w2.y = pack_bf16(hT[i][pt][2], hT[i][pt][3]);
                    *reinterpret_cast<uint2*>(smem + S_HL + (pt * 16 + fr) * S_RS + (wid * 32 + i * 16 + fq * 4) * 2) = w2;
                }
            __syncthreads();
            bf16x8 cf[2][4];
#pragma unroll
            for (int j = 0; j < 2; ++j)
#pragma unroll
                for (int k = 0; k < 4; ++k)
                    cf[j][k] = *reinterpret_cast<const bf16x8*>(p.xbcb + (t0 + wid * 32 + j * 16 + fr) * CONVD + 1280 + g * 128 + k * 32 + fq * 8);
            f32x4 acc[4][2];
#pragma unroll
            for (int pt = 0; pt < 4; ++pt)
#pragma unroll
                for (int j = 0; j < 2; ++j) acc[pt][j] = f32x4{0.f, 0.f, 0.f, 0.f};
#pragma unroll
            for (int pt = 0; pt < 4; ++pt)
#pragma unroll
                for (int k = 0; k < 4; ++k) {
                    const bf16x8 hf = *reinterpret_cast<const bf16x8*>(smem + S_HL + (pt * 16 + fr) * S_RS + (k * 32 + fq * 8) * 2);
#pragma unroll
                    for (int j = 0; j < 2; ++j) acc[pt][j] = __builtin_amdgcn_mfma_f32_16x16x32_bf16(hf, cf[j][k], acc[pt][j], 0, 0, 0);
                }
            float alv[2];
#pragma unroll
            for (int j = 0; j < 2; ++j) {
                alv[j] = acs[wid * 32 + j * 16 + fr];
                const float el = __expf(alv[j]);
#pragma unroll
                for (int pt = 0; pt < 4; ++pt) { acc[pt][j][0] *= el; acc[pt][j][1] *= el; acc[pt][j][2] *= el; acc[pt][j][3] *= el; }
            }
#pragma unroll 1
            for (int ii = 0; ii <= wid; ++ii) {
                f32x4 cb[2][2];
#pragma unroll
                for (int si = 0; si < 2; ++si)
#pragma unroll
                    for (int j = 0; j < 2; ++j) cb[si][j] = f32x4{0.f, 0.f, 0.f, 0.f};
#pragma unroll
                for (int k = 0; k < 4; ++k)
#pragma unroll
                    for (int si = 0; si < 2; ++si) {
                        const bf16x8 bfr = *reinterpret_cast<const bf16x8*>(p.xbcb + (t0 + ii * 32 + si * 16 + fr) * CONVD + 1024 + g * 128 + k * 32 + fq * 8);
#pragma unroll
                        for (int j = 0; j < 2; ++j) cb[si][j] = __builtin_amdgcn_mfma_f32_16x16x32_bf16(bfr, cf[j][k], cb[si][j], 0, 0, 0);
                    }
                bf16x8 mf[2];
                {
                    float as8[8], ds8[8];
#pragma unroll
                    for (int si = 0; si < 2; ++si) {
                        const float4 a4 = *reinterpret_cast<const float4*>(acs + ii * 32 + si * 16 + fq * 4);
                        const float4 d4 = *reinterpret_cast<const float4*>(dtl + ii * 32 + si * 16 + fq * 4);
                        as8[si * 4 + 0] = a4.x; as8[si * 4 + 1] = a4.y; as8[si * 4 + 2] = a4.z; as8[si * 4 + 3] = a4.w;
                        ds8[si * 4 + 0] = d4.x; ds8[si * 4 + 1] = d4.y; ds8[si * 4 + 2] = d4.z; ds8[si * 4 + 3] = d4.w;
                    }
#pragma unroll
                    for (int j = 0; j < 2; ++j) {
                        const int lidx = wid * 32 + j * 16 + fr;
                        float mv[8];
#pragma unroll
                        for (int si = 0; si < 2; ++si)
#pragma unroll
                            for (int r = 0; r < 4; ++r) {
                                const int sidx = ii * 32 + si * 16 + fq * 4 + r;
                                const float dec = __expf(fminf(alv[j] - as8[si * 4 + r], 0.f)) * ds8[si * 4 + r];
                                mv[si * 4 + r] = (lidx >= sidx) ? cb[si][j][r] * dec : 0.f;
                            }
                        uint4 pk;
                        pk.x = pack_bf16(mv[0], mv[1]); pk.y = pack_bf16(mv[2], mv[3]); pk.z = pack_bf16(mv[4], mv[5]); pk.w = pack_bf16(mv[6], mv[7]);
                        mf[j] = __builtin_bit_cast(bf16x8, pk);
                    }
                }
#pragma unroll
                for (int pt = 0; pt < 4; ++pt) {
                    const char* xp = smem + S_XT + (pt * 16 + fr) * S_RS + (ii * 32 + fq * 4) * 2;
                    const uint2 lo = *reinterpret_cast<const uint2*>(xp);
                    const uint2 hi = *reinterpret_cast<const uint2*>(xp + 32);
                    uint4 xv; xv.x = lo.x; xv.y = lo.y; xv.z = hi.x; xv.w = hi.y;
                    const bf16x8 xf = __builtin_bit_cast(bf16x8, xv);
#pragma unroll
                    for (int j = 0; j < 2; ++j) acc[pt][j] = __builtin_amdgcn_mfma_f32_16x16x32_bf16(xf, mf[j], acc[pt][j], 0, 0, 0);
                }
            }
#pragma unroll
            for (int j = 0; j < 2; ++j) {
                const size_t tl = t0 + wid * 32 + j * 16 + fr;
#pragma unroll
                for (int pt = 0; pt < 4; ++pt) {
                    const uint2 xx = *reinterpret_cast<const uint2*>(p.xbcb + tl * CONVD + e * 64 + pt * 16 + fq * 4);
                    float4 y;
                    y.x = acc[pt][j][0] + Dk * bflo(xx.x); y.y = acc[pt][j][1] + Dk * bfhi(xx.x);
                    y.z = acc[pt][j][2] + Dk * bflo(xx.y); y.w = acc[pt][j][3] + Dk * bfhi(xx.y);
                    *reinterpret_cast<float4*>(p.yraw + tl * DM + e * 64 + pt * 16 + fq * 4) = y;
                }
            }
            {
                const float dec = __expf(acs[127]);
#pragma unroll
                for (int i = 0; i < 2; ++i)
#pragma unroll
                    for (int pt = 0; pt < 4; ++pt) { hT[i][pt][0] *= dec; hT[i][pt][1] *= dec; hT[i][pt][2] *= dec; hT[i][pt][3] *= dec; }
            }
#pragma unroll
            for (int k = 0; k < 4; ++k) {
                const float4 w0 = *reinterpret_cast<const float4*>(wl + k * 32 + fq * 8);
                const float4 w1 = *reinterpret_cast<const float4*>(wl + k * 32 + fq * 8 + 4);
                bf16x8 bt[2];
#pragma unroll
                for (int i = 0; i < 2; ++i) bt[i] = *reinterpret_cast<const bf16x8*>(smem + S_BT + (wid * 32 + i * 16 + fr) * S_RS + (k * 32 + fq * 8) * 2);
#pragma unroll
                for (int pt = 0; pt < 4; ++pt) {
                    const uint4 xr = *reinterpret_cast<const uint4*>(smem + S_XT + (pt * 16 + fr) * S_RS + (k * 32 + fq * 8) * 2);
                    uint4 xs;
                    xs.x = pack_bf16(bflo(xr.x) * w0.x, bfhi(xr.x) * w0.y); xs.y = pack_bf16(bflo(xr.y) * w0.z, bfhi(xr.y) * w0.w);
                    xs.z = pack_bf16(bflo(xr.z) * w1.x, bfhi(xr.z) * w1.y); xs.w = pack_bf16(bflo(xr.w) * w1.z, bfhi(xr.w) * w1.w);
                    const bf16x8 xsf = __builtin_bit_cast(bf16x8, xs);
#pragma unroll
                    for (int i = 0; i < 2; ++i) hT[i][pt] = __builtin_amdgcn_mfma_f32_16x16x32_bf16(bt[i], xsf, hT[i][pt], 0, 0, 0);
                }
            }
            __syncthreads();
        }
#pragma unroll
        for (int i = 0; i < 2; ++i)
#pragma unroll
            for (int pt = 0; pt < 4; ++pt) {
                float4 hv; hv.x = hT[i][pt][0]; hv.y = hT[i][pt][1]; hv.z = hT[i][pt][2]; hv.w = hT[i][pt][3];
                *reinterpret_cast<float4*>(p.out + O_SSMP + (((size_t)(layer * NB + b) * 16 + e) * 64 + pt * 16 + fr) * 128 + wid * 32 + i * 16 + fq * 4) = hv;
            }
    }
}

#define BAR() xcd_barrier(bar)
#define NPAD_IN 5376

__global__ void __launch_bounds__(256, 2) k_fwd(P p) {
    __shared__ uint4 xb_words;
    __shared__ __attribute__((aligned(16))) char smem[73728];
    if (threadIdx.x == 0) xb_words = make_uint4(0u, 0u, 0u, 0u);
    __syncthreads();
    XcdBarrier bar = xcd_barrier_post(p.bar, (volatile LAS unsigned*)&xb_words);

    ph_rope_table(p);
    ph_copy_x(p);
#pragma unroll 1
    for (int l = 0; l < DEPTH; ++l) {
        ph_convert_w(p.w_in + (size_t)l * DM * DIN, DM, DIN, NPAD_IN, p.wt_in + (size_t)l * NPAD_IN * DM, smem);
        ph_convert_w(p.w_ssm_proj + (size_t)l * DM * DM, DM, DM, DM, p.wt_ssm + (size_t)l * DM * DM, smem);
        ph_convert_w(p.w_qb + (size_t)l * QL * 768, QL, 768, 768, p.wt_qb + (size_t)l * 768 * QL, smem);
        ph_convert_w(p.w_kvb + (size_t)l * KVL * 1024, KVL, 1024, 1024, p.wt_kvb + (size_t)l * 1024 * KVL, smem);
        ph_convert_w(p.w_mla_proj + (size_t)l * 512 * DM, 512, DM, DM, p.wt_mla + (size_t)l * DM * 512, smem);
        ph_convert_w(p.w_out + (size_t)l * DM * DM, DM, DM, DM, p.wt_out + (size_t)l * DM * DM, smem);
    }
    ph_convert_plain(p.peer_wq, p.wqb, (size_t)DEPTH * DM * 2048);
    ph_convert_plain(p.peer_keys, p.keysb, (size_t)DEPTH * 16 * 128 * 128);
    ph_convert_plain(p.peer_u, p.ub, (size_t)DEPTH * NEXP * DM);
    ph_convert_plain(p.peer_v, p.vb, (size_t)DEPTH * NEXP * DM);
    BAR();
#pragma unroll 1
    for (int c = 0; c < DEPTH * 16; ++c) {
        const int l = c >> 4, hh = c & 15;
        gemm_bf16(p.keysb + (size_t)c * 128 * 128, 128, p.wqb + (size_t)l * DM * 2048 + hh * 128, 2048, 1, 8, 128, smem,
                  EpiStoreBf{p.wt_pq + (size_t)l * 2048 * DM + (size_t)hh * 128 * DM, DM}, c * 8);
    }
    BAR();
#pragma unroll 1
    for (int l = 0; l < DEPTH; ++l) {
        ph_rmsnorm(p.xres, DM, p.norm_mix + l * DM, nullptr, 0, p.hb, DM, DM, TP);
        BAR();
        gemm_bf16(p.hb, DM, p.wt_in + (size_t)l * NPAD_IN * DM, DM, TP / 128, NPAD_IN / 128, DM, smem, EpiStore{p.proj, DIN, DIN});
        BAR();
        ph_conv(p, l);
        ph_dt(p, l);
        ph_rmsnorm(p.proj + OFF_CQ, DIN, p.q_norm + l * QL, nullptr, 0, p.qnb, QL, QL, TP);
        ph_rmsnorm(p.proj + OFF_CKV, DIN, p.kv_norm + l * KVL, p.lat, KVL, p.latb, KVL, KVL, TP);
        BAR();
        ph_ssd_chunk(p, l, smem);
        ph_ssd_seq(p, l);
        gemm_bf16(p.qnb, QL, p.wt_qb + (size_t)l * 768 * QL, QL, TP / 128, 768 / 128, QL, smem, EpiStore{p.q, 768, 768}, 128);
        gemm_bf16(p.latb, KVL, p.wt_kvb + (size_t)l * 1024 * KVL, KVL, TP / 128, 1024 / 128, KVL, smem, EpiKV{p.kn, p.vT}, 128);
        BAR();
        ph_mla_post(p, l);
        ph_gate_norm(p, l);
        BAR();
        ph_attn(p, smem);
        ph_qlat(p, l);
        gemm_bf16(p.ynb, DM, p.wt_ssm + (size_t)l * DM * DM, DM, TP / 128, DM / 128, DM, smem, EpiStore{p.ya, DM, DM});
        BAR();
        ph_decode_part(p, l, smem);
        BAR();
        ph_decode_comb(p, l, smem);
        BAR();
        gemm_bf16(p.ob, 512, p.wt_mla + (size_t)l * DM * 512, 512, TP / 128, DM / 128, 512, smem, EpiStore{p.yb, DM, DM});
        BAR();
        ph_mix(p, l);
        BAR();
        gemm_bf16(p.mixb, DM, p.wt_out + (size_t)l * DM * DM, DM, TP / 128, DM / 128, DM, smem, EpiAccum{p.xres, DM});
        BAR();
        ph_rmsnorm(p.xres, DM, p.norm_ffn + l * DM, nullptr, 0, p.hb, DM, DM, TP);
        BAR();
        gemm_bf16(p.hb, DM, p.wt_pq + (size_t)l * 2048 * DM, DM, TP / 128, 2048 / 128, DM, smem, EpiStore{p.sc, 2048, 2048});
        BAR();
        ph_peer_topk(p);
        BAR();
        ph_peer_experts2(p, l);
        BAR();
    }
    ph_rmsnorm(p.xres, DM, p.norm_final, p.out + O_YP, DM, nullptr, 0, DM, NT);
}

static inline char* carve_b(char*& cur, size_t bytes) {
    char* r = cur;
    cur += ((bytes + 255) / 256) * 256;
    return r;
}
static inline float* carve(char*& cur, size_t nfloats) { return (float*)carve_b(cur, nfloats * 4); }
static inline bf16_t* carve_h(char*& cur, size_t n) { return (bf16_t*)carve_b(cur, n * 2); }

extern "C" void kernel_launch(void* const* d_in, const int* in_sizes, int n_in,
                              void* d_out, int out_size, void* d_ws, size_t ws_size,
                              hipStream_t stream) {
    P p{};
    p.x_prompt = (const float*)d_in[0]; p.x_sample = (const float*)d_in[1];
    p.cache_lat = (const float*)d_in[2]; p.cache_kr = (const float*)d_in[3];
    p.state_ssm = (const float*)d_in[4]; p.state_conv = (const float*)d_in[5];
    p.page_table = (const int*)d_in[6];
    p.norm_mix = (const float*)d_in[7]; p.w_in = (const float*)d_in[8]; p.b_gate = (const float*)d_in[9];
    p.conv_w = (const float*)d_in[10]; p.conv_b = (const float*)d_in[11]; p.dt_bias = (const float*)d_in[12];
    p.a_log = (const float*)d_in[13]; p.d_skip = (const float*)d_in[14]; p.ssm_norm = (const float*)d_in[15];
    p.w_ssm_proj = (const float*)d_in[16]; p.q_norm = (const float*)d_in[17]; p.w_qb = (const float*)d_in[18];
    p.kv_norm = (const float*)d_in[19]; p.w_kvb = (const float*)d_in[20]; p.w_mla_proj = (const float*)d_in[21];
    p.w_out = (const float*)d_in[22]; p.norm_ffn = (const float*)d_in[23]; p.peer_wq = (const float*)d_in[24];
    p.peer_keys = (const float*)d_in[25]; p.peer_u = (const float*)d_in[26]; p.peer_v = (const float*)d_in[27];
    p.norm_final = (const float*)d_in[28];
    p.out = (float*)d_out;
    char* cur = (char*)d_ws;
    p.bar = (unsigned*)carve(cur, XCD_BAR_WORDS);
    char* zero_begin = (char*)d_ws;
    p.xres = carve(cur, (size_t)TP * DM);
    p.proj = carve(cur, (size_t)TP * DIN);
    p.xbc = carve(cur, (size_t)TP * CONVD);
    p.dt = carve(cur, (size_t)TP * 16);
    p.yraw = carve(cur, (size_t)TP * DM);
    p.ya = carve(cur, (size_t)TP * DM);
    p.q = carve(cur, (size_t)TP * 768);
    p.lat = carve(cur, (size_t)TP * KVL);
    p.kpe = carve(cur, (size_t)TP * 32);
    p.yb = carve(cur, (size_t)TP * DM);
    p.sc = carve(cur, (size_t)TP * 2048);
    p.gate = carve(cur, (size_t)TP * 128);
    p.part = carve(cur, (size_t)NS * 129 * 8 * 258);
    p.qlat = carve(cur, (size_t)NS * 8 * 256);
    p.rope = carve(cur, (size_t)2 * 2049 * 16);
    p.idx = (int*)carve(cur, (size_t)TP * 128);
    p.hb = carve_h(cur, (size_t)TP * DM);
    p.ynb = carve_h(cur, (size_t)TP * DM);
    p.qnb = carve_h(cur, (size_t)TP * QL);
    p.latb = carve_h(cur, (size_t)TP * KVL);
    p.ob = carve_h(cur, (size_t)TP * 512);
    p.mixb = carve_h(cur, (size_t)TP * DM);
    p.qb = carve_h(cur, (size_t)TP * 768);
    p.kn = carve_h(cur, (size_t)TP * 512);
    p.kpeb = carve_h(cur, (size_t)TP * 32);
    p.vT = carve_h(cur, (size_t)NB * 8 * 64 * SEQ);
    p.xbcb = carve_h(cur, (size_t)TP * CONVD);
    char* zero_end = cur;
    p.wt_in = carve_h(cur, (size_t)DEPTH * NPAD_IN * DM);
    p.wt_ssm = carve_h(cur, (size_t)DEPTH * DM * DM);
    p.wt_qb = carve_h(cur, (size_t)DEPTH * 768 * QL);
    p.wt_kvb = carve_h(cur, (size_t)DEPTH * 1024 * KVL);
    p.wt_mla = carve_h(cur, (size_t)DEPTH * DM * 512);
    p.wt_out = carve_h(cur, (size_t)DEPTH * DM * DM);
    p.wt_pq = carve_h(cur, (size_t)DEPTH * 2048 * DM);
    p.wqb = carve_h(cur, (size_t)DEPTH * DM * 2048);
    p.keysb = carve_h(cur, (size_t)DEPTH * 16 * 128 * 128);
    p.ub = carve_h(cur, (size_t)DEPTH * NEXP * DM);
    p.vb = carve_h(cur, (size_t)DEPTH * NEXP * DM);

    (void)hipMemsetAsync(zero_begin, 0, (size_t)(zero_end - zero_begin), stream);

    static int grid = 0;
    if (!grid) {
        int dev = 0, cus = 0, per_cu = 0;
        (void)hipGetDevice(&dev);
        (void)hipDeviceGetAttribute(&cus, hipDeviceAttributeMultiprocessorCount, dev);
        (void)hipOccupancyMaxActiveBlocksPerMultiprocessor(&per_cu, k_fwd, 256, 0);
        if (per_cu > 2) per_cu = 2;
        if (per_cu < 1) per_cu = 1;
        grid = cus * per_cu;
    }
    k_fwd<<<grid, 256, 0, stream>>>(p);
}
```

```cpp
#include <hip/hip_runtime.h>
#include <stdint.h>

#define DM 1024
#define NB 8
#define SEQ 2048
#define NPT (NB * SEQ)
#define NS 32
#define NT (NPT + NS)
#define TP 16512
#define DEPTH 2
#define PAST 16384
#define PAGE 128
#define NPAGES 128
#define NPOOL 5120
#define DIN 5296
#define OFF_GA 0
#define OFF_GB 1024
#define OFF_Z 2048
#define OFF_XBC 3072
#define OFF_DT 4608
#define OFF_CQ 4624
#define OFF_CKV 5008
#define OFF_KR 5264
#define CONVD 1536
#define QL 384
#define KVL 256
#define NEXP 16384
#define EPSF 1e-6f
#define ATT_SCALE 0.10206207261596577f

#define O_YP 0
#define O_YS (O_YP + NPT * DM)
#define O_LATP (O_YS + NS * DM)
#define O_KRP (O_LATP + DEPTH * NPT * KVL)
#define O_SSMP (O_KRP + DEPTH * NPT * 32)
#define O_CONVP (O_SSMP + DEPTH * NB * 16 * 64 * 128)
#define O_LATS (O_CONVP + DEPTH * NB * 3 * CONVD)
#define O_KRS (O_LATS + DEPTH * NS * KVL)
#define O_SSMS (O_KRS + DEPTH * NS * 32)
#define O_CONVS (O_SSMS + DEPTH * NS * 16 * 64 * 128)

struct P {
    const float *x_prompt, *x_sample, *cache_lat, *cache_kr, *state_ssm, *state_conv;
    const int* page_table;
    const float *norm_mix, *w_in, *b_gate, *conv_w, *conv_b, *dt_bias, *a_log, *d_skip, *ssm_norm, *w_ssm_proj;
    const float *q_norm, *w_qb, *kv_norm, *w_kvb, *w_mla_proj, *w_out, *norm_ffn, *peer_wq, *peer_keys, *peer_u, *peer_v, *norm_final;
    float* out;
    float *xres, *h, *proj, *xbc, *dt, *yraw, *yn, *ya, *qn, *q, *lat, *kpe, *kv, *o, *yb, *mix, *pq, *sc, *gate, *part, *qlat, *rope;
    int* idx;
    unsigned* bar;
    unsigned short *hb, *ynb, *qnb, *latb, *ob, *mixb, *qb, *kn, *kpeb, *vT, *xbcb;
    unsigned short *wt_in, *wt_ssm, *wt_qb, *wt_kvb, *wt_mla, *wt_out, *wt_pq, *wqb, *keysb;
    unsigned char *u8, *v8;
    float *uinv, *vinv;
};

#define XB_TMO      128
#define XB_XCNT(j)  (256  + 64 * (j))
#define XB_XSUB(j)  (1280 + 64 * (j))
#define XB_XGEN(j)  (2304 + 64 * (j))
#define XB_TOP      3328
#define XB_TOPGEN   3392
#define XCD_BAR_WORDS 3456
#define XB_SPIN_CAP (1u << 18)
#define LAS __attribute__((address_space(3)))

__device__ __forceinline__ unsigned xb_ld(unsigned* p)              { return __hip_atomic_load(p, __ATOMIC_RELAXED, __HIP_MEMORY_SCOPE_AGENT); }
__device__ __forceinline__ unsigned xb_add(unsigned* p, unsigned v) { return __hip_atomic_fetch_add(p, v, __ATOMIC_RELAXED, __HIP_MEMORY_SCOPE_AGENT); }
__device__ __forceinline__ unsigned xb_xcc_id() { return (unsigned)__builtin_amdgcn_s_getreg((3 << 11) | 20) & 0xFu; }
#define XB_SPIN(cond, bar) do { unsigned _sp = 0; while (cond) { __builtin_amdgcn_s_sleep(1); \
    if ((++_sp & 255u) == 0u) { if (xb_ld(&(bar)[XB_TMO])) break; if (_sp > XB_SPIN_CAP) { atomicAdd(&(bar)[XB_TMO], 1u); break; } } } } while (0)

struct XcdBarrier {
    unsigned* bar; unsigned x;
    volatile LAS unsigned* st;
};

__device__ __forceinline__ XcdBarrier xcd_barrier_post(unsigned* bar, volatile LAS unsigned* st) {
    XcdBarrier b; b.bar = bar; b.x = xb_xcc_id(); b.st = st;
    if (threadIdx.x == 0) (void)xb_add(&bar[XB_XCNT(b.x)], 1u);
    return b;
}
__device__ __forceinline__ void xcd_barrier_complete(unsigned* bar, unsigned x, unsigned& nloc, unsigned& nx) {
    const unsigned G = gridDim.x * gridDim.y * gridDim.z;
    unsigned sum, cnt, mine, sp = 0u;
    for (;;) {
        sum = 0u; cnt = 0u; mine = 0u;
#pragma unroll
        for (unsigned j = 0; j < 16; ++j) { const unsigned c = xb_ld(&bar[XB_XCNT(j)]); sum += c; cnt += (c > 0u) ? 1u : 0u; mine = (j == x) ? c : mine; }
        if (sum == G) break;
        __builtin_amdgcn_s_sleep(1);
        if ((++sp & 255u) == 0u) { if (xb_ld(&bar[XB_TMO])) break; if (sp > XB_SPIN_CAP) { atomicAdd(&bar[XB_TMO], 1u); break; } }
    }
    nloc = mine > 0u ? mine : 1u; nx = cnt > 0u ? cnt : 1u;
}

__device__ __forceinline__ void xcd_barrier(const XcdBarrier& b) {
    asm volatile("s_waitcnt vmcnt(0)" ::: "memory");
    __syncthreads();
    if (threadIdx.x == 0) {
        unsigned* bar = b.bar;
        __builtin_amdgcn_s_waitcnt(0);
        unsigned nloc = b.st[0], nx = b.st[1];
        if (nloc == 0u) { xcd_barrier_complete(bar, b.x, nloc, nx); b.st[0] = nloc; b.st[1] = nx; }
        const unsigned old = xb_add(&bar[XB_XSUB(b.x)], 1u);
        const unsigned gen = old / nloc;
        if (old + 1u == (gen + 1u) * nloc) {
            __builtin_amdgcn_fence(__ATOMIC_RELEASE, "agent");
            asm volatile("s_waitcnt vmcnt(0)" ::: "memory");
            const unsigned og = xb_add(&bar[XB_TOP], 1u);
            const unsigned tg = og / nx;
            if (og + 1u == (tg + 1u) * nx) xb_add(&bar[XB_TOPGEN], 1u);
            else XB_SPIN(xb_ld(&bar[XB_TOPGEN]) == tg, bar);
            __builtin_amdgcn_fence(__ATOMIC_ACQUIRE, "agent");
            xb_add(&bar[XB_XGEN(b.x)], 1u);
            asm volatile("s_waitcnt vmcnt(0)" ::: "memory");
        } else {
            XB_SPIN(xb_ld(&bar[XB_XGEN(b.x)]) == gen, bar);
            __builtin_amdgcn_fence(__ATOMIC_ACQUIRE, "agent");
            asm volatile("s_waitcnt vmcnt(0)" ::: "memory");
        }
    }
    __syncthreads();
}


__device__ __forceinline__ float wave_sum(float v) {
#pragma unroll
    for (int o = 32; o > 0; o >>= 1) v += __shfl_xor(v, o);
    return v;
}
__device__ __forceinline__ float wave_max(float v) {
#pragma unroll
    for (int o = 32; o > 0; o >>= 1) v = fmaxf(v, __shfl_xor(v, o));
    return v;
}
__device__ __forceinline__ float silu_f(float x) { return x / (1.f + expf(-x)); }
__device__ __forceinline__ float sigmoid_f(float x) { return 1.f / (1.f + expf(-x)); }


__device__ __forceinline__ int opaque_v(int x) { asm volatile("" : "+v"(x)); return x; }
__device__ __forceinline__ int opaque_s(int x) { asm volatile("" : "+s"(x)); return x; }

#ifndef PROBE_GEMM
#define PROBE_GEMM 0
#endif
#ifndef PROBE_TOPK
#define PROBE_TOPK 0
#endif
#ifndef PROBE_ATTN
#define PROBE_ATTN 0
#endif
#ifndef PROBE_DEC
#define PROBE_DEC 0
#endif
#ifndef PROBE_SSD
#define PROBE_SSD 0
#endif
#ifndef PROBE_ELEM
#define PROBE_ELEM 0
#endif
#ifndef PROBE_EXP
#define PROBE_EXP 0
#endif
#ifndef PROBE_PRO
#define PROBE_PRO 0
#endif
#define NTHR 256
#define VB_LOOP(n) for (int vb = bid_; vb < (n); vb += gridDim.x)


typedef unsigned short bf16_t;
using bf16x8 = __attribute__((ext_vector_type(8))) short;
using f32x4 = __attribute__((ext_vector_type(4))) float;
typedef __attribute__((ext_vector_type(2))) __bf16 bf16x2_t;
__device__ __forceinline__ bf16_t f2bf(float f) { __bf16 h = (__bf16)f; return __builtin_bit_cast(unsigned short, h); }
__device__ __forceinline__ unsigned pack_bf16(float a, float b) { bf16x2_t r; r[0] = (__bf16)a; r[1] = (__bf16)b; return __builtin_bit_cast(unsigned, r); }
__device__ __forceinline__ float bf2f(bf16_t h) { return __uint_as_float(((unsigned)h) << 16); }

__device__ __forceinline__ int lds_byte(int r, int c) {
    int st = (r >> 4) * 2 + (c >> 5), rr = r & 15, cc = c & 31, ob = rr * 64 + cc * 2;
    return st * 1024 + (ob ^ (((ob >> 9) & 1) << 5));
}
__device__ __forceinline__ void stage_rc(int b, int& R, int& C) {
    int st = b / 1024, sb = b % 1024, swz = sb ^ (((sb >> 9) & 1) << 5);
    R = (st >> 1) * 16 + swz / 64; C = (st & 1) * 32 + (swz % 64) / 2;
}
__device__ __forceinline__ void stage_tile(const bf16_t* base, int ld, int row0, int k0, char* dst, int tid) {
#pragma unroll
    for (int i = 0; i < 4; ++i) {
        int b = tid * 16 + i * 4096;
        int R, C; stage_rc(b, R, C);
        const bf16_t* src = base + (size_t)(row0 + R) * ld + k0 + C;
        __builtin_amdgcn_global_load_lds((const unsigned*)src, (unsigned*)(dst + b), 16, 0, 0);
    }
}
template <class Epi>
__device__ __forceinline__ void gemm_bf16(const bf16_t* A, int lda, const bf16_t* Bt, int ldb, int mtiles, int ntiles, int K, char* smem, Epi epi, int vb0 = 0) {
    const int tid = opaque_v((int)threadIdx.x);
    int bid0 = (int)blockIdx.x - vb0;
    while (bid0 < 0) bid0 += (int)gridDim.x;
    const int bid = opaque_s(__builtin_amdgcn_readfirstlane(bid0));
    const int wid = tid >> 6, lane = tid & 63, wm = wid >> 1, wn = wid & 1, fr = lane & 15, fq = lane >> 4;
    const int nk = K / 64;
    for (int vb = bid; vb < mtiles * ntiles; vb += gridDim.x) {
        const int m0 = (vb / ntiles) * 128, n0 = (vb % ntiles) * 128;
        f32x4 acc[4][4];
#pragma unroll
        for (int i = 0; i < 4; ++i)
#pragma unroll
            for (int j = 0; j < 4; ++j) acc[i][j] = f32x4{0.f, 0.f, 0.f, 0.f};
        stage_tile(A, lda, m0, 0, smem, tid);
        stage_tile(Bt, ldb, n0, 0, smem + 16384, tid);
        for (int kt = 0; kt < nk; ++kt) {
            asm volatile("s_waitcnt vmcnt(0)" ::: "memory");
            __syncthreads();
            if (kt + 1 < nk) {
                char* nb = smem + ((kt + 1) & 1) * 32768;
                stage_tile(A, lda, m0, (kt + 1) * 64, nb, tid);
                stage_tile(Bt, ldb, n0, (kt + 1) * 64, nb + 16384, tid);
            }
            const char* ab = smem + (kt & 1) * 32768;
            const char* bb = ab + 16384;
#pragma unroll
            for (int s = 0; s < 2; ++s) {
                bf16x8 a[4], b[4];
#pragma unroll
                for (int i = 0; i < 4; ++i) a[i] = *reinterpret_cast<const bf16x8*>(ab + lds_byte(wm * 64 + i * 16 + fr, s * 32 + fq * 8));
#pragma unroll
                for (int j = 0; j < 4; ++j) b[j] = *reinterpret_cast<const bf16x8*>(bb + lds_byte(wn * 64 + j * 16 + fr, s * 32 + fq * 8));
#pragma unroll
                for (int i = 0; i < 4; ++i)
#pragma unroll
                    for (int j = 0; j < 4; ++j) acc[i][j] = __builtin_amdgcn_mfma_f32_16x16x32_bf16(a[i], b[j], acc[i][j], 0, 0, 0);
            }
        }
#pragma unroll
        for (int i = 0; i < 4; ++i)
#pragma unroll
            for (int j = 0; j < 4; ++j)
#pragma unroll
                for (int r = 0; r < 4; ++r) epi(m0 + wm * 64 + i * 16 + fq * 4 + r, n0 + wn * 64 + j * 16 + fr, acc[i][j][r]);
        __syncthreads();
    }
}
struct EpiStore { float* C; int ldc; int N; __device__ __forceinline__ void operator()(int m, int n, float v) const { if (n < N) C[(size_t)m * ldc + n] = v; } };
struct EpiAccum { float* C; int ldc; __device__ __forceinline__ void operator()(int m, int n, float v) const { C[(size_t)m * ldc + n] += v; } };

__device__ __forceinline__ void ph_convert_plain(const float* src, bf16_t* dst, size_t n) {
    const int tid = opaque_v((int)threadIdx.x); const int bid = opaque_s((int)blockIdx.x);
    for (size_t i = ((size_t)bid * NTHR + tid) * 4; i < n; i += (size_t)gridDim.x * NTHR * 4) {
        float4 v = *(const float4*)(src + i);
        ushort4 o; o.x = f2bf(v.x); o.y = f2bf(v.y); o.z = f2bf(v.z); o.w = f2bf(v.w);
        *(ushort4*)(dst + i) = o;
    }
}
struct EpiStoreBf { bf16_t* C; int ldc; __device__ __forceinline__ void operator()(int m, int n, float v) const { C[(size_t)m * ldc + n] = f2bf(v); } };
__device__ __forceinline__ void ph_convert_w(const float* W, int K, int N, int Npad, bf16_t* Bt, char* smem) {
    const int tid = opaque_v((int)threadIdx.x); const int bid = opaque_s((int)blockIdx.x);
    float (*t)[65] = (float (*)[65])smem;
    int tk = K / 64, tn = Npad / 64;
    for (int vb = bid; vb < tk * tn; vb += gridDim.x) {
        int k0 = (vb % tk) * 64, n0 = (vb / tk) * 64;
        for (int i = tid; i < 64 * 64; i += NTHR) {
            int kk = i >> 6, nn = i & 63;
            t[kk][nn] = (n0 + nn < N) ? W[(size_t)(k0 + kk) * N + n0 + nn] : 0.f;
        }
        __syncthreads();
        for (int i = tid; i < 64 * 64; i += NTHR) {
            int nn = i >> 6, kk = i & 63;
            Bt[(size_t)(n0 + nn) * K + k0 + kk] = f2bf(t[kk][nn]);
        }
        __syncthreads();
    }
}

__device__ __forceinline__ void ph_rope_table(const P& p) {
    const int tid_ = opaque_v((int)threadIdx.x); const int bid_ = opaque_s((int)blockIdx.x); (void)tid_; (void)bid_;
    for (int i = bid_ * NTHR + tid_; i < 2049 * 16; i += gridDim.x * NTHR) {
        int pi = i / 16, j = i % 16;
        float pos = (pi == 2048) ? 16384.f : (float)pi;
        float inv = powf(10000.f, -(float)j / 16.f);
        float ang = pos * inv;
        p.rope[i] = (float)cos((double)ang);
        p.rope[2049 * 16 + i] = (float)sin((double)ang);
    }
}
__device__ __forceinline__ void ph_copy_x(const P& p) {
    const int tid_ = opaque_v((int)threadIdx.x); const int bid_ = opaque_s((int)blockIdx.x); (void)tid_; (void)bid_;
    size_t n = (size_t)TP * DM;
    for (size_t i = (size_t)bid_ * NTHR + tid_; i < n; i += (size_t)gridDim.x * NTHR) {
        size_t t = i / DM;
        float v = 0.f;
        if (t < NPT) v = p.x_prompt[i];
        else if (t < NT) v = p.x_sample[i - (size_t)NPT * DM];
        p.xres[i] = v;
    }
}
__device__ __forceinline__ void ph_rmsnorm(const float* in, int ldi, const float* w, float* out, int ldo, bf16_t* outb, int ldob, int D, int rows) {
    const int tid_ = opaque_v((int)threadIdx.x); const int bid_ = opaque_s((int)blockIdx.x); (void)tid_; (void)bid_;
    VB_LOOP((rows + 3) / 4) {
        int row = vb * 4 + (tid_ >> 6);
        int lane = tid_ & 63;
        if (row < rows) {
            const float* x = in + (size_t)row * ldi;
            float s = 0.f;
            for (int c = lane; c < D; c += 64) { float v = x[c]; s += v * v; }
            s = wave_sum(s);
            float r = rsqrtf(s / (float)D + EPSF);
            for (int c = lane; c < D; c += 64) {
                float v = x[c] * r * w[c];
                if (out) out[(size_t)row * ldo + c] = v;
                if (outb) outb[(size_t)row * ldob + c] = f2bf(v);
            }
        }
    }
}
__device__ __forceinline__ void ph_conv(const P& p, int layer) {
    const int tid_ = opaque_v((int)threadIdx.x); const int bid_ = opaque_s((int)blockIdx.x); (void)tid_; (void)bid_;
    const size_t n = (size_t)NT * CONVD;
    for (size_t i = (size_t)bid_ * NTHR + tid_; i < n; i += (size_t)gridDim.x * NTHR) {
        int t = (int)(i / CONVD), c = (int)(i % CONVD);
        const float* cw = p.conv_w + (size_t)layer * 4 * CONVD;
        float acc = p.conv_b[layer * CONVD + c];
        float raw = p.proj[(size_t)t * DIN + OFF_XBC + c];
        if (t < NPT) {
            int b = t / SEQ, l = t % SEQ;
#pragma unroll
            for (int k = 0; k < 4; ++k) {
                int ls = l + k - 3;
                if (ls >= 0) acc += p.proj[(size_t)(t + k - 3) * DIN + OFF_XBC + c] * cw[k * CONVD + c];
            }
            if (l >= SEQ - 3) p.out[O_CONVP + ((size_t)(layer * NB + b) * 3 + (l - (SEQ - 3))) * CONVD + c] = raw;
        } else {
            int bs = t - NPT;
            const float* prev = p.state_conv + ((size_t)(layer * NS + bs) * 3) * CONVD;
#pragma unroll
            for (int k = 0; k < 3; ++k) acc += prev[k * CONVD + c] * cw[k * CONVD + c];
            acc += raw * cw[3 * CONVD + c];
            float* oc = p.out + O_CONVS + ((size_t)(layer * NS + bs) * 3) * CONVD;
            oc[0 * CONVD + c] = prev[1 * CONVD + c];
            oc[1 * CONVD + c] = prev[2 * CONVD + c];
            oc[2 * CONVD + c] = raw;
        }
        const float sv = silu_f(acc);
        p.xbc[(size_t)t * CONVD + c] = sv;
        p.xbcb[(size_t)t * CONVD + c] = f2bf(sv);
    }
}
__device__ __forceinline__ void ph_dt(const P& p, int layer) {
    const int tid_ = opaque_v((int)threadIdx.x); const int bid_ = opaque_s((int)blockIdx.x); (void)tid_; (void)bid_;
    for (int i = bid_ * NTHR + tid_; i < NT * 16; i += gridDim.x * NTHR) {
        int t = i / 16, e = i % 16;
        float x = p.proj[(size_t)t * DIN + OFF_DT + e] + p.dt_bias[layer * 16 + e];
        p.dt[i] = (x > 20.f) ? x : log1pf(expf(x));
    }
}
__device__ __forceinline__ void ph_ssd_seq(const P& p, int layer) {
    const int tid_ = opaque_v((int)threadIdx.x); const int bid_ = opaque_s((int)blockIdx.x); (void)tid_; (void)bid_;
    VB_LOOP(NS * 16) {
        int seq = NB + vb / 16, e = vb % 16, g = e / 8;
        int pp = tid_ >> 2, nq = tid_ & 3;
        float A = -expf(p.a_log[layer * 16 + e]);
        float Dk = p.d_skip[layer * 16 + e];
        float s[32];
        int t0, L;
        float* hout;
        if (seq < NB) {
            t0 = seq * SEQ; L = SEQ;
#pragma unroll
            for (int j = 0; j < 32; ++j) s[j] = 0.f;
            hout = p.out + O_SSMP + (((size_t)(layer * NB + seq) * 16 + e) * 64 + pp) * 128 + nq * 32;
        } else {
            int bs = seq - NB;
            t0 = NPT + bs; L = 1;
            const float* h0 = p.state_ssm + (((size_t)(layer * NS + bs) * 16 + e) * 64 + pp) * 128 + nq * 32;
#pragma unroll
            for (int j = 0; j < 32; ++j) s[j] = h0[j];
            hout = p.out + O_SSMS + (((size_t)(layer * NS + bs) * 16 + e) * 64 + pp) * 128 + nq * 32;
        }
        for (int l = 0; l < L; ++l) {
            int t = t0 + l;
            float dt = p.dt[t * 16 + e];
            float dA = expf(dt * A);
            const float* xr = p.xbc + (size_t)t * CONVD;
            float xv = xr[e * 64 + pp];
            float xdt = xv * dt;
            const float4* Bp = (const float4*)(xr + 1024 + g * 128 + nq * 32);
            const float4* Cp = (const float4*)(xr + 1280 + g * 128 + nq * 32);
            float ys = 0.f;
#pragma unroll
            for (int j4 = 0; j4 < 8; ++j4) {
                float4 b = Bp[j4], c = Cp[j4];
                s[j4 * 4 + 0] = s[j4 * 4 + 0] * dA + xdt * b.x; ys += c.x * s[j4 * 4 + 0];
                s[j4 * 4 + 1] = s[j4 * 4 + 1] * dA + xdt * b.y; ys += c.y * s[j4 * 4 + 1];
                s[j4 * 4 + 2] = s[j4 * 4 + 2] * dA + xdt * b.z; ys += c.z * s[j4 * 4 + 2];
                s[j4 * 4 + 3] = s[j4 * 4 + 3] * dA + xdt * b.w; ys += c.w * s[j4 * 4 + 3];
            }
            ys += __shfl_xor(ys, 1);
            ys += __shfl_xor(ys, 2);
            if (nq == 0) p.yraw[(size_t)t * DM + e * 64 + pp] = ys + Dk * xv;
        }
#pragma unroll
        for (int j = 0; j < 32; ++j) hout[j] = s[j];
    }
}
__device__ __forceinline__ void ph_gate_norm(const P& p, int layer) {
    const int tid_ = opaque_v((int)threadIdx.x); const int bid_ = opaque_s((int)blockIdx.x); (void)tid_; (void)bid_;
    VB_LOOP((NT * 2 + 3) / 4) {
        int w = vb * 4 + (tid_ >> 6);
        int lane = tid_ & 63;
        if (w < NT * 2) {
            int t = w >> 1, g = w & 1;
            float v[8];
            float ss = 0.f;
#pragma unroll
            for (int j = 0; j < 8; ++j) {
                int c = g * 512 + j * 64 + lane;
                float y = p.yraw[(size_t)t * DM + c];
                float z = p.proj[(size_t)t * DIN + OFF_Z + c];
                v[j] = y * silu_f(z);
                ss += v[j] * v[j];
            }
            ss = wave_sum(ss);
            float r = rsqrtf(ss / 512.f + EPSF);
#pragma unroll
            for (int j = 0; j < 8; ++j) {
                int c = g * 512 + j * 64 + lane;
                p.ynb[(size_t)t * DM + c] = f2bf(v[j] * r * p.ssm_norm[layer * DM + c]);
            }
        }
    }
}
__device__ __forceinline__ void ph_mla_post(const P& p, int layer) {
    const int tid_ = opaque_v((int)threadIdx.x); const int bid_ = opaque_s((int)blockIdx.x); (void)tid_; (void)bid_;
    VB_LOOP((NT + 3) / 4) {
        int t = vb * 4 + (tid_ >> 6);
        int lane = tid_ & 63;
        if (t < NT) {
            int pi = (t < NPT) ? (t % SEQ) : 2048;
            const float* cs = p.rope + pi * 16;
            const float* sn = p.rope + 2049 * 16 + pi * 16;
            const float qsc = ATT_SCALE * 1.4426950408889634f;
#pragma unroll
            for (int r = 0; r < 2; ++r) {
                int id = lane + r * 64;
                int hh = id >> 4, j = id & 15;
                float* qp = p.q + (size_t)t * 768 + hh * 96 + 64;
                float x1 = qp[j], x2 = qp[16 + j];
                float o1 = x1 * cs[j] - x2 * sn[j];
                float o2 = x1 * sn[j] + x2 * cs[j];
                qp[j] = o1;
                qp[16 + j] = o2;
                p.qb[(size_t)t * 768 + hh * 96 + 64 + j] = f2bf(o1 * qsc);
                p.qb[(size_t)t * 768 + hh * 96 + 80 + j] = f2bf(o2 * qsc);
            }
#pragma unroll
            for (int r = 0; r < 8; ++r) {
                int id = lane + r * 64;
                int hh = id >> 6, d = id & 63;
                p.qb[(size_t)t * 768 + hh * 96 + d] = f2bf(p.q[(size_t)t * 768 + hh * 96 + d] * qsc);
            }
            if (lane < 16) {
                const float* kr = p.proj + (size_t)t * DIN + OFF_KR;
                float x1 = kr[lane], x2 = kr[16 + lane];
                float o1 = x1 * cs[lane] - x2 * sn[lane];
                float o2 = x1 * sn[lane] + x2 * cs[lane];
                p.kpe[(size_t)t * 32 + lane] = o1;
                p.kpe[(size_t)t * 32 + 16 + lane] = o2;
                p.kpeb[(size_t)t * 32 + lane] = f2bf(o1);
                p.kpeb[(size_t)t * 32 + 16 + lane] = f2bf(o2);
                float* ok = (t < NPT) ? (p.out + O_KRP + ((size_t)layer * NPT + t) * 32) : (p.out + O_KRS + ((size_t)layer * NS + (t - NPT)) * 32);
                ok[lane] = o1; ok[16 + lane] = o2;
            }
            float* ol = (t < NPT) ? (p.out + O_LATP + ((size_t)layer * NPT + t) * KVL) : (p.out + O_LATS + ((size_t)layer * NS + (t - NPT)) * KVL);
#pragma unroll
            for (int r = 0; r < 4; ++r) ol[lane + r * 64] = p.lat[(size_t)t * KVL + lane + r * 64];
        }
    }
}

#define A_KRS 208
#define A_VRS 144
#define A_KBYTES (64 * A_KRS)
#define A_BUF (64 * A_KRS + 64 * A_VRS)
struct EpiKV { bf16_t* kn; bf16_t* vT; __device__ __forceinline__ void operator()(int m, int n, float v) const {
    int h = n >> 7, j = n & 127;
    if (j < 64) kn[(size_t)m * 512 + h * 64 + j] = f2bf(v);
    else if (m < NPT) vT[((size_t)((m >> 11) * 8 + h) * 64 + (j - 64)) * SEQ + (m & (SEQ - 1))] = f2bf(v);
} };
__device__ __forceinline__ void ph_attn(const P& p, char* smem) {
    const int tid = opaque_v((int)threadIdx.x); const int bid = opaque_s((int)blockIdx.x);
    const int wid = tid >> 6, lane = tid & 63, fr = lane & 15, fq = lane >> 4;
    const int G = (int)gridDim.x;
    for (int rnd = 0;; ++rnd) {
        int o = rnd * G + ((rnd & 1) ? (G - 1 - bid) : bid);
        if (rnd * G >= 1024) break;
        if (o >= 1024) continue;
        const int qblk = 15 - (o >> 6), bh = o & 63, b = bh >> 3, h = bh & 7;
        const int q0w = qblk * 128 + wid * 32;
        const size_t tok0 = (size_t)b * SEQ;
        bf16x8 qf[2][3];
#pragma unroll
        for (int qt = 0; qt < 2; ++qt)
#pragma unroll
            for (int s3 = 0; s3 < 3; ++s3)
                qf[qt][s3] = *reinterpret_cast<const bf16x8*>(p.qb + (tok0 + q0w + qt * 16 + fr) * 768 + h * 96 + s3 * 32 + fq * 8);
        f32x4 oacc[2][4];
        float mrun[2], lrun[2];
#pragma unroll
        for (int qt = 0; qt < 2; ++qt) {
            mrun[qt] = -INFINITY; lrun[qt] = 0.f;
#pragma unroll
            for (int mt = 0; mt < 4; ++mt) oacc[qt][mt] = f32x4{0.f, 0.f, 0.f, 0.f};
        }
        const int nkb = 2 * qblk + 2;
        uint4 stg0, stg1, stg2, stg3, stg4;
#define A_ISSUE(kb_) do { const size_t key0 = (size_t)(kb_) * 64; \
            { int c = tid; int row = c >> 3, ch = c & 7; stg0 = *reinterpret_cast<const uint4*>(p.kn + (tok0 + key0 + row) * 512 + h * 64 + ch * 8); } \
            { int c = tid + 256; int row = c >> 3, ch = c & 7; stg1 = *reinterpret_cast<const uint4*>(p.kn + (tok0 + key0 + row) * 512 + h * 64 + ch * 8); } \
            { int c = tid; int row = c >> 2, ch = c & 3; stg2 = *reinterpret_cast<const uint4*>(p.kpeb + (tok0 + key0 + row) * 32 + ch * 8); } \
            { int c = tid; int row = c >> 3, ch = c & 7; stg3 = *reinterpret_cast<const uint4*>(p.vT + ((size_t)(b * 8 + h) * 64 + row) * SEQ + key0 + ch * 8); } \
            { int c = tid + 256; int row = c >> 3, ch = c & 7; stg4 = *reinterpret_cast<const uint4*>(p.vT + ((size_t)(b * 8 + h) * 64 + row) * SEQ + key0 + ch * 8); } \
        } while (0)
#define A_COMMIT(buf_) do { char* buf = (buf_); \
            { int c = tid; int row = c >> 3, ch = c & 7; *reinterpret_cast<uint4*>(buf + row * A_KRS + ch * 16) = stg0; } \
            { int c = tid + 256; int row = c >> 3, ch = c & 7; *reinterpret_cast<uint4*>(buf + row * A_KRS + ch * 16) = stg1; } \
            { int c = tid; int row = c >> 2, ch = c & 3; *reinterpret_cast<uint4*>(buf + row * A_KRS + 128 + ch * 16) = stg2; } \
            { int c = tid; int row = c >> 3, ch = c & 7; *reinterpret_cast<uint4*>(buf + A_KBYTES + row * A_VRS + ch * 16) = stg3; } \
            { int c = tid + 256; int row = c >> 3, ch = c & 7; *reinterpret_cast<uint4*>(buf + A_KBYTES + row * A_VRS + ch * 16) = stg4; } \
        } while (0)
        A_ISSUE(0);
        A_COMMIT(smem);
        __syncthreads();
        for (int kb = 0; kb < nkb; ++kb) {
            const char* kbuf = smem + (kb & 1) * A_BUF;
            const char* vbuf = kbuf + A_KBYTES;
            if (kb + 1 < nkb) A_ISSUE(kb + 1);
#pragma unroll
            for (int kh = 0; kh < 2; ++kh) {
                const int k0 = kb * 64 + kh * 32;
                if (k0 <= q0w + 31) {
                    f32x4 st[2][2];
#pragma unroll
                    for (int qt = 0; qt < 2; ++qt)
#pragma unroll
                        for (int kt = 0; kt < 2; ++kt) st[qt][kt] = f32x4{0.f, 0.f, 0.f, 0.f};
#pragma unroll
                    for (int s3 = 0; s3 < 3; ++s3)
#pragma unroll
                        for (int kt = 0; kt < 2; ++kt) {
                            bf16x8 kf = *reinterpret_cast<const bf16x8*>(kbuf + (kh * 32 + kt * 16 + fr) * A_KRS + (s3 * 32 + fq * 8) * 2);
#pragma unroll
                            for (int qt = 0; qt < 2; ++qt) st[qt][kt] = __builtin_amdgcn_mfma_f32_16x16x32_bf16(kf, qf[qt][s3], st[qt][kt], 0, 0, 0);
                        }
                    const bool need_mask = (k0 + 31 > q0w);
                    bf16x8 pf[2];
#pragma unroll
                    for (int qt = 0; qt < 2; ++qt) {
                        if (need_mask) {
                            const int qi = q0w + qt * 16 + fr;
#pragma unroll
                            for (int kt = 0; kt < 2; ++kt)
#pragma unroll
                                for (int r = 0; r < 4; ++r)
                                    if (k0 + kt * 16 + fq * 4 + r > qi) st[qt][kt][r] = -INFINITY;
                        }
                        float mx = fmaxf(fmaxf(fmaxf(st[qt][0][0], st[qt][0][1]), fmaxf(st[qt][0][2], st[qt][0][3])),
                                         fmaxf(fmaxf(st[qt][1][0], st[qt][1][1]), fmaxf(st[qt][1][2], st[qt][1][3])));
                        mx = fmaxf(mx, __shfl_xor(mx, 16));
                        mx = fmaxf(mx, __shfl_xor(mx, 32));
                        const float mnew = fmaxf(mrun[qt], mx);
                        const float corr = __builtin_amdgcn_exp2f(mrun[qt] - mnew);
                        float pv[8];
                        float rs = 0.f;
#pragma unroll
                        for (int kt = 0; kt < 2; ++kt)
#pragma unroll
                            for (int r = 0; r < 4; ++r) { pv[kt * 4 + r] = __builtin_amdgcn_exp2f(st[qt][kt][r] - mnew); rs += pv[kt * 4 + r]; }
                        rs += __shfl_xor(rs, 16);
                        rs += __shfl_xor(rs, 32);
                        lrun[qt] = lrun[qt] * corr + rs;
                        mrun[qt] = mnew;
#pragma unroll
                        for (int mt = 0; mt < 4; ++mt) { oacc[qt][mt][0] *= corr; oacc[qt][mt][1] *= corr; oacc[qt][mt][2] *= corr; oacc[qt][mt][3] *= corr; }
                        uint4 pk;
                        pk.x = pack_bf16(pv[0], pv[1]); pk.y = pack_bf16(pv[2], pv[3]); pk.z = pack_bf16(pv[4], pv[5]); pk.w = pack_bf16(pv[6], pv[7]);
                        pf[qt] = __builtin_bit_cast(bf16x8, pk);
                    }
#pragma unroll
                    for (int mt = 0; mt < 4; ++mt) {
                        const char* vp = vbuf + (mt * 16 + fr) * A_VRS + (kh * 32 + fq * 4) * 2;
                        uint2 lo = *reinterpret_cast<const uint2*>(vp);
                        uint2 hi = *reinterpret_cast<const uint2*>(vp + 32);
                        uint4 vv; vv.x = lo.x; vv.y = lo.y; vv.z = hi.x; vv.w = hi.y;
                        bf16x8 vf = __builtin_bit_cast(bf16x8, vv);
#pragma unroll
                        for (int qt = 0; qt < 2; ++qt) oacc[qt][mt] = __builtin_amdgcn_mfma_f32_16x16x32_bf16(vf, pf[qt], oacc[qt][mt], 0, 0, 0);
                    }
                }
            }
            if (kb + 1 < nkb) A_COMMIT(smem + ((kb + 1) & 1) * A_BUF);
            __syncthreads();
        }
#pragma unroll
        for (int qt = 0; qt < 2; ++qt) {
            const float inv = 1.f / lrun[qt];
            bf16_t* op = p.ob + (tok0 + q0w + qt * 16 + fr) * 512 + h * 64 + fq * 4;
#pragma unroll
            for (int mt = 0; mt < 4; ++mt) {
                uint2 w;
                w.x = pack_bf16(oacc[qt][mt][0] * inv, oacc[qt][mt][1] * inv);
                w.y = pack_bf16(oacc[qt][mt][2] * inv, oacc[qt][mt][3] * inv);
                *reinterpret_cast<uint2*>(op + mt * 16) = w;
            }
        }
    }
}
__device__ __forceinline__ void ph_qlat(const P& p, int layer) {
    const int tid_ = opaque_v((int)threadIdx.x); const int bid_ = opaque_s((int)blockIdx.x); (void)tid_; (void)bid_;
    VB_LOOP(NS * 8) {
        int bs = vb / 8, h = vb % 8;
        int r = tid_;
        const float* qp = p.q + (size_t)(NPT + bs) * 768 + h * 96;
        const float* w = p.w_kvb + (size_t)layer * 256 * 1024 + (size_t)r * 1024 + h * 128;
        float s = 0.f;
        for (int d = 0; d < 64; ++d) s += qp[d] * w[d];
        p.qlat[((size_t)bs * 8 + h) * 256 + r] = s * ATT_SCALE;
    }
}
__device__ __forceinline__ void ph_decode_part(const P& p, int layer, char* smem) {
    const int tid_ = opaque_v((int)threadIdx.x); const int bid_ = opaque_s((int)blockIdx.x); (void)tid_; (void)bid_;
    float (*sq)[288] = (float (*)[288])smem;
    float (*ss)[128] = (float (*)[128])(smem + 8 * 288 * 4);
    float* sm = (float*)(smem + 8 * 288 * 4 + 8 * 128 * 4);
    float* sl = sm + 8;
    VB_LOOP(NS * 129) {
        int bs = vb / 129, ch = vb % 129;
        int tid = tid_, lane = tid & 63, wv = tid >> 6;
        for (int i = tid; i < 8 * 288; i += 256) {
            int h = i / 288, d = i % 288;
            sq[h][d] = (d < 256) ? p.qlat[((size_t)bs * 8 + h) * 256 + d] : p.q[(size_t)(NPT + bs) * 768 + h * 96 + 64 + (d - 256)] * ATT_SCALE;
        }
        __syncthreads();
        int nkeys = (ch < 128) ? 128 : 1;
        const float* latb; const float* krb;
        if (ch < 128) {
            int pg = p.page_table[bs * NPAGES + ch];
            latb = p.cache_lat + ((size_t)layer * NPOOL + pg) * PAGE * KVL;
            krb = p.cache_kr + ((size_t)layer * NPOOL + pg) * PAGE * 32;
        } else {
            latb = p.lat + (size_t)(NPT + bs) * KVL;
            krb = p.kpe + (size_t)(NPT + bs) * 32;
        }
        for (int k = wv; k < nkeys; k += 4) {
            float4 kv4 = *(const float4*)(latb + (size_t)k * KVL + lane * 4);
            float kr = (lane < 32) ? krb[(size_t)k * 32 + lane] : 0.f;
            float sh[8];
#pragma unroll
            for (int h = 0; h < 8; ++h) {
                float s = sq[h][lane * 4] * kv4.x + sq[h][lane * 4 + 1] * kv4.y + sq[h][lane * 4 + 2] * kv4.z + sq[h][lane * 4 + 3] * kv4.w;
                if (lane < 32) s += sq[h][256 + lane] * kr;
                sh[h] = wave_sum(s);
            }
            if (lane == 0) {
#pragma unroll
                for (int h = 0; h < 8; ++h) ss[h][k] = sh[h];
            }
        }
        __syncthreads();
        for (int hh = 0; hh < 2; ++hh) {
            int h = wv * 2 + hh;
            float v0 = (lane < nkeys) ? ss[h][lane] : -INFINITY;
            float v1 = (lane + 64 < nkeys) ? ss[h][lane + 64] : -INFINITY;
            float m = wave_max(fmaxf(v0, v1));
            float p0 = (lane < nkeys) ? expf(v0 - m) : 0.f;
            float p1 = (lane + 64 < nkeys) ? expf(v1 - m) : 0.f;
            float l = wave_sum(p0 + p1);
            if (lane < nkeys) ss[h][lane] = p0;
            if (lane + 64 < nkeys) ss[h][lane + 64] = p1;
            if (lane == 0) { sm[h] = m; sl[h] = l; }
        }
        __syncthreads();
        float acc[8];
#pragma unroll
        for (int h = 0; h < 8; ++h) acc[h] = 0.f;
        for (int k = 0; k < nkeys; ++k) {
            float v = latb[(size_t)k * KVL + tid];
#pragma unroll
            for (int h = 0; h < 8; ++h) acc[h] += ss[h][k] * v;
        }
        float* pp = p.part + ((size_t)bs * 129 + ch) * 8 * 258;
#pragma unroll
        for (int h = 0; h < 8; ++h) pp[h * 258 + 2 + tid] = acc[h];
        if (tid < 8) { pp[tid * 258 + 0] = sm[tid]; pp[tid * 258 + 1] = sl[tid]; }
        __syncthreads();
    }
}
__device__ __forceinline__ void ph_decode_comb(const P& p, int layer, char* smem) {
    const int tid_ = opaque_v((int)threadIdx.x); const int bid_ = opaque_s((int)blockIdx.x); (void)tid_; (void)bid_;
    float* sw = (float*)smem;
    float* so = sw + 132;
    float* sLp = so + 256;
    VB_LOOP(NS * 8) {
        int bs = vb / 8, h = vb % 8, tid = tid_;
        const float* pb = p.part + (size_t)bs * 129 * 8 * 258 + h * 258;
        if (tid < 64) {
            float m = -INFINITY;
            for (int c = tid; c < 129; c += 64) m = fmaxf(m, pb[(size_t)c * 8 * 258]);
            m = wave_max(m);
            float l = 0.f;
            for (int c = tid; c < 129; c += 64) {
                float w = expf(pb[(size_t)c * 8 * 258] - m);
                sw[c] = w;
                l += w * pb[(size_t)c * 8 * 258 + 1];
            }
            l = wave_sum(l);
            if (tid == 0) sLp[0] = l;
        }
        __syncthreads();
        float a = 0.f;
        for (int c = 0; c < 129; ++c) a += sw[c] * pb[(size_t)c * 8 * 258 + 2 + tid];
        so[tid] = a / sLp[0];
        __syncthreads();
        if (tid < 64) {
            const float* w = p.w_kvb + (size_t)layer * 256 * 1024 + h * 128 + 64 + tid;
            float s = 0.f;
            for (int r = 0; r < 256; ++r) s += so[r] * w[(size_t)r * 1024];
            p.ob[(size_t)(NPT + bs) * 512 + h * 64 + tid] = f2bf(s);
        }
        __syncthreads();
    }
}
__device__ __forceinline__ void ph_mix(const P& p, int layer) {
    const int tid_ = opaque_v((int)threadIdx.x); const int bid_ = opaque_s((int)blockIdx.x); (void)tid_; (void)bid_;
    const size_t n = (size_t)NT * DM;
    for (size_t i = (size_t)bid_ * NTHR + tid_; i < n; i += (size_t)gridDim.x * NTHR) {
        int t = (int)(i / DM), c = (int)(i % DM);
        float ga = sigmoid_f(p.proj[(size_t)t * DIN + OFF_GA + c] + p.b_gate[layer * 2048 + c]);
        float gb = sigmoid_f(p.proj[(size_t)t * DIN + OFF_GB + c] + p.b_gate[layer * 2048 + 1024 + c]);
        p.mixb[i] = f2bf(ga * p.ya[i] + gb * p.yb[i]);
    }
}
__device__ __forceinline__ void ph_peer_scores(const P& p, int layer, char* smem) {
    const int tid_ = opaque_v((int)threadIdx.x); const int bid_ = opaque_s((int)blockIdx.x); (void)tid_; (void)bid_;
    float* sq = (float*)smem;
    VB_LOOP(NT * 8) {
        int t = vb / 8, hh = (vb % 8) * 2 + (tid_ >> 7), k = tid_ & 127;
        sq[tid_] = p.pq[(size_t)t * 2048 + hh * 128 + k];
        __syncthreads();
        const float* sqq = sq + (tid_ >> 7) * 128;
        const float4* kp = (const float4*)(p.peer_keys + ((size_t)(layer * 16 + hh) * 128 + k) * 128);
        float s = 0.f;
#pragma unroll 8
        for (int d4 = 0; d4 < 32; ++d4) { float4 v = kp[d4]; s += sqq[d4 * 4] * v.x + sqq[d4 * 4 + 1] * v.y + sqq[d4 * 4 + 2] * v.z + sqq[d4 * 4 + 3] * v.w; }
        p.sc[(size_t)t * 2048 + hh * 128 + k] = s;
        __syncthreads();
    }
}
__device__ __forceinline__ void wave_argmax(float& v, int& i) {
#pragma unroll
    for (int o = 32; o > 0; o >>= 1) {
        float ov = __shfl_xor(v, o);
        int oi = __shfl_xor(i, o);
        if (ov > v || (ov == v && oi < i)) { v = ov; i = oi; }
    }
}
__device__ __forceinline__ void ph_peer_topk(const P& p) {
    const int tid_ = opaque_v((int)threadIdx.x); const int bid_ = opaque_s((int)blockIdx.x); (void)tid_; (void)bid_;
    VB_LOOP((NT * 8 + 3) / 4) {
        int w = vb * 4 + (tid_ >> 6);
        int lane = tid_ & 63;
        if (w < NT * 8) {
            int t = w / 8, h = w % 8;
            float topv0 = 0.f, topv1 = 0.f;
            int topi0 = 0, topi1 = 0;
#pragma unroll
            for (int half = 0; half < 2; ++half) {
                const float* sp = p.sc + (size_t)t * 2048 + (h * 2 + half) * 128;
                float a0 = sp[lane], a1 = sp[lane + 64];
                float tv = 0.f; int ti = 0;
                for (int r = 0; r < 16; ++r) {
                    float v; int i;
                    if (a0 >= a1) { v = a0; i = lane; } else { v = a1; i = lane + 64; }
                    wave_argmax(v, i);
                    if (i == lane) a0 = -INFINITY;
                    if (i == lane + 64) a1 = -INFINITY;
                    if (lane == r) { tv = v; ti = i; }
                }
                if (half == 0) { topv0 = tv; topi0 = ti; } else { topv1 = tv; topi1 = ti; }
            }
            float cv0, cv1, cv2, cv3;
            {
                float va = __shfl(topv0, lane >> 2);
                int b0 = (lane & 3) * 4;
                cv0 = va + __shfl(topv1, b0 + 0);
                cv1 = va + __shfl(topv1, b0 + 1);
                cv2 = va + __shfl(topv1, b0 + 2);
                cv3 = va + __shfl(topv1, b0 + 3);
            }
            float selv = 0.f; int selc = 0;
            for (int r = 0; r < 16; ++r) {
                float v = cv0; int c = lane * 4;
                if (cv1 > v) { v = cv1; c = lane * 4 + 1; }
                if (cv2 > v) { v = cv2; c = lane * 4 + 2; }
                if (cv3 > v) { v = cv3; c = lane * 4 + 3; }
                wave_argmax(v, c);
                if (c == lane * 4 + 0) cv0 = -INFINITY;
                if (c == lane * 4 + 1) cv1 = -INFINITY;
                if (c == lane * 4 + 2) cv2 = -INFINITY;
                if (c == lane * 4 + 3) cv3 = -INFINITY;
                if (lane == r) { selv = v; selc = c; }
            }
            float mx = __shfl(selv, 0);
            float e = (lane < 16) ? expf(selv - mx) : 0.f;
            float sum = wave_sum(e);
            int ia = __shfl(topi0, selc >> 4);
            int ib = __shfl(topi1, selc & 15);
            if (lane < 16) {
                p.idx[(size_t)t * 128 + h * 16 + lane] = ia * 128 + ib;
                p.gate[(size_t)t * 128 + h * 16 + lane] = e / sum;
            }
        }
    }
}

__device__ __forceinline__ float dot2bf(unsigned a, unsigned b, float c) {
    return __builtin_amdgcn_fdot2_f32_bf16(__builtin_bit_cast(bf16x2_t, a), __builtin_bit_cast(bf16x2_t, b), c, false);
}
__device__ __forceinline__ float bflo(unsigned d) { return __uint_as_float(d << 16); }
__device__ __forceinline__ float bfhi(unsigned d) { return __uint_as_float(d & 0xffff0000u); }
typedef __attribute__((ext_vector_type(2))) float f32x2;
__device__ __forceinline__ void ph_convert_fp8(const float* src, unsigned char* dst, float* inv, int rows) {
    const int tid = opaque_v((int)threadIdx.x); const int bid = opaque_s((int)blockIdx.x);
    const int wid = tid >> 6, lane = tid & 63;
    for (int r = bid * 4 + wid; r < rows; r += (int)gridDim.x * 4) {
        const float4* sp = reinterpret_cast<const float4*>(src + (size_t)r * DM + lane * 16);
        const float4 a = sp[0], b = sp[1], c = sp[2], d = sp[3];
        float mx = fmaxf(fmaxf(fmaxf(fabsf(a.x), fabsf(a.y)), fmaxf(fabsf(a.z), fabsf(a.w))), fmaxf(fmaxf(fabsf(b.x), fabsf(b.y)), fmaxf(fabsf(b.z), fabsf(b.w))));
        mx = fmaxf(mx, fmaxf(fmaxf(fmaxf(fabsf(c.x), fabsf(c.y)), fmaxf(fabsf(c.z), fabsf(c.w))), fmaxf(fmaxf(fabsf(d.x), fabsf(d.y)), fmaxf(fabsf(d.z), fabsf(d.w)))));
        mx = fmaxf(wave_max(mx), 1e-30f);
        const float sc = 224.f / mx;
        uint4 o; int w;
        w = 0; w = __builtin_amdgcn_cvt_pk_fp8_f32(a.x * sc, a.y * sc, w, false); w = __builtin_amdgcn_cvt_pk_fp8_f32(a.z * sc, a.w * sc, w, true); o.x = (unsigned)w;
        w = 0; w = __builtin_amdgcn_cvt_pk_fp8_f32(b.x * sc, b.y * sc, w, false); w = __builtin_amdgcn_cvt_pk_fp8_f32(b.z * sc, b.w * sc, w, true); o.y = (unsigned)w;
        w = 0; w = __builtin_amdgcn_cvt_pk_fp8_f32(c.x * sc, c.y * sc, w, false); w = __builtin_amdgcn_cvt_pk_fp8_f32(c.z * sc, c.w * sc, w, true); o.z = (unsigned)w;
        w = 0; w = __builtin_amdgcn_cvt_pk_fp8_f32(d.x * sc, d.y * sc, w, false); w = __builtin_amdgcn_cvt_pk_fp8_f32(d.z * sc, d.w * sc, w, true); o.w = (unsigned)w;
        *reinterpret_cast<uint4*>(dst + (size_t)r * DM + lane * 16) = o;
        if (lane == 0) inv[r] = mx / 224.f;
    }
}
#define FP8_UNPACK16(v_, f_) do { \
    f32x2 t_; \
    t_ = __builtin_amdgcn_cvt_pk_f32_fp8((int)(v_).x, false); f_[0] = t_[0]; f_[1] = t_[1]; t_ = __builtin_amdgcn_cvt_pk_f32_fp8((int)(v_).x, true); f_[2] = t_[0]; f_[3] = t_[1]; \
    t_ = __builtin_amdgcn_cvt_pk_f32_fp8((int)(v_).y, false); f_[4] = t_[0]; f_[5] = t_[1]; t_ = __builtin_amdgcn_cvt_pk_f32_fp8((int)(v_).y, true); f_[6] = t_[0]; f_[7] = t_[1]; \
    t_ = __builtin_amdgcn_cvt_pk_f32_fp8((int)(v_).z, false); f_[8] = t_[0]; f_[9] = t_[1]; t_ = __builtin_amdgcn_cvt_pk_f32_fp8((int)(v_).z, true); f_[10] = t_[0]; f_[11] = t_[1]; \
    t_ = __builtin_amdgcn_cvt_pk_f32_fp8((int)(v_).w, false); f_[12] = t_[0]; f_[13] = t_[1]; t_ = __builtin_amdgcn_cvt_pk_f32_fp8((int)(v_).w, true); f_[14] = t_[0]; f_[15] = t_[1]; \
} while (0)
__device__ __forceinline__ void ph_peer_experts3(const P& p, int layer, bool dry = false) {
    const int tid = opaque_v((int)threadIdx.x); const int bid = opaque_s((int)blockIdx.x);
    const int wid = tid >> 6, lane = tid & 63;
    const unsigned char* U = p.u8 + (size_t)layer * NEXP * DM;
    const unsigned char* V = p.v8 + (size_t)layer * NEXP * DM;
    const float* IU = p.uinv + (size_t)layer * NEXP;
    const float* IV = p.vinv + (size_t)layer * NEXP;
    for (int t = bid * 4 + wid; t < NT; t += (int)gridDim.x * 4) {
        float hx[16];
        {
            const uint4* hrow = reinterpret_cast<const uint4*>(p.hb + (size_t)t * DM + lane * 16);
            const uint4 h0 = hrow[0], h1 = hrow[1];
            hx[0] = bflo(h0.x); hx[1] = bfhi(h0.x); hx[2] = bflo(h0.y); hx[3] = bfhi(h0.y); hx[4] = bflo(h0.z); hx[5] = bfhi(h0.z); hx[6] = bflo(h0.w); hx[7] = bfhi(h0.w);
            hx[8] = bflo(h1.x); hx[9] = bfhi(h1.x); hx[10] = bflo(h1.y); hx[11] = bfhi(h1.y); hx[12] = bflo(h1.z); hx[13] = bfhi(h1.z); hx[14] = bflo(h1.w); hx[15] = bfhi(h1.w);
        }
        const int i0 = p.idx[(size_t)t * 128 + lane], i1 = p.idx[(size_t)t * 128 + 64 + lane];
        const float g0 = p.gate[(size_t)t * 128 + lane], g1 = p.gate[(size_t)t * 128 + 64 + lane];
        const float su0 = IU[i0], su1 = IU[i1];
        float w0 = 0.f, w1 = 0.f;
        uint4 nx[4];
#pragma unroll
        for (int j = 0; j < 4; ++j) nx[j] = *reinterpret_cast<const uint4*>(U + (size_t)__builtin_amdgcn_readlane(i0, j) * DM + lane * 16);
#pragma unroll 1
        for (int kk = 0; kk < 128; kk += 4) {
            uint4 cu[4];
#pragma unroll
            for (int j = 0; j < 4; ++j) cu[j] = nx[j];
            if (kk + 4 < 128) {
                const int ivn = (kk + 4 < 64) ? i0 : i1;
#pragma unroll
                for (int j = 0; j < 4; ++j) nx[j] = *reinterpret_cast<const uint4*>(U + (size_t)__builtin_amdgcn_readlane(ivn, (kk + 4 + j) & 63) * DM + lane * 16);
            }
            float sd[4];
#pragma unroll
            for (int j = 0; j < 4; ++j) {
                float f[16];
                FP8_UNPACK16(cu[j], f);
                float a = 0.f;
#pragma unroll
                for (int i = 0; i < 16; ++i) a += f[i] * hx[i];
                sd[j] = a;
            }
#pragma unroll
            for (int o = 32; o > 0; o >>= 1) {
#pragma unroll
                for (int j = 0; j < 4; ++j) sd[j] += __shfl_xor(sd[j], o);
            }
#pragma unroll
            for (int j = 0; j < 4; ++j) {
                if (lane == ((kk + j) & 63)) {
                    const float x = sd[j] * ((kk < 64) ? su0 : su1);
                    const float act = 0.5f * x * (1.f + erff(x * 0.70710678118654752f));
                    if (kk < 64) w0 = g0 * act; else w1 = g1 * act;
                }
            }
        }
        w0 *= IV[i0]; w1 *= IV[i1];
        float acc[16];
#pragma unroll
        for (int i = 0; i < 16; ++i) acc[i] = 0.f;
#pragma unroll
        for (int j = 0; j < 4; ++j) nx[j] = *reinterpret_cast<const uint4*>(V + (size_t)__builtin_amdgcn_readlane(i0, j) * DM + lane * 16);
#pragma unroll 1
        for (int kk = 0; kk < 128; kk += 4) {
            uint4 cu[4];
#pragma unroll
            for (int j = 0; j < 4; ++j) cu[j] = nx[j];
            if (kk + 4 < 128) {
                const int ivn = (kk + 4 < 64) ? i0 : i1;
#pragma unroll
                for (int j = 0; j < 4; ++j) nx[j] = *reinterpret_cast<const uint4*>(V + (size_t)__builtin_amdgcn_readlane(ivn, (kk + 4 + j) & 63) * DM + lane * 16);
            }
            const float wv = (kk < 64) ? w0 : w1;
#pragma unroll
            for (int j = 0; j < 4; ++j) {
                const float w = __builtin_bit_cast(float, __builtin_amdgcn_readlane(__builtin_bit_cast(int, wv), (kk + j) & 63));
                float f[16];
                FP8_UNPACK16(cu[j], f);
#pragma unroll
                for (int i = 0; i < 16; ++i) acc[i] += w * f[i];
            }
        }
        float4* xp = reinterpret_cast<float4*>((dry ? p.yraw : p.xres) + (size_t)t * DM + lane * 16);
#pragma unroll
        for (int q4 = 0; q4 < 4; ++q4) {
            float4 x = xp[q4];
            x.x += acc[q4 * 4 + 0]; x.y += acc[q4 * 4 + 1]; x.z += acc[q4 * 4 + 2]; x.w += acc[q4 * 4 + 3];
            xp[q4] = x;
        }
    }
}

#define S_RS 272
#define S_XT 0
#define S_HL (64 * S_RS)
#define S_BT (2 * 64 * S_RS)
#define S_ACS (2 * 64 * S_RS + 128 * S_RS)
#define S_DTL (S_ACS + 512)
#define S_WL (S_DTL + 512)
__device__ __forceinline__ void ph_ssd_chunk(const P& p, int layer, char* smem) {
    const int tid = opaque_v((int)threadIdx.x); const int bid = opaque_s((int)blockIdx.x);
    const int wid = tid >> 6, lane = tid & 63, fr = lane & 15, fq = lane >> 4;
    float* acs = reinterpret_cast<float*>(smem + S_ACS);
    float* dtl = reinterpret_cast<float*>(smem + S_DTL);
    float* wl = reinterpret_cast<float*>(smem + S_WL);
    for (int u = bid; u < NB * 16; u += (int)gridDim.x) {
        const int b = u >> 4, e = u & 15, g = e >> 3;
        const float A = -__expf(p.a_log[layer * 16 + e]);
        const float Dk = p.d_skip[layer * 16 + e];
        f32x4 hT[2][4];
#pragma unroll
        for (int i = 0; i < 2; ++i)
#pragma unroll
            for (int pt = 0; pt < 4; ++pt) hT[i][pt] = f32x4{0.f, 0.f, 0.f, 0.f};
#pragma unroll 1
        for (int c = 0; c < 16; ++c) {
            const size_t t0 = (size_t)b * SEQ + c * 128;
            if (wid == 0) {
                const float d0 = p.dt[(t0 + lane) * 16 + e], d1 = p.dt[(t0 + 64 + lane) * 16 + e];
                float s0 = d0 * A, s1 = d1 * A;
#pragma unroll
                for (int o = 1; o < 64; o <<= 1) {
                    float t0s = __shfl_up(s0, o), t1s = __shfl_up(s1, o);
                    if (lane >= o) { s0 += t0s; s1 += t1s; }
                }
                s1 += __shfl(s0, 63);
                const float aend = __shfl(s1, 63);
                acs[lane] = s0; acs[64 + lane] = s1; dtl[lane] = d0; dtl[64 + lane] = d1;
                wl[lane] = d0 * __expf(aend - s0); wl[64 + lane] = d1 * __expf(aend - s1);
            }
#pragma unroll
            for (int i = 0; i < 4; ++i) {
                const int id = tid + 256 * i, l = id & 127, pc = id >> 7;
                const uint4 v = *reinterpret_cast<const uint4*>(p.xbcb + (t0 + l) * CONVD + e * 64 + pc * 8);
                bf16_t* dst = reinterpret_cast<bf16_t*>(smem + S_XT + (pc * 8) * S_RS + l * 2);
                dst[0 * (S_RS / 2)] = (bf16_t)(v.x & 0xffff); dst[1 * (S_RS / 2)] = (bf16_t)(v.x >> 16);
                dst[2 * (S_RS / 2)] = (bf16_t)(v.y & 0xffff); dst[3 * (S_RS / 2)] = (bf16_t)(v.y >> 16);
                dst[4 * (S_RS / 2)] = (bf16_t)(v.z & 0xffff); dst[5 * (S_RS / 2)] = (bf16_t)(v.z >> 16);
                dst[6 * (S_RS / 2)] = (bf16_t)(v.w & 0xffff); dst[7 * (S_RS / 2)] = (bf16_t)(v.w >> 16);
            }
#pragma unroll
            for (int i = 0; i < 8; ++i) {
                const int id = tid + 256 * i, l = id & 127, nc = id >> 7;
                const uint4 v = *reinterpret_cast<const uint4*>(p.xbcb + (t0 + l) * CONVD + 1024 + g * 128 + nc * 8);
                bf16_t* dst = reinterpret_cast<bf16_t*>(smem + S_BT + (nc * 8) * S_RS + l * 2);
                dst[0 * (S_RS / 2)] = (bf16_t)(v.x & 0xffff); dst[1 * (S_RS / 2)] = (bf16_t)(v.x >> 16);
                dst[2 * (S_RS / 2)] = (bf16_t)(v.y & 0xffff); dst[3 * (S_RS / 2)] = (bf16_t)(v.y >> 16);
                dst[4 * (S_RS / 2)] = (bf16_t)(v.z & 0xffff); dst[5 * (S_RS / 2)] = (bf16_t)(v.z >> 16);
                dst[6 * (S_RS / 2)] = (bf16_t)(v.w & 0xffff); dst[7 * (S_RS / 2)] = (bf16_t)(v.w >> 16);
            }
#pragma unroll
            for (int i = 0; i < 2; ++i)
#pragma unroll
                for (int pt = 0; pt < 4; ++pt) {
                    uint2 w2;
                    w2.x = pack_bf16(hT[i][pt][0], hT[i][pt][1]); w2.y = pack_bf16(hT[i][pt][2], hT[i][pt][3]);
                    *reinterpret_cast<uint2*>(smem + S_HL + (pt * 16 + fr) * S_RS + (wid * 32 + i * 16 + fq * 4) * 2) = w2;
                }
            __syncthreads();
            bf16x8 cf[2][4];
#pragma unroll
            for (int j = 0; j < 2; ++j)
#pragma unroll
                for (int k = 0; k < 4; ++k)
                    cf[j][k] = *reinterpret_cast<const bf16x8*>(p.xbcb + (t0 + wid * 32 + j * 16 + fr) * CONVD + 1280 + g * 128 + k * 32 + fq * 8);
            f32x4 acc[4][2];
#pragma unroll
            for (int pt = 0; pt < 4; ++pt)
#pragma unroll
                for (int j = 0; j < 2; ++j) acc[pt][j] = f32x4{0.f, 0.f, 0.f, 0.f};
#pragma unroll
            for (int pt = 0; pt < 4; ++pt)
#pragma unroll
                for (int k = 0; k < 4; ++k) {
                    const bf16x8 hf = *reinterpret_cast<const bf16x8*>(smem + S_HL + (pt * 16 + fr) * S_RS + (k * 32 + fq * 8) * 2);
#pragma unroll
                    for (int j = 0; j < 2; ++j) acc[pt][j] = __builtin_amdgcn_mfma_f32_16x16x32_bf16(hf, cf[j][k], acc[pt][j], 0, 0, 0);
                }
            float alv[2];
#pragma unroll
            for (int j = 0; j < 2; ++j) {
                alv[j] = acs[wid * 32 + j * 16 + fr];
                const float el = __expf(alv[j]);
#pragma unroll
                for (int pt = 0; pt < 4; ++pt) { acc[pt][j][0] *= el; acc[pt][j][1] *= el; acc[pt][j][2] *= el; acc[pt][j][3] *= el; }
            }
#pragma unroll 1
            for (int ii = 0; ii <= wid; ++ii) {
                f32x4 cb[2][2];
#pragma unroll
                for (int si = 0; si < 2; ++si)
#pragma unroll
                    for (int j = 0; j < 2; ++j) cb[si][j] = f32x4{0.f, 0.f, 0.f, 0.f};
#pragma unroll
                for (int k = 0; k < 4; ++k)
#pragma unroll
                    for (int si = 0; si < 2; ++si) {
                        const bf16x8 bfr = *reinterpret_cast<const bf16x8*>(p.xbcb + (t0 + ii * 32 + si * 16 + fr) * CONVD + 1024 + g * 128 + k * 32 + fq * 8);
#pragma unroll
                        for (int j = 0; j < 2; ++j) cb[si][j] = __builtin_amdgcn_mfma_f32_16x16x32_bf16(bfr, cf[j][k], cb[si][j], 0, 0, 0);
                    }
                bf16x8 mf[2];
                {
                    float as8[8], ds8[8];
#pragma unroll
                    for (int si = 0; si < 2; ++si) {
                        const float4 a4 = *reinterpret_cast<const float4*>(acs + ii * 32 + si * 16 + fq * 4);
                        const float4 d4 = *reinterpret_cast<const float4*>(dtl + ii * 32 + si * 16 + fq * 4);
                        as8[si * 4 + 0] = a4.x; as8[si * 4 + 1] = a4.y; as8[si * 4 + 2] = a4.z; as8[si * 4 + 3] = a4.w;
                        ds8[si * 4 + 0] = d4.x; ds8[si * 4 + 1] = d4.y; ds8[si * 4 + 2] = d4.z; ds8[si * 4 + 3] = d4.w;
                    }
#pragma unroll
                    for (int j = 0; j < 2; ++j) {
                        const int lidx = wid * 32 + j * 16 + fr;
                        float mv[8];
#pragma unroll
                        for (int si = 0; si < 2; ++si)
#pragma unroll
                            for (int r = 0; r < 4; ++r) {
                                const int sidx = ii * 32 + si * 16 + fq * 4 + r;
                                const float dec = __expf(fminf(alv[j] - as8[si * 4 + r], 0.f)) * ds8[si * 4 + r];
                                mv[si * 4 + r] = (lidx >= sidx) ? cb[si][j][r] * dec : 0.f;
                            }
                        uint4 pk;
                        pk.x = pack_bf16(mv[0], mv[1]); pk.y = pack_bf16(mv[2], mv[3]); pk.z = pack_bf16(mv[4], mv[5]); pk.w = pack_bf16(mv[6], mv[7]);
                        mf[j] = __builtin_bit_cast(bf16x8, pk);
                    }
                }
#pragma unroll
                for (int pt = 0; pt < 4; ++pt) {
                    const char* xp = smem + S_XT + (pt * 16 + fr) * S_RS + (ii * 32 + fq * 4) * 2;
                    const uint2 lo = *reinterpret_cast<const uint2*>(xp);
                    const uint2 hi = *reinterpret_cast<const uint2*>(xp + 32);
                    uint4 xv; xv.x = lo.x; xv.y = lo.y; xv.z = hi.x; xv.w = hi.y;
                    const bf16x8 xf = __builtin_bit_cast(bf16x8, xv);
#pragma unroll
                    for (int j = 0; j < 2; ++j) acc[pt][j] = __builtin_amdgcn_mfma_f32_16x16x32_bf16(xf, mf[j], acc[pt][j], 0, 0, 0);
                }
            }
#pragma unroll
            for (int j = 0; j < 2; ++j) {
                const size_t tl = t0 + wid * 32 + j * 16 + fr;
#pragma unroll
                for (int pt = 0; pt < 4; ++pt) {
                    const uint2 xx = *reinterpret_cast<const uint2*>(p.xbcb + tl * CONVD + e * 64 + pt * 16 + fq * 4);
                    float4 y;
                    y.x = acc[pt][j][0] + Dk * bflo(xx.x); y.y = acc[pt][j][1] + Dk * bfhi(xx.x);
                    y.z = acc[pt][j][2] + Dk * bflo(xx.y); y.w = acc[pt][j][3] + Dk * bfhi(xx.y);
                    *reinterpret_cast<float4*>(p.yraw + tl * DM + e * 64 + pt * 16 + fq * 4) = y;
                }
            }
            {
                const float dec = __expf(acs[127]);
#pragma unroll
                for (int i = 0; i < 2; ++i)
#pragma unroll
                    for (int pt = 0; pt < 4; ++pt) { hT[i][pt][0] *= dec; hT[i][pt][1] *= dec; hT[i][pt][2] *= dec; hT[i][pt][3] *= dec; }
            }
#pragma unroll
            for (int k = 0; k < 4; ++k) {
                const float4 w0 = *reinterpret_cast<const float4*>(wl + k * 32 + fq * 8);
                const float4 w1 = *reinterpret_cast<const float4*>(wl + k * 32 + fq * 8 + 4);
                bf16x8 bt[2];
#pragma unroll
                for (int i = 0; i < 2; ++i) bt[i] = *reinterpret_cast<const bf16x8*>(smem + S_BT + (wid * 32 + i * 16 + fr) * S_RS + (k * 32 + fq * 8) * 2);
#pragma unroll
                for (int pt = 0; pt < 4; ++pt) {
                    const uint4 xr = *reinterpret_cast<const uint4*>(smem + S_XT + (pt * 16 + fr) * S_RS + (k * 32 + fq * 8) * 2);
                    uint4 xs;
                    xs.x = pack_bf16(bflo(xr.x) * w0.x, bfhi(xr.x) * w0.y); xs.y = pack_bf16(bflo(xr.y) * w0.z, bfhi(xr.y) * w0.w);
                    xs.z = pack_bf16(bflo(xr.z) * w1.x, bfhi(xr.z) * w1.y); xs.w = pack_bf16(bflo(xr.w) * w1.z, bfhi(xr.w) * w1.w);
                    const bf16x8 xsf = __builtin_bit_cast(bf16x8, xs);
#pragma unroll
                    for (int i = 0; i < 2; ++i) hT[i][pt] = __builtin_amdgcn_mfma_f32_16x16x32_bf16(bt[i], xsf, hT[i][pt], 0, 0, 0);
                }
            }
            __syncthreads();
        }
#pragma unroll
        for (int i = 0; i < 2; ++i)
#pragma unroll
            for (int pt = 0; pt < 4; ++pt) {
                float4 hv; hv.x = hT[i][pt][0]; hv.y = hT[i][pt][1]; hv.z = hT[i][pt][2]; hv.w = hT[i][pt][3];
                *reinterpret_cast<float4*>(p.out + O_SSMP + (((size_t)(layer * NB + b) * 16 + e) * 64 + pt * 16 + fr) * 128 + wid * 32 + i * 16 + fq * 4) = hv;
            }
    }
}


__device__ __forceinline__ int med3i(int a, int b, int c) { return max(min(a, b), min(max(a, b), c)); }
__device__ __forceinline__ int okey(float v) { int o = __float_as_int(v); return o ^ ((o >> 31) & 0x7fffffff); }
__device__ __forceinline__ float okey_inv(int o) { return __int_as_float(o ^ ((o >> 31) & 0x7fffffff)); }
#define TK_INSERT(L_, key_) do { const int k_ = (key_); \
    L_[15] = med3i(L_[14], L_[15], k_); L_[14] = med3i(L_[13], L_[14], k_); L_[13] = med3i(L_[12], L_[13], k_); L_[12] = med3i(L_[11], L_[12], k_); \
    L_[11] = med3i(L_[10], L_[11], k_); L_[10] = med3i(L_[9], L_[10], k_); L_[9] = med3i(L_[8], L_[9], k_); L_[8] = med3i(L_[7], L_[8], k_); \
    L_[7] = med3i(L_[6], L_[7], k_); L_[6] = med3i(L_[5], L_[6], k_); L_[5] = med3i(L_[4], L_[5], k_); L_[4] = med3i(L_[3], L_[4], k_); \
    L_[3] = med3i(L_[2], L_[3], k_); L_[2] = med3i(L_[1], L_[2], k_); L_[1] = med3i(L_[0], L_[1], k_); L_[0] = max(L_[0], k_); } while (0)
#define TK_INS2(a_, b_) do { const float sv_ = V1[a_] + V2[b_]; TK_INSERT(M, (okey(sv_) & ~255) | (255 - ((a_) * 16 + (b_)))); } while (0)
__device__ __forceinline__ void ph_peer_topk2(const P& p) {
    const int tid = opaque_v((int)threadIdx.x); const int bid = opaque_s((int)blockIdx.x);
    for (int pr = bid * NTHR + tid; pr < NT * 8; pr += (int)gridDim.x * NTHR) {
        const int t = pr >> 3, h = pr & 7;
        int L1[16], L2[16], M[16];
#pragma unroll
        for (int i = 0; i < 16; ++i) { L1[i] = (int)0x80000000; L2[i] = (int)0x80000000; M[i] = (int)0x80000000; }
        const float4* sp = reinterpret_cast<const float4*>(p.sc + (size_t)t * 2048 + h * 256);
#pragma unroll 2
        for (int k4 = 0; k4 < 32; ++k4) {
            const float4 v = sp[k4];
            const int kb = 127 - k4 * 4;
            TK_INSERT(L1, (okey(v.x) & ~127) | (kb - 0));
            TK_INSERT(L1, (okey(v.y) & ~127) | (kb - 1));
            TK_INSERT(L1, (okey(v.z) & ~127) | (kb - 2));
            TK_INSERT(L1, (okey(v.w) & ~127) | (kb - 3));
        }
#pragma unroll 2
        for (int k4 = 0; k4 < 32; ++k4) {
            const float4 v = sp[32 + k4];
            const int kb = 127 - k4 * 4;
            TK_INSERT(L2, (okey(v.x) & ~127) | (kb - 0));
            TK_INSERT(L2, (okey(v.y) & ~127) | (kb - 1));
            TK_INSERT(L2, (okey(v.z) & ~127) | (kb - 2));
            TK_INSERT(L2, (okey(v.w) & ~127) | (kb - 3));
        }
        float V1[16], V2[16];
#pragma unroll
        for (int i = 0; i < 16; ++i) { V1[i] = okey_inv(L1[i] & ~127); V2[i] = okey_inv(L2[i] & ~127); }
        TK_INS2(0, 0);
        TK_INS2(0, 1);
        TK_INS2(0, 2);
        TK_INS2(0, 3);
        TK_INS2(0, 4);
        TK_INS2(0, 5);
        TK_INS2(0, 6);
        TK_INS2(0, 7);
        TK_INS2(0, 8);
        TK_INS2(0, 9);
        TK_INS2(0, 10);
        TK_INS2(0, 11);
        TK_INS2(0, 12);
        TK_INS2(0, 13);
        TK_INS2(0, 14);
        TK_INS2(0, 15);
        TK_INS2(1, 0);
        TK_INS2(1, 1);
        TK_INS2(1, 2);
        TK_INS2(1, 3);
        TK_INS2(1, 4);
        TK_INS2(1, 5);
        TK_INS2(1, 6);
        TK_INS2(1, 7);
        TK_INS2(2, 0);
        TK_INS2(2, 1);
        TK_INS2(2, 2);
        TK_INS2(2, 3);
        TK_INS2(2, 4);
        TK_INS2(3, 0);
        TK_INS2(3, 1);
        TK_INS2(3, 2);
        TK_INS2(3, 3);
        TK_INS2(4, 0);
        TK_INS2(4, 1);
        TK_INS2(4, 2);
        TK_INS2(5, 0);
        TK_INS2(5, 1);
        TK_INS2(6, 0);
        TK_INS2(6, 1);
        TK_INS2(7, 0);
        TK_INS2(7, 1);
        TK_INS2(8, 0);
        TK_INS2(9, 0);
        TK_INS2(10, 0);
        TK_INS2(11, 0);
        TK_INS2(12, 0);
        TK_INS2(13, 0);
        TK_INS2(14, 0);
        TK_INS2(15, 0);
        float sv[16];
        int ex[16];
#pragma unroll
        for (int j = 0; j < 16; ++j) {
            const int c = 255 - (M[j] & 255);
            const int a = c >> 4, b = c & 15;
            int ka = L1[0], kb2 = L2[0];
            float va = V1[0], vb = V2[0];
#pragma unroll
            for (int i = 1; i < 16; ++i) {
                if (a == i) { ka = L1[i]; va = V1[i]; }
                if (b == i) { kb2 = L2[i]; vb = V2[i]; }
            }
            sv[j] = va + vb;
            ex[j] = (127 - (ka & 127)) * 128 + (127 - (kb2 & 127));
        }
        float sum = 0.f;
        float ev[16];
#pragma unroll
        for (int j = 0; j < 16; ++j) { ev[j] = __expf(sv[j] - sv[0]); sum += ev[j]; }
        const float inv = 1.f / sum;
        int* ip = p.idx + (size_t)t * 128 + h * 16;
        float* gp = p.gate + (size_t)t * 128 + h * 16;
#pragma unroll
        for (int j4 = 0; j4 < 4; ++j4) {
            *reinterpret_cast<int4*>(ip + j4 * 4) = make_int4(ex[j4 * 4], ex[j4 * 4 + 1], ex[j4 * 4 + 2], ex[j4 * 4 + 3]);
            *reinterpret_cast<float4*>(gp + j4 * 4) = make_float4(ev[j4 * 4] * inv, ev[j4 * 4 + 1] * inv, ev[j4 * 4 + 2] * inv, ev[j4 * 4 + 3] * inv);
        }
    }
}


#define D_RS 544
#define D_NCH 16
typedef __attribute__((ext_vector_type(4))) short s16x4;
__device__ __forceinline__ uint4 pack8(const float4 a, const float4 b, float sc) {
    uint4 r; r.x = pack_bf16(a.x * sc, a.y * sc); r.y = pack_bf16(a.z * sc, a.w * sc); r.z = pack_bf16(b.x * sc, b.y * sc); r.w = pack_bf16(b.z * sc, b.w * sc); return r;
}
__device__ __forceinline__ void ph_decode2(const P& p, int layer, char* smem) {
    const int tid = opaque_v((int)threadIdx.x); const int bid = opaque_s((int)blockIdx.x);
    const int wid = tid >> 6, lane = tid & 63, fr = lane & 15, fq = lane >> 4;
    char* vbuf = smem + wid * (16 * D_RS);
    const float L2E = 1.4426950408889634f;
    for (int u = bid; u < NS * D_NCH; u += (int)gridDim.x) {
        const int bs = u / D_NCH, ch = u % D_NCH;
        char* qls = smem + 4 * 16 * D_RS;
        {
            const int hh = fr & 7;
            const float zf = (fr < 8) ? 1.f : 0.f;
            const float* ql = p.qlat + ((size_t)bs * 8 + hh) * 256 + fq * 8;
            const float* qr = p.q + (size_t)(NPT + bs) * 768 + hh * 96 + 64 + fq * 8;
#pragma unroll
            for (int j = 0; j < 3; ++j) {
                const int s9 = wid + 4 * j;
                if (s9 < 8) {
                    const float4 a = *reinterpret_cast<const float4*>(ql + s9 * 32), b = *reinterpret_cast<const float4*>(ql + s9 * 32 + 4);
                    *reinterpret_cast<uint4*>(qls + (s9 * 64 + lane) * 16) = pack8(a, b, L2E * zf);
                } else if (s9 == 8) {
                    const float4 a = *reinterpret_cast<const float4*>(qr), b = *reinterpret_cast<const float4*>(qr + 4);
                    *reinterpret_cast<uint4*>(qls + (s9 * 64 + lane) * 16) = pack8(a, b, ATT_SCALE * L2E * zf);
                }
            }
        }
        __syncthreads();
        f32x4 oacc[16];
#pragma unroll
        for (int dt = 0; dt < 16; ++dt) oacc[dt] = f32x4{0.f, 0.f, 0.f, 0.f};
        float mrun = -INFINITY, lrun = 0.f;
        float4 raw[18];
#define D_ISSUE(ti_) do { const int ti = (ti_); const int pg = p.page_table[bs * NPAGES + ch * 8 + (ti >> 3)]; \
            const size_t krow = ((size_t)layer * NPOOL + pg) * PAGE + (ti & 7) * 16 + fr; \
            const float* lp = p.cache_lat + krow * KVL + fq * 8; const float* rp = p.cache_kr + krow * 32 + fq * 8; \
            _Pragma("unroll") for (int s9 = 0; s9 < 8; ++s9) { raw[2 * s9] = *reinterpret_cast<const float4*>(lp + s9 * 32); raw[2 * s9 + 1] = *reinterpret_cast<const float4*>(lp + s9 * 32 + 4); } \
            raw[16] = *reinterpret_cast<const float4*>(rp); raw[17] = *reinterpret_cast<const float4*>(rp + 4); } while (0)
#pragma unroll 1
        for (int it = 0; it < 16; ++it) {
            D_ISSUE(wid + 4 * it);
            bf16x8 kf[9];
#pragma unroll
            for (int s9 = 0; s9 < 9; ++s9) kf[s9] = __builtin_bit_cast(bf16x8, pack8(raw[2 * s9], raw[2 * s9 + 1], 1.f));
            f32x4 st = f32x4{0.f, 0.f, 0.f, 0.f};
#pragma unroll
            for (int s9 = 0; s9 < 9; ++s9) st = __builtin_amdgcn_mfma_f32_16x16x32_bf16(kf[s9], *reinterpret_cast<const bf16x8*>(qls + (s9 * 64 + lane) * 16), st, 0, 0, 0);
#pragma unroll
            for (int s9 = 0; s9 < 8; ++s9) *reinterpret_cast<bf16x8*>(vbuf + fr * D_RS + (s9 * 32 + fq * 8) * 2) = kf[s9];
            float mx = fmaxf(fmaxf(st[0], st[1]), fmaxf(st[2], st[3]));
            mx = fmaxf(mx, __shfl_xor(mx, 16));
            mx = fmaxf(mx, __shfl_xor(mx, 32));
            const float mnew = fmaxf(mrun, mx);
            const float corr = __builtin_amdgcn_exp2f(mrun - mnew);
            const float p0 = __builtin_amdgcn_exp2f(st[0] - mnew), p1 = __builtin_amdgcn_exp2f(st[1] - mnew);
            const float p2 = __builtin_amdgcn_exp2f(st[2] - mnew), p3 = __builtin_amdgcn_exp2f(st[3] - mnew);
            float rs = (p0 + p1) + (p2 + p3);
            rs += __shfl_xor(rs, 16);
            rs += __shfl_xor(rs, 32);
            lrun = lrun * corr + rs;
            mrun = mnew;
#pragma unroll
            for (int dt = 0; dt < 16; ++dt) { oacc[dt][0] *= corr; oacc[dt][1] *= corr; oacc[dt][2] *= corr; oacc[dt][3] *= corr; }
            uint4 pk; pk.x = pack_bf16(p0, p1); pk.y = pack_bf16(p2, p3); pk.z = 0u; pk.w = 0u;
            const bf16x8 pf = __builtin_bit_cast(bf16x8, pk);
            const char* tb = vbuf + (fq * 4 + (fr >> 2)) * D_RS + (fr & 3) * 8;
#pragma unroll
            for (int dt = 0; dt < 16; ++dt) {
                const s16x4 lo = __builtin_amdgcn_ds_read_tr16_b64_v4i16((__attribute__((address_space(3))) s16x4*)(tb + dt * 32));
                bf16x8 vf; vf[0] = lo[0]; vf[1] = lo[1]; vf[2] = lo[2]; vf[3] = lo[3]; vf[4] = 0; vf[5] = 0; vf[6] = 0; vf[7] = 0;
                oacc[dt] = __builtin_amdgcn_mfma_f32_16x16x32_bf16(vf, pf, oacc[dt], 0, 0, 0);
            }
        }
        __syncthreads();
        float* wm = reinterpret_cast<float*>(smem + 65536);
        float* wl = wm + 64;
        float* ob = reinterpret_cast<float*>(smem);
        if (fq == 0) { wm[wid * 16 + fr] = mrun; wl[wid * 16 + fr] = lrun; }
        if (fr < 8) {
#pragma unroll
            for (int dt = 0; dt < 16; ++dt) {
                float4 v; v.x = oacc[dt][0]; v.y = oacc[dt][1]; v.z = oacc[dt][2]; v.w = oacc[dt][3];
                *reinterpret_cast<float4*>(ob + ((size_t)wid * 8 + fr) * 256 + dt * 16 + fq * 4) = v;
            }
        }
        __syncthreads();
        {
            float* pp = p.part + ((size_t)bs * D_NCH + ch) * 8 * 258;
#pragma unroll
            for (int h = 0; h < 8; ++h) {
                const float m0 = wm[h], m1 = wm[16 + h], m2 = wm[32 + h], m3 = wm[48 + h];
                const float M = fmaxf(fmaxf(m0, m1), fmaxf(m2, m3));
                const float e0 = __builtin_amdgcn_exp2f(m0 - M), e1 = __builtin_amdgcn_exp2f(m1 - M), e2 = __builtin_amdgcn_exp2f(m2 - M), e3 = __builtin_amdgcn_exp2f(m3 - M);
                const float a = ob[(0 * 8 + h) * 256 + tid] * e0 + ob[(1 * 8 + h) * 256 + tid] * e1 + ob[(2 * 8 + h) * 256 + tid] * e2 + ob[(3 * 8 + h) * 256 + tid] * e3;
                pp[h * 258 + 2 + tid] = a;
                if (tid == 0) { pp[h * 258] = M; pp[h * 258 + 1] = wl[h] * e0 + wl[16 + h] * e1 + wl[32 + h] * e2 + wl[48 + h] * e3; }
            }
        }
        __syncthreads();
    }
}
__device__ __forceinline__ void ph_decode_comb2(const P& p, int layer, char* smem) {
    const int tid_ = opaque_v((int)threadIdx.x); const int bid_ = opaque_s((int)blockIdx.x);
    float* sw = (float*)smem;
    float* so = sw + 20;
    float* sLp = so + 256;
    VB_LOOP(NS * 8) {
        int bs = vb / 8, h = vb % 8, tid = tid_;
        const float* pb = p.part + (size_t)bs * D_NCH * 8 * 258 + h * 258;
        const float* latn = p.lat + (size_t)(NPT + bs) * KVL;
        if (tid < 64) {
            const float4 q4 = *reinterpret_cast<const float4*>(p.qlat + ((size_t)bs * 8 + h) * 256 + tid * 4);
            const float4 l4 = *reinterpret_cast<const float4*>(latn + tid * 4);
            float sn = q4.x * l4.x + q4.y * l4.y + q4.z * l4.z + q4.w * l4.w;
            if (tid < 32) sn += p.q[(size_t)(NPT + bs) * 768 + h * 96 + 64 + tid] * ATT_SCALE * p.kpe[(size_t)(NPT + bs) * 32 + tid];
            sn = wave_sum(sn) * 1.4426950408889634f;
            float m = sn;
            if (tid < D_NCH) m = fmaxf(m, pb[(size_t)tid * 8 * 258]);
            m = wave_max(m);
            float l = 0.f;
            if (tid < D_NCH) {
                float w = __builtin_amdgcn_exp2f(pb[(size_t)tid * 8 * 258] - m);
                sw[tid] = w;
                l = w * pb[(size_t)tid * 8 * 258 + 1];
            }
            const float wn = __builtin_amdgcn_exp2f(sn - m);
            if (tid == 0) { sw[D_NCH] = wn; l += wn; }
            l = wave_sum(l);
            if (tid == 0) sLp[0] = l;
        }
        __syncthreads();
        float a = sw[D_NCH] * latn[tid];
        for (int c = 0; c < D_NCH; ++c) a += sw[c] * pb[(size_t)c * 8 * 258 + 2 + tid];
        so[tid] = a / sLp[0];
        __syncthreads();
        if (tid < 64) {
            const float* w = p.w_kvb + (size_t)layer * 256 * 1024 + h * 128 + 64 + tid;
            float sacc = 0.f;
            for (int r = 0; r < 256; ++r) sacc += so[r] * w[(size_t)r * 1024];
            p.ob[(size_t)(NPT + bs) * 512 + h * 64 + tid] = f2bf(sacc);
        }
        __syncthreads();
    }
}

#define BAR() xcd_barrier(bar)
#define NPAD_IN 5376

__global__ void __launch_bounds__(256, 2) k_fwd(P p) {
    __shared__ uint4 xb_words;
    __shared__ __attribute__((aligned(16))) char smem[73728];
    if (threadIdx.x == 0) xb_words = make_uint4(0u, 0u, 0u, 0u);
    __syncthreads();
    XcdBarrier bar = xcd_barrier_post(p.bar, (volatile LAS unsigned*)&xb_words);

    ph_rope_table(p);
    ph_copy_x(p);
#pragma unroll 1
    for (int l = 0; l < DEPTH; ++l) {
        ph_convert_w(p.w_in + (size_t)l * DM * DIN, DM, DIN, NPAD_IN, p.wt_in + (size_t)l * NPAD_IN * DM, smem);
        ph_convert_w(p.w_ssm_proj + (size_t)l * DM * DM, DM, DM, DM, p.wt_ssm + (size_t)l * DM * DM, smem);
        ph_convert_w(p.w_qb + (size_t)l * QL * 768, QL, 768, 768, p.wt_qb + (size_t)l * 768 * QL, smem);
        ph_convert_w(p.w_kvb + (size_t)l * KVL * 1024, KVL, 1024, 1024, p.wt_kvb + (size_t)l * 1024 * KVL, smem);
        ph_convert_w(p.w_mla_proj + (size_t)l * 512 * DM, 512, DM, DM, p.wt_mla + (size_t)l * DM * 512, smem);
        ph_convert_w(p.w_out + (size_t)l * DM * DM, DM, DM, DM, p.wt_out + (size_t)l * DM * DM, smem);
    }
    ph_convert_plain(p.peer_wq, p.wqb, (size_t)DEPTH * DM * 2048);
    ph_convert_plain(p.peer_keys, p.keysb, (size_t)DEPTH * 16 * 128 * 128);
    ph_convert_fp8(p.peer_u, p.u8, p.uinv, DEPTH * NEXP);
    ph_convert_fp8(p.peer_v, p.v8, p.vinv, DEPTH * NEXP);
#if PROBE_PRO
    ph_convert_fp8(p.peer_u, p.u8, p.uinv, DEPTH * NEXP);
    ph_convert_fp8(p.peer_v, p.v8, p.vinv, DEPTH * NEXP);
#endif
    BAR();
#pragma unroll 1
    for (int c = 0; c < DEPTH * 16; ++c) {
        const int l = c >> 4, hh = c & 15;
        gemm_bf16(p.keysb + (size_t)c * 128 * 128, 128, p.wqb + (size_t)l * DM * 2048 + hh * 128, 2048, 1, 8, 128, smem,
                  EpiStoreBf{p.wt_pq + (size_t)l * 2048 * DM + (size_t)hh * 128 * DM, DM}, c * 8);
    }
    BAR();
#pragma unroll 1
    for (int l = 0; l < DEPTH; ++l) {
        ph_rmsnorm(p.xres, DM, p.norm_mix + l * DM, nullptr, 0, p.hb, DM, DM, TP);
#if PROBE_ELEM
        ph_rmsnorm(p.xres, DM, p.norm_mix + l * DM, nullptr, 0, p.hb, DM, DM, TP);
#endif
        BAR();
        gemm_bf16(p.hb, DM, p.wt_in + (size_t)l * NPAD_IN * DM, DM, TP / 128, NPAD_IN / 128, DM, smem, EpiStore{p.proj, DIN, DIN});
#if PROBE_GEMM
        gemm_bf16(p.hb, DM, p.wt_in + (size_t)l * NPAD_IN * DM, DM, TP / 128, NPAD_IN / 128, DM, smem, EpiStore{p.proj, DIN, DIN});
#endif
        BAR();
        ph_conv(p, l);
#if PROBE_ELEM
        ph_conv(p, l);
#endif
        ph_dt(p, l);
#if PROBE_ELEM
        ph_dt(p, l);
#endif
        ph_rmsnorm(p.proj + OFF_CQ, DIN, p.q_norm + l * QL, nullptr, 0, p.qnb, QL, QL, TP);
#if PROBE_ELEM
        ph_rmsnorm(p.proj + OFF_CQ, DIN, p.q_norm + l * QL, nullptr, 0, p.qnb, QL, QL, TP);
#endif
        ph_rmsnorm(p.proj + OFF_CKV, DIN, p.kv_norm + l * KVL, p.lat, KVL, p.latb, KVL, KVL, TP);
#if PROBE_ELEM
        ph_rmsnorm(p.proj + OFF_CKV, DIN, p.kv_norm + l * KVL, p.lat, KVL, p.latb, KVL, KVL, TP);
#endif
        BAR();
        ph_ssd_chunk(p, l, smem);
#if PROBE_SSD
        ph_ssd_chunk(p, l, smem);
#endif
        ph_ssd_seq(p, l);
        gemm_bf16(p.qnb, QL, p.wt_qb + (size_t)l * 768 * QL, QL, TP / 128, 768 / 128, QL, smem, EpiStore{p.q, 768, 768}, 128);
#if PROBE_GEMM
        gemm_bf16(p.qnb, QL, p.wt_qb + (size_t)l * 768 * QL, QL, TP / 128, 768 / 128, QL, smem, EpiStore{p.q, 768, 768}, 128);
#endif
        gemm_bf16(p.latb, KVL, p.wt_kvb + (size_t)l * 1024 * KVL, KVL, TP / 128, 1024 / 128, KVL, smem, EpiKV{p.kn, p.vT}, 128);
#if PROBE_GEMM
        gemm_bf16(p.latb, KVL, p.wt_kvb + (size_t)l * 1024 * KVL, KVL, TP / 128, 1024 / 128, KVL, smem, EpiKV{p.kn, p.vT}, 128);
#endif
        BAR();
        ph_mla_post(p, l);
        ph_gate_norm(p, l);
#if PROBE_ELEM
        ph_gate_norm(p, l);
#endif
        BAR();
        ph_attn(p, smem);
#if PROBE_ATTN
        ph_attn(p, smem);
#endif
        ph_qlat(p, l);
        gemm_bf16(p.ynb, DM, p.wt_ssm + (size_t)l * DM * DM, DM, TP / 128, DM / 128, DM, smem, EpiStore{p.ya, DM, DM});
#if PROBE_GEMM
        gemm_bf16(p.ynb, DM, p.wt_ssm + (size_t)l * DM * DM, DM, TP / 128, DM / 128, DM, smem, EpiStore{p.ya, DM, DM});
#endif
        BAR();
        ph_decode2(p, l, smem);
#if PROBE_DEC
        ph_decode2(p, l, smem);
#endif
        BAR();
        ph_decode_comb2(p, l, smem);
        BAR();
        gemm_bf16(p.ob, 512, p.wt_mla + (size_t)l * DM * 512, 512, TP / 128, DM / 128, 512, smem, EpiStore{p.yb, DM, DM});
#if PROBE_GEMM
        gemm_bf16(p.ob, 512, p.wt_mla + (size_t)l * DM * 512, 512, TP / 128, DM / 128, 512, smem, EpiStore{p.yb, DM, DM});
#endif
        BAR();
        ph_mix(p, l);
#if PROBE_ELEM
        ph_mix(p, l);
#endif
        BAR();
        gemm_bf16(p.mixb, DM, p.wt_out + (size_t)l * DM * DM, DM, TP / 128, DM / 128, DM, smem, EpiAccum{p.xres, DM});
        BAR();
        ph_rmsnorm(p.xres, DM, p.norm_ffn + l * DM, nullptr, 0, p.hb, DM, DM, TP);
#if PROBE_ELEM
        ph_rmsnorm(p.xres, DM, p.norm_ffn + l * DM, nullptr, 0, p.hb, DM, DM, TP);
#endif
        BAR();
        gemm_bf16(p.hb, DM, p.wt_pq + (size_t)l * 2048 * DM, DM, TP / 128, 2048 / 128, DM, smem, EpiStore{p.sc, 2048, 2048});
#if PROBE_GEMM
        gemm_bf16(p.hb, DM, p.wt_pq + (size_t)l * 2048 * DM, DM, TP / 128, 2048 / 128, DM, smem, EpiStore{p.sc, 2048, 2048});
#endif
        BAR();
        ph_peer_topk2(p);
#if PROBE_TOPK
        ph_peer_topk2(p);
#endif
        BAR();
#if PROBE_EXP
        ph_peer_experts3(p, l, true);
#endif
        ph_peer_experts3(p, l);
        BAR();
    }
    ph_rmsnorm(p.xres, DM, p.norm_final, p.out + O_YP, DM, nullptr, 0, DM, NT);
}

static inline char* carve_b(char*& cur, size_t bytes) {
    char* r = cur;
    cur += ((bytes + 255) / 256) * 256;
    return r;
}
static inline float* carve(char*& cur, size_t nfloats) { return (float*)carve_b(cur, nfloats * 4); }
static inline bf16_t* carve_h(char*& cur, size_t n) { return (bf16_t*)carve_b(cur, n * 2); }

extern "C" void kernel_launch(void* const* d_in, const int* in_sizes, int n_in,
                              void* d_out, int out_size, void* d_ws, size_t ws_size,
                              hipStream_t stream) {
    P p{};
    p.x_prompt = (const float*)d_in[0]; p.x_sample = (const float*)d_in[1];
    p.cache_lat = (const float*)d_in[2]; p.cache_kr = (const float*)d_in[3];
    p.state_ssm = (const float*)d_in[4]; p.state_conv = (const float*)d_in[5];
    p.page_table = (const int*)d_in[6];
    p.norm_mix = (const float*)d_in[7]; p.w_in = (const float*)d_in[8]; p.b_gate = (const float*)d_in[9];
    p.conv_w = (const float*)d_in[10]; p.conv_b = (const float*)d_in[11]; p.dt_bias = (const float*)d_in[12];
    p.a_log = (const float*)d_in[13]; p.d_skip = (const float*)d_in[14]; p.ssm_norm = (const float*)d_in[15];
    p.w_ssm_proj = (const float*)d_in[16]; p.q_norm = (const float*)d_in[17]; p.w_qb = (const float*)d_in[18];
    p.kv_norm = (const float*)d_in[19]; p.w_kvb = (const float*)d_in[20]; p.w_mla_proj = (const float*)d_in[21];
    p.w_out = (const float*)d_in[22]; p.norm_ffn = (const float*)d_in[23]; p.peer_wq = (const float*)d_in[24];
    p.peer_keys = (const float*)d_in[25]; p.peer_u = (const float*)d_in[26]; p.peer_v = (const float*)d_in[27];
    p.norm_final = (const float*)d_in[28];
    p.out = (float*)d_out;
    char* cur = (char*)d_ws;
    p.bar = (unsigned*)carve(cur, XCD_BAR_WORDS);
    char* zero_begin = (char*)d_ws;
    p.xres = carve(cur, (size_t)TP * DM);
    p.proj = carve(cur, (size_t)TP * DIN);
    p.xbc = carve(cur, (size_t)TP * CONVD);
    p.dt = carve(cur, (size_t)TP * 16);
    p.yraw = carve(cur, (size_t)TP * DM);
    p.ya = carve(cur, (size_t)TP * DM);
    p.q = carve(cur, (size_t)TP * 768);
    p.lat = carve(cur, (size_t)TP * KVL);
    p.kpe = carve(cur, (size_t)TP * 32);
    p.yb = carve(cur, (size_t)TP * DM);
    p.sc = carve(cur, (size_t)TP * 2048);
    p.gate = carve(cur, (size_t)TP * 128);
    p.part = carve(cur, (size_t)NS * 129 * 8 * 258);
    p.qlat = carve(cur, (size_t)NS * 8 * 256);
    p.rope = carve(cur, (size_t)2 * 2049 * 16);
    p.idx = (int*)carve(cur, (size_t)TP * 128);
    p.hb = carve_h(cur, (size_t)TP * DM);
    p.ynb = carve_h(cur, (size_t)TP * DM);
    p.qnb = carve_h(cur, (size_t)TP * QL);
    p.latb = carve_h(cur, (size_t)TP * KVL);
    p.ob = carve_h(cur, (size_t)TP * 512);
    p.mixb = carve_h(cur, (size_t)TP * DM);
    p.qb = carve_h(cur, (size_t)TP * 768);
    p.kn = carve_h(cur, (size_t)TP * 512);
    p.kpeb = carve_h(cur, (size_t)TP * 32);
    p.vT = carve_h(cur, (size_t)NB * 8 * 64 * SEQ);
    p.xbcb = carve_h(cur, (size_t)TP * CONVD);
    char* zero_end = cur;
    p.wt_in = carve_h(cur, (size_t)DEPTH * NPAD_IN * DM);
    p.wt_ssm = carve_h(cur, (size_t)DEPTH * DM * DM);
    p.wt_qb = carve_h(cur, (size_t)DEPTH * 768 * QL);
    p.wt_kvb = carve_h(cur, (size_t)DEPTH * 1024 * KVL);
    p.wt_mla = carve_h(cur, (size_t)DEPTH * DM * 512);
    p.wt_out = carve_h(cur, (size_t)DEPTH * DM * DM);
    p.wt_pq = carve_h(cur, (size_t)DEPTH * 2048 * DM);
    p.wqb = carve_h(cur, (size_t)DEPTH * DM * 2048);
    p.keysb = carve_h(cur, (size_t)DEPTH * 16 * 128 * 128);
    p.u8 = (unsigned char*)carve_b(cur, (size_t)DEPTH * NEXP * DM);
    p.v8 = (unsigned char*)carve_b(cur, (size_t)DEPTH * NEXP * DM);
    p.uinv = carve(cur, (size_t)DEPTH * NEXP);
    p.vinv = carve(cur, (size_t)DEPTH * NEXP);

    (void)hipMemsetAsync(zero_begin, 0, (size_t)(zero_end - zero_begin), stream);

    static int grid = 0;
    if (!grid) {
        int dev = 0, cus = 0, per_cu = 0;
        (void)hipGetDevice(&dev);
        (void)hipDeviceGetAttribute(&cus, hipDeviceAttributeMultiprocessorCount, dev);
        (void)hipOccupancyMaxActiveBlocksPerMultiprocessor(&per_cu, k_fwd, 256, 0);
        if (per_cu > 2) per_cu = 2;
        if (per_cu < 1) per_cu = 1;
        grid = cus * per_cu;
    }
    k_fwd<<<grid, 256, 0, stream>>>(p);
}
```

```cpp
#include <hip/hip_runtime.h>
#include <stdint.h>

#define DM 1024
#define NB 8
#define SEQ 2048
#define NPT (NB * SEQ)
#define NS 32
#define NT (NPT + NS)
#define TP 16512
#define DEPTH 2
#define PAST 16384
#define PAGE 128
#define NPAGES 128
#define NPOOL 5120
#define DIN 5296
#define OFF_GA 0
#define OFF_GB 1024
#define OFF_Z 2048
#define OFF_XBC 3072
#define OFF_DT 4608
#define OFF_CQ 4624
#define OFF_CKV 5008
#define OFF_KR 5264
#define CONVD 1536
#define QL 384
#define KVL 256
#define NEXP 16384
#define EPSF 1e-6f
#define ATT_SCALE 0.10206207261596577f

#define O_YP 0
#define O_YS (O_YP + NPT * DM)
#define O_LATP (O_YS + NS * DM)
#define O_KRP (O_LATP + DEPTH * NPT * KVL)
#define O_SSMP (O_KRP + DEPTH * NPT * 32)
#define O_CONVP (O_SSMP + DEPTH * NB * 16 * 64 * 128)
#define O_LATS (O_CONVP + DEPTH * NB * 3 * CONVD)
#define O_KRS (O_LATS + DEPTH * NS * KVL)
#define O_SSMS (O_KRS + DEPTH * NS * 32)
#define O_CONVS (O_SSMS + DEPTH * NS * 16 * 64 * 128)

struct P {
    const float *x_prompt, *x_sample, *cache_lat, *cache_kr, *state_ssm, *state_conv;
    const int* page_table;
    const float *norm_mix, *w_in, *b_gate, *conv_w, *conv_b, *dt_bias, *a_log, *d_skip, *ssm_norm, *w_ssm_proj;
    const float *q_norm, *w_qb, *kv_norm, *w_kvb, *w_mla_proj, *w_out, *norm_ffn, *peer_wq, *peer_keys, *peer_u, *peer_v, *norm_final;
    float* out;
    float *xres, *h, *proj, *xbc, *dt, *yraw, *yn, *ya, *qn, *q, *lat, *kpe, *kv, *o, *yb, *mix, *pq, *sc, *gate, *part, *qlat, *rope;
    int* idx;
    unsigned* bar;
    unsigned short *hb, *ynb, *qnb, *latb, *ob, *mixb, *qb, *kn, *kpeb, *vT, *xbcb, *xbr, *gab, *zs;
    float *cq, *ckv, *kr, *rstd, *sumsq1;
    unsigned short* xb;
    unsigned short *wt_in, *wt_ssm, *wt_qb, *wt_kvb, *wt_mla, *wt_out, *wt_pq, *wqb, *keysb;
    unsigned char *u8, *v8;
    float *uinv, *vinv;
};

#define XB_TMO      128
#define XB_XCNT(j)  (256  + 64 * (j))
#define XB_XSUB(j)  (1280 + 64 * (j))
#define XB_XGEN(j)  (2304 + 64 * (j))
#define XB_TOP      3328
#define XB_TOPGEN   3392
#define XCD_BAR_WORDS 3456
#define XB_SPIN_CAP (1u << 18)
#define LAS __attribute__((address_space(3)))

__device__ __forceinline__ unsigned xb_ld(unsigned* p)              { return __hip_atomic_load(p, __ATOMIC_RELAXED, __HIP_MEMORY_SCOPE_AGENT); }
__device__ __forceinline__ unsigned xb_add(unsigned* p, unsigned v) { return __hip_atomic_fetch_add(p, v, __ATOMIC_RELAXED, __HIP_MEMORY_SCOPE_AGENT); }
__device__ __forceinline__ unsigned xb_xcc_id() { return (unsigned)__builtin_amdgcn_s_getreg((3 << 11) | 20) & 0xFu; }
#define XB_SPIN(cond, bar) do { unsigned _sp = 0; while (cond) { __builtin_amdgcn_s_sleep(1); \
    if ((++_sp & 255u) == 0u) { if (xb_ld(&(bar)[XB_TMO])) break; if (_sp > XB_SPIN_CAP) { atomicAdd(&(bar)[XB_TMO], 1u); break; } } } } while (0)

struct XcdBarrier {
    unsigned* bar; unsigned x;
    volatile LAS unsigned* st;
};

__device__ __forceinline__ XcdBarrier xcd_barrier_post(unsigned* bar, volatile LAS unsigned* st) {
    XcdBarrier b; b.bar = bar; b.x = xb_xcc_id(); b.st = st;
    if (threadIdx.x == 0) (void)xb_add(&bar[XB_XCNT(b.x)], 1u);
    return b;
}
__device__ __forceinline__ void xcd_barrier_complete(unsigned* bar, unsigned x, unsigned& nloc, unsigned& nx) {
    const unsigned G = gridDim.x * gridDim.y * gridDim.z;
    unsigned sum, cnt, mine, sp = 0u;
    for (;;) {
        sum = 0u; cnt = 0u; mine = 0u;
#pragma unroll
        for (unsigned j = 0; j < 16; ++j) { const unsigned c = xb_ld(&bar[XB_XCNT(j)]); sum += c; cnt += (c > 0u) ? 1u : 0u; mine = (j == x) ? c : mine; }
        if (sum == G) break;
        __builtin_amdgcn_s_sleep(1);
        if ((++sp & 255u) == 0u) { if (xb_ld(&bar[XB_TMO])) break; if (sp > XB_SPIN_CAP) { atomicAdd(&bar[XB_TMO], 1u); break; } }
    }
    nloc = mine > 0u ? mine : 1u; nx = cnt > 0u ? cnt : 1u;
}

__device__ __forceinline__ void xcd_barrier(const XcdBarrier& b) {
    asm volatile("s_waitcnt vmcnt(0)" ::: "memory");
    __syncthreads();
    if (threadIdx.x == 0) {
        unsigned* bar = b.bar;
        __builtin_amdgcn_s_waitcnt(0);
        unsigned nloc = b.st[0], nx = b.st[1];
        if (nloc == 0u) { xcd_barrier_complete(bar, b.x, nloc, nx); b.st[0] = nloc; b.st[1] = nx; }
        const unsigned old = xb_add(&bar[XB_XSUB(b.x)], 1u);
        const unsigned gen = old / nloc;
        if (old + 1u == (gen + 1u) * nloc) {
            __builtin_amdgcn_fence(__ATOMIC_RELEASE, "agent");
            asm volatile("s_waitcnt vmcnt(0)" ::: "memory");
            const unsigned og = xb_add(&bar[XB_TOP], 1u);
            const unsigned tg = og / nx;
            if (og + 1u == (tg + 1u) * nx) xb_add(&bar[XB_TOPGEN], 1u);
            else XB_SPIN(xb_ld(&bar[XB_TOPGEN]) == tg, bar);
            __builtin_amdgcn_fence(__ATOMIC_ACQUIRE, "agent");
            xb_add(&bar[XB_XGEN(b.x)], 1u);
            asm volatile("s_waitcnt vmcnt(0)" ::: "memory");
        } else {
            XB_SPIN(xb_ld(&bar[XB_XGEN(b.x)]) == gen, bar);
            __builtin_amdgcn_fence(__ATOMIC_ACQUIRE, "agent");
            asm volatile("s_waitcnt vmcnt(0)" ::: "memory");
        }
    }
    __syncthreads();
}


__device__ __forceinline__ float wave_sum(float v) {
#pragma unroll
    for (int o = 32; o > 0; o >>= 1) v += __shfl_xor(v, o);
    return v;
}
__device__ __forceinline__ float wave_max(float v) {
#pragma unroll
    for (int o = 32; o > 0; o >>= 1) v = fmaxf(v, __shfl_xor(v, o));
    return v;
}
__device__ __forceinline__ float silu_f(float x) { return x / (1.f + expf(-x)); }
__device__ __forceinline__ float sigmoid_f(float x) { return 1.f / (1.f + expf(-x)); }


__device__ __forceinline__ int opaque_v(int x) { asm volatile("" : "+v"(x)); return x; }
__device__ __forceinline__ int opaque_s(int x) { asm volatile("" : "+s"(x)); return x; }

#ifndef PROBE_GEMM
#define PROBE_GEMM 0
#endif
#ifndef PROBE_TOPK
#define PROBE_TOPK 0
#endif
#ifndef PROBE_ATTN
#define PROBE_ATTN 0
#endif
#ifndef PROBE_DEC
#define PROBE_DEC 0
#endif
#ifndef PROBE_SSD
#define PROBE_SSD 0
#endif
#ifndef PROBE_ELEM
#define PROBE_ELEM 0
#endif
#ifndef PROBE_EXP
#define PROBE_EXP 0
#endif
#ifndef PROBE_PRO2
#define PROBE_PRO2 0
#endif
#ifndef PROBE_WEFF
#define PROBE_WEFF 0
#endif
#ifndef PROBE_MISC
#define PROBE_MISC 0
#endif
#ifndef PROBE_BAR
#define PROBE_BAR 0
#endif
#ifndef PROBE_PRO
#define PROBE_PRO 0
#endif
#define NTHR 256
#define VB_LOOP(n) for (int vb = bid_; vb < (n); vb += gridDim.x)


typedef unsigned short bf16_t;
using bf16x8 = __attribute__((ext_vector_type(8))) short;
using f32x4 = __attribute__((ext_vector_type(4))) float;
typedef __attribute__((ext_vector_type(2))) __bf16 bf16x2_t;
__device__ __forceinline__ bf16_t f2bf(float f) { __bf16 h = (__bf16)f; return __builtin_bit_cast(unsigned short, h); }
__device__ __forceinline__ unsigned pack_bf16(float a, float b) { bf16x2_t r; r[0] = (__bf16)a; r[1] = (__bf16)b; return __builtin_bit_cast(unsigned, r); }
__device__ __forceinline__ float bf2f(bf16_t h) { return __uint_as_float(((unsigned)h) << 16); }
__device__ __forceinline__ float bflo(unsigned d) { return __uint_as_float(d << 16); }
__device__ __forceinline__ float bfhi(unsigned d) { return __uint_as_float(d & 0xffff0000u); }

__device__ __forceinline__ int lds_byte(int r, int c) {
    int st = (r >> 4) * 2 + (c >> 5), rr = r & 15, cc = c & 31, ob = rr * 64 + cc * 2;
    return st * 1024 + (ob ^ (((ob >> 9) & 1) << 5));
}
__device__ __forceinline__ void stage_rc(int b, int& R, int& C) {
    int st = b / 1024, sb = b % 1024, swz = sb ^ (((sb >> 9) & 1) << 5);
    R = (st >> 1) * 16 + swz / 64; C = (st & 1) * 32 + (swz % 64) / 2;
}
template <bool PERM>
__device__ __forceinline__ void stage_tile(const bf16_t* base, int ld, int row0, int k0, char* dst, int tid) {
#pragma unroll
    for (int i = 0; i < 4; ++i) {
        int b = tid * 16 + i * 4096;
        int R, C; stage_rc(b, R, C);
        if (PERM) R = (R & 64) + 4 * (R & 15) + ((R >> 4) & 3);
        const bf16_t* src = base + (size_t)(row0 + R) * ld + k0 + C;
        __builtin_amdgcn_global_load_lds((const unsigned*)src, (unsigned*)(dst + b), 16, 0, 0);
    }
}
__device__ __forceinline__ void tile_map(int id, int mtiles, int ntiles, int& mt, int& nt) {
    const int fg = mtiles >> 3, full = fg * ntiles * 8;
    if (id < full) { const int mg = id / (ntiles * 8), r = id % (ntiles * 8); nt = r >> 3; mt = mg * 8 + (r & 7); }
    else { const int rem = mtiles & 7, r = id - full; nt = r / rem; mt = fg * 8 + r % rem; }
}
template <class Epi>
__device__ __forceinline__ void gemm_bf16(const bf16_t* A, int lda, const bf16_t* Bt, int ldb, int mtiles, int ntiles, int K, char* smem, Epi epi, int vb0 = 0) {
    const int tid = opaque_v((int)threadIdx.x);
    int bid0 = (int)blockIdx.x - vb0;
    while (bid0 < 0) bid0 += (int)gridDim.x;
    const int bid = opaque_s(__builtin_amdgcn_readfirstlane(bid0));
    const int wid = tid >> 6, lane = tid & 63, wm = wid >> 1, wn = wid & 1, fr = lane & 15, fq = lane >> 4;
    const int nk = K / 64, total = mtiles * ntiles, G = (int)gridDim.x;
    const bool xcd = (G & 7) == 0;
    const int nq = G >> 3;
    for (int st = 0;; ++st) {
        const int id = xcd ? ((st * 8 + (bid & 7)) * nq + (bid >> 3)) : (st * G + bid);
        if (st * G >= total) break;
        if (id >= total) continue;
        int mt, nt; tile_map(id, mtiles, ntiles, mt, nt);
        const int m0 = mt * 128, n0 = nt * 128;
        f32x4 acc[4][4];
#pragma unroll
        for (int i = 0; i < 4; ++i)
#pragma unroll
            for (int j = 0; j < 4; ++j) acc[i][j] = f32x4{0.f, 0.f, 0.f, 0.f};
        stage_tile<false>(A, lda, m0, 0, smem, tid);
        stage_tile<true>(Bt, ldb, n0, 0, smem + 16384, tid);
        for (int kt = 0; kt < nk; ++kt) {
            asm volatile("s_waitcnt vmcnt(0)" ::: "memory");
            __syncthreads();
            if (kt + 1 < nk) {
                char* nb = smem + ((kt + 1) & 1) * 32768;
                stage_tile<false>(A, lda, m0, (kt + 1) * 64, nb, tid);
                stage_tile<true>(Bt, ldb, n0, (kt + 1) * 64, nb + 16384, tid);
            }
            const char* ab = smem + (kt & 1) * 32768;
            const char* bb = ab + 16384;
#pragma unroll
            for (int s2 = 0; s2 < 2; ++s2) {
                bf16x8 a[4], b[4];
#pragma unroll
                for (int i = 0; i < 4; ++i) a[i] = *reinterpret_cast<const bf16x8*>(ab + lds_byte(wm * 64 + i * 16 + fr, s2 * 32 + fq * 8));
#pragma unroll
                for (int j = 0; j < 4; ++j) b[j] = *reinterpret_cast<const bf16x8*>(bb + lds_byte(wn * 64 + j * 16 + fr, s2 * 32 + fq * 8));
#pragma unroll
                for (int i = 0; i < 4; ++i)
#pragma unroll
                    for (int j = 0; j < 4; ++j) acc[i][j] = __builtin_amdgcn_mfma_f32_16x16x32_bf16(a[i], b[j], acc[i][j], 0, 0, 0);
            }
        }
#pragma unroll
        for (int i = 0; i < 4; ++i) epi.blk(m0 + wm * 64 + i * 16 + fq * 4, n0 + wn * 64 + fr * 4, acc[i]);
        __syncthreads();
    }
}
#define EPI_ROWS __device__ __forceinline__ void blk(int m, int n, const f32x4 (&c)[4]) const { \
    row4(m + 0, n, c[0][0], c[1][0], c[2][0], c[3][0]); row4(m + 1, n, c[0][1], c[1][1], c[2][1], c[3][1]); \
    row4(m + 2, n, c[0][2], c[1][2], c[2][2], c[3][2]); row4(m + 3, n, c[0][3], c[1][3], c[2][3], c[3][3]); }
__device__ __forceinline__ uint2 pack4(float a, float b, float c, float d) { uint2 r; r.x = pack_bf16(a, b); r.y = pack_bf16(c, d); return r; }
struct EpiGateA { float* ya; const bf16_t* gab;
    __device__ __forceinline__ void row4(int m, int n, float v0, float v1, float v2, float v3) const {
        const uint2 g = *reinterpret_cast<const uint2*>(gab + (size_t)m * 2048 + n);
        *reinterpret_cast<float4*>(ya + (size_t)m * DM + n) = make_float4(bflo(g.x) * v0, bfhi(g.x) * v1, bflo(g.y) * v2, bfhi(g.y) * v3);
    } EPI_ROWS };
struct EpiGateB { const float* ya; const bf16_t* gab; bf16_t* mixb;
    __device__ __forceinline__ void row4(int m, int n, float v0, float v1, float v2, float v3) const {
        const uint2 g = *reinterpret_cast<const uint2*>(gab + (size_t)m * 2048 + 1024 + n);
        const float4 y = *reinterpret_cast<const float4*>(ya + (size_t)m * DM + n);
        *reinterpret_cast<uint2*>(mixb + (size_t)m * DM + n) = pack4(y.x + bflo(g.x) * v0, y.y + bfhi(g.x) * v1, y.z + bflo(g.y) * v2, y.w + bfhi(g.y) * v3);
    } EPI_ROWS };
struct EpiStore { float* C; int ldc; int N;
    __device__ __forceinline__ void row4(int m, int n, float v0, float v1, float v2, float v3) const { if (n < N) *reinterpret_cast<float4*>(C + (size_t)m * ldc + n) = make_float4(v0, v1, v2, v3); } EPI_ROWS };
struct EpiStoreBfCol { bf16_t* C; int ldc; const float* cs;
    __device__ __forceinline__ void row4(int m, int n, float v0, float v1, float v2, float v3) const {
        const float4 c4 = *reinterpret_cast<const float4*>(cs + n);
        *reinterpret_cast<uint2*>(C + (size_t)m * ldc + n) = pack4(v0 * c4.x, v1 * c4.y, v2 * c4.z, v3 * c4.w);
    } EPI_ROWS };
struct EpiScaleRow { float* C; int ldc; const float* sumsq;
    __device__ __forceinline__ void row4(int m, int n, float v0, float v1, float v2, float v3) const {
        const float rs = rsqrtf(sumsq[m] * (1.f / DM) + EPSF);
        *reinterpret_cast<float4*>(C + (size_t)m * ldc + n) = make_float4(v0 * rs, v1 * rs, v2 * rs, v3 * rs);
    } EPI_ROWS };
struct EpiResidRow { float* xres; bf16_t* xb; float* sumsq;
    __device__ __forceinline__ void row4(int m, int n, float v0, float v1, float v2, float v3) const {
        float4* xp = reinterpret_cast<float4*>(xres + (size_t)m * DM + n);
        float4 x = *xp;
        x.x += v0; x.y += v1; x.z += v2; x.w += v3;
        *xp = x;
        *reinterpret_cast<uint2*>(xb + (size_t)m * DM + n) = pack4(x.x, x.y, x.z, x.w);
        float ss = x.x * x.x + x.y * x.y + x.z * x.z + x.w * x.w;
        ss += __shfl_xor(ss, 1); ss += __shfl_xor(ss, 2); ss += __shfl_xor(ss, 4); ss += __shfl_xor(ss, 8);
        if ((threadIdx.x & 15) == 0) atomicAdd(sumsq + m, ss);
    } EPI_ROWS };
struct EpiQRope { bf16_t* qb; float* q; const float* rope;
    __device__ __forceinline__ void row4(int m, int n, float v0, float v1, float v2, float v3) const {
        const float o0 = __shfl_xor(v0, 4), o1 = __shfl_xor(v1, 4), o2 = __shfl_xor(v2, 4), o3 = __shfl_xor(v3, 4);
        const int d = n % 96;
        float r0 = v0, r1 = v1, r2 = v2, r3 = v3;
        if (d >= 64) {
            const int pi = (m < NPT) ? (m & (SEQ - 1)) : 2048;
            const int dd = d - 64, jj = dd & 15;
            const float4 cs = *reinterpret_cast<const float4*>(rope + pi * 16 + jj);
            const float4 sn = *reinterpret_cast<const float4*>(rope + 2049 * 16 + pi * 16 + jj);
            if (dd < 16) { r0 = v0 * cs.x - o0 * sn.x; r1 = v1 * cs.y - o1 * sn.y; r2 = v2 * cs.z - o2 * sn.z; r3 = v3 * cs.w - o3 * sn.w; }
            else { r0 = o0 * sn.x + v0 * cs.x; r1 = o1 * sn.y + v1 * cs.y; r2 = o2 * sn.z + v2 * cs.z; r3 = o3 * sn.w + v3 * cs.w; }
        }
        const float qsc = ATT_SCALE * 1.4426950408889634f;
        *reinterpret_cast<uint2*>(qb + (size_t)m * 768 + n) = pack4(r0 * qsc, r1 * qsc, r2 * qsc, r3 * qsc);
        if (m >= NPT) *reinterpret_cast<float4*>(q + (size_t)m * 768 + n) = make_float4(r0, r1, r2, r3);
    } EPI_ROWS };
struct EpiStoreBf { bf16_t* C; int ldc;
    __device__ __forceinline__ void row4(int m, int n, float v0, float v1, float v2, float v3) const { *reinterpret_cast<uint2*>(C + (size_t)m * ldc + n) = pack4(v0, v1, v2, v3); } EPI_ROWS };
__device__ __forceinline__ void ph_convert_plain(const float* src, bf16_t* dst, size_t n) {
    const int tid = opaque_v((int)threadIdx.x); const int bid = opaque_s((int)blockIdx.x);
    for (size_t i = ((size_t)bid * NTHR + tid) * 4; i < n; i += (size_t)gridDim.x * NTHR * 4) {
        float4 v = *(const float4*)(src + i);
        ushort4 o; o.x = f2bf(v.x); o.y = f2bf(v.y); o.z = f2bf(v.z); o.w = f2bf(v.w);
        *(ushort4*)(dst + i) = o;
    }
}
__device__ __forceinline__ void ph_convert_w(const float* W, int K, int N, int Npad, bf16_t* Bt, char* smem, const float* kscale = nullptr) {
    const int tid = opaque_v((int)threadIdx.x); const int bid = opaque_s((int)blockIdx.x);
    float (*t)[65] = (float (*)[65])smem;
    int tk = K / 64, tn = Npad / 64;
    for (int vb = bid; vb < tk * tn; vb += gridDim.x) {
        int k0 = (vb % tk) * 64, n0 = (vb / tk) * 64;
        for (int i = tid; i < 64 * 64; i += NTHR) {
            int kk = i >> 6, nn = i & 63;
            t[kk][nn] = (n0 + nn < N) ? W[(size_t)(k0 + kk) * N + n0 + nn] * (kscale ? kscale[k0 + kk] : 1.f) : 0.f;
        }
        __syncthreads();
        for (int i = tid; i < 64 * 64; i += NTHR) {
            int nn = i >> 6, kk = i & 63;
            Bt[(size_t)(n0 + nn) * K + k0 + kk] = f2bf(t[kk][nn]);
        }
        __syncthreads();
    }
}

__device__ __forceinline__ void ph_rope_table(const P& p) {
    const int tid_ = opaque_v((int)threadIdx.x); const int bid_ = opaque_s((int)blockIdx.x); (void)tid_; (void)bid_;
    for (int i = bid_ * NTHR + tid_; i < 2049 * 16; i += gridDim.x * NTHR) {
        int pi = i / 16, j = i % 16;
        float pos = (pi == 2048) ? 16384.f : (float)pi;
        float inv = powf(10000.f, -(float)j / 16.f);
        float ang = pos * inv;
        p.rope[i] = (float)cos((double)ang);
        p.rope[2049 * 16 + i] = (float)sin((double)ang);
    }
}
__device__ __forceinline__ void ph_copy_x(const P& p) {
    const int tid_ = opaque_v((int)threadIdx.x); const int bid_ = opaque_s((int)blockIdx.x);
    const int wid = tid_ >> 6, lane = tid_ & 63;
    for (int t = bid_ * 4 + wid; t < NT; t += (int)gridDim.x * 4) {
        const float* src = (t < NPT) ? (p.x_prompt + (size_t)t * DM) : (p.x_sample + (size_t)(t - NPT) * DM);
        const float4* sp = reinterpret_cast<const float4*>(src + lane * 16);
        float4 v[4]; float ss = 0.f;
#pragma unroll
        for (int q4 = 0; q4 < 4; ++q4) { v[q4] = sp[q4]; ss += v[q4].x * v[q4].x + v[q4].y * v[q4].y + v[q4].z * v[q4].z + v[q4].w * v[q4].w; }
        ss = wave_sum(ss);
        float4* xp = reinterpret_cast<float4*>(p.xres + (size_t)t * DM + lane * 16);
#pragma unroll
        for (int q4 = 0; q4 < 4; ++q4) xp[q4] = v[q4];
        uint4 b0, b1;
        b0.x = pack_bf16(v[0].x, v[0].y); b0.y = pack_bf16(v[0].z, v[0].w); b0.z = pack_bf16(v[1].x, v[1].y); b0.w = pack_bf16(v[1].z, v[1].w);
        b1.x = pack_bf16(v[2].x, v[2].y); b1.y = pack_bf16(v[2].z, v[2].w); b1.z = pack_bf16(v[3].x, v[3].y); b1.w = pack_bf16(v[3].z, v[3].w);
        uint4* bp = reinterpret_cast<uint4*>(p.xb + (size_t)t * DM + lane * 16);
        bp[0] = b0; bp[1] = b1;
        if (lane == 0) p.rstd[t] = rsqrtf(ss * (1.f / DM) + EPSF);
    }
}
__device__ __forceinline__ void ph_rmsnorm(const float* in, int ldi, const float* w, float* out, int ldo, bf16_t* outb, int ldob, int D, int rows) {
    const int tid_ = opaque_v((int)threadIdx.x); const int bid_ = opaque_s((int)blockIdx.x); (void)tid_; (void)bid_;
    VB_LOOP((rows + 3) / 4) {
        int row = vb * 4 + (tid_ >> 6);
        int lane = tid_ & 63;
        if (row < rows) {
            const float* x = in + (size_t)row * ldi;
            float s = 0.f;
            for (int c = lane; c < D; c += 64) { float v = x[c]; s += v * v; }
            s = wave_sum(s);
            float r = rsqrtf(s / (float)D + EPSF);
            for (int c = lane; c < D; c += 64) {
                float v = x[c] * r * w[c];
                if (out) out[(size_t)row * ldo + c] = v;
                if (outb) outb[(size_t)row * ldob + c] = f2bf(v);
            }
        }
    }
}
__device__ __forceinline__ void ph_ssd_seq(const P& p, int layer) {
    const int tid_ = opaque_v((int)threadIdx.x); const int bid_ = opaque_s((int)blockIdx.x); (void)tid_; (void)bid_;
    VB_LOOP(NS * 16) {
        int seq = NB + vb / 16, e = vb % 16, g = e / 8;
        int pp = tid_ >> 2, nq = tid_ & 3;
        float A = -expf(p.a_log[layer * 16 + e]);
        float Dk = p.d_skip[layer * 16 + e];
        float s[32];
        int t0, L;
        float* hout;
        if (seq < NB) {
            t0 = seq * SEQ; L = SEQ;
#pragma unroll
            for (int j = 0; j < 32; ++j) s[j] = 0.f;
            hout = p.out + O_SSMP + (((size_t)(layer * NB + seq) * 16 + e) * 64 + pp) * 128 + nq * 32;
        } else {
            int bs = seq - NB;
            t0 = NPT + bs; L = 1;
            const float* h0 = p.state_ssm + (((size_t)(layer * NS + bs) * 16 + e) * 64 + pp) * 128 + nq * 32;
#pragma unroll
            for (int j = 0; j < 32; ++j) s[j] = h0[j];
            hout = p.out + O_SSMS + (((size_t)(layer * NS + bs) * 16 + e) * 64 + pp) * 128 + nq * 32;
        }
        for (int l = 0; l < L; ++l) {
            int t = t0 + l;
            float dt = p.dt[t * 16 + e];
            float dA = expf(dt * A);
            const bf16_t* xr = p.xbcb + (size_t)t * CONVD;
            float xv = bf2f(xr[e * 64 + pp]);
            float xdt = xv * dt;
            const bf16_t* Bp = xr + 1024 + g * 128 + nq * 32;
            const bf16_t* Cp = xr + 1280 + g * 128 + nq * 32;
            float ys = 0.f;
#pragma unroll
            for (int j4 = 0; j4 < 8; ++j4) {
                float4 b, c;
                b.x = bf2f(Bp[j4 * 4]); b.y = bf2f(Bp[j4 * 4 + 1]); b.z = bf2f(Bp[j4 * 4 + 2]); b.w = bf2f(Bp[j4 * 4 + 3]);
                c.x = bf2f(Cp[j4 * 4]); c.y = bf2f(Cp[j4 * 4 + 1]); c.z = bf2f(Cp[j4 * 4 + 2]); c.w = bf2f(Cp[j4 * 4 + 3]);
                s[j4 * 4 + 0] = s[j4 * 4 + 0] * dA + xdt * b.x; ys += c.x * s[j4 * 4 + 0];
                s[j4 * 4 + 1] = s[j4 * 4 + 1] * dA + xdt * b.y; ys += c.y * s[j4 * 4 + 1];
                s[j4 * 4 + 2] = s[j4 * 4 + 2] * dA + xdt * b.z; ys += c.z * s[j4 * 4 + 2];
                s[j4 * 4 + 3] = s[j4 * 4 + 3] * dA + xdt * b.w; ys += c.w * s[j4 * 4 + 3];
            }
            ys += __shfl_xor(ys, 1);
            ys += __shfl_xor(ys, 2);
            if (nq == 0) p.yraw[(size_t)t * DM + e * 64 + pp] = ys + Dk * xv;
        }
#pragma unroll
        for (int j = 0; j < 32; ++j) hout[j] = s[j];
    }
}
__device__ __forceinline__ void ph_gate_norm(const P& p, int layer) {
    const int tid_ = opaque_v((int)threadIdx.x); const int bid_ = opaque_s((int)blockIdx.x); (void)tid_; (void)bid_;
    VB_LOOP((NT * 2 + 3) / 4) {
        int w = vb * 4 + (tid_ >> 6);
        int lane = tid_ & 63;
        if (w < NT * 2) {
            int t = w >> 1, g = w & 1;
            float v[8];
            float ss = 0.f;
#pragma unroll
            for (int j = 0; j < 8; ++j) {
                int c = g * 512 + j * 64 + lane;
                float y = p.yraw[(size_t)t * DM + c];
                v[j] = y * bf2f(p.zs[(size_t)t * DM + c]);
                ss += v[j] * v[j];
            }
            ss = wave_sum(ss);
            float r = rsqrtf(ss / 512.f + EPSF);
#pragma unroll
            for (int j = 0; j < 8; ++j) {
                int c = g * 512 + j * 64 + lane;
                p.ynb[(size_t)t * DM + c] = f2bf(v[j] * r * p.ssm_norm[layer * DM + c]);
            }
        }
    }
}
__device__ __forceinline__ void ph_lat_kpe(const P& p, int layer) {
    const int tid_ = opaque_v((int)threadIdx.x); const int bid_ = opaque_s((int)blockIdx.x);
    VB_LOOP((NT + 3) / 4) {
        int t = vb * 4 + (tid_ >> 6);
        int lane = tid_ & 63;
        if (t < NT) {
            const float4 c4 = *reinterpret_cast<const float4*>(p.ckv + (size_t)t * KVL + lane * 4);
            float ss = wave_sum(c4.x * c4.x + c4.y * c4.y + c4.z * c4.z + c4.w * c4.w);
            const float r = rsqrtf(ss * (1.f / KVL) + EPSF);
            const float4 g4 = *reinterpret_cast<const float4*>(p.kv_norm + layer * KVL + lane * 4);
            const float4 l4 = make_float4(c4.x * r * g4.x, c4.y * r * g4.y, c4.z * r * g4.z, c4.w * r * g4.w);
            *reinterpret_cast<float4*>(p.lat + (size_t)t * KVL + lane * 4) = l4;
            *reinterpret_cast<uint2*>(p.latb + (size_t)t * KVL + lane * 4) = pack4(l4.x, l4.y, l4.z, l4.w);
            float* ol = (t < NPT) ? (p.out + O_LATP + ((size_t)layer * NPT + t) * KVL) : (p.out + O_LATS + ((size_t)layer * NS + (t - NPT)) * KVL);
            *reinterpret_cast<float4*>(ol + lane * 4) = l4;
            if (lane < 16) {
                int pi = (t < NPT) ? (t % SEQ) : 2048;
                const float* cs = p.rope + pi * 16;
                const float* sn = p.rope + 2049 * 16 + pi * 16;
                const float* kr = p.kr + (size_t)t * 32;
                float x1 = kr[lane], x2 = kr[16 + lane];
                float o1 = x1 * cs[lane] - x2 * sn[lane];
                float o2 = x1 * sn[lane] + x2 * cs[lane];
                p.kpe[(size_t)t * 32 + lane] = o1;
                p.kpe[(size_t)t * 32 + 16 + lane] = o2;
                p.kpeb[(size_t)t * 32 + lane] = f2bf(o1);
                p.kpeb[(size_t)t * 32 + 16 + lane] = f2bf(o2);
                float* ok = (t < NPT) ? (p.out + O_KRP + ((size_t)layer * NPT + t) * 32) : (p.out + O_KRS + ((size_t)layer * NS + (t - NPT)) * 32);
                ok[lane] = o1; ok[16 + lane] = o2;
            }
        }
    }
}

#define A_KRS 208
#define A_VRS 144
#define A_KBYTES (64 * A_KRS)
#define A_BUF (64 * A_KRS + 64 * A_VRS)
struct EpiKV { bf16_t* kn; bf16_t* vT;
    __device__ __forceinline__ void blk(int m, int n, const f32x4 (&c)[4]) const {
        const int h = n >> 7, j = n & 127;
        if (j < 64) {
#pragma unroll
            for (int r = 0; r < 4; ++r) *reinterpret_cast<uint2*>(kn + (size_t)(m + r) * 512 + h * 64 + j) = pack4(c[0][r], c[1][r], c[2][r], c[3][r]);
        } else if (m < NPT) {
#pragma unroll
            for (int jj = 0; jj < 4; ++jj)
                *reinterpret_cast<uint2*>(vT + ((size_t)((m >> 11) * 8 + h) * 64 + (j - 64 + jj)) * SEQ + (m & (SEQ - 1))) = pack4(c[jj][0], c[jj][1], c[jj][2], c[jj][3]);
        }
    } };
__device__ __forceinline__ void ph_attn(const P& p, char* smem) {
    const int tid = opaque_v((int)threadIdx.x); const int bid = opaque_s((int)blockIdx.x);
    const int wid = tid >> 6, lane = tid & 63, fr = lane & 15, fq = lane >> 4;
    const int G = (int)gridDim.x;
    for (int rnd = 0;; ++rnd) {
        int o = rnd * G + ((rnd & 1) ? (G - 1 - bid) : bid);
        if (rnd * G >= 1024) break;
        if (o >= 1024) continue;
        const int qblk = 15 - (o >> 6), bh = o & 63, b = bh >> 3, h = bh & 7;
        const int q0w = qblk * 128 + wid * 32;
        const size_t tok0 = (size_t)b * SEQ;
        bf16x8 qf[2][3];
#pragma unroll
        for (int qt = 0; qt < 2; ++qt)
#pragma unroll
            for (int s3 = 0; s3 < 3; ++s3)
                qf[qt][s3] = *reinterpret_cast<const bf16x8*>(p.qb + (tok0 + q0w + qt * 16 + fr) * 768 + h * 96 + s3 * 32 + fq * 8);
        f32x4 oacc[2][4];
        float mrun[2], lrun[2];
#pragma unroll
        for (int qt = 0; qt < 2; ++qt) {
            mrun[qt] = -INFINITY; lrun[qt] = 0.f;
#pragma unroll
            for (int mt = 0; mt < 4; ++mt) oacc[qt][mt] = f32x4{0.f, 0.f, 0.f, 0.f};
        }
        const int nkb = 2 * qblk + 2;
        uint4 stg0, stg1, stg2, stg3, stg4;
#define A_ISSUE(kb_) do { const size_t key0 = (size_t)(kb_) * 64; \
            { int c = tid; int row = c >> 3, ch = c & 7; stg0 = *reinterpret_cast<const uint4*>(p.kn + (tok0 + key0 + row) * 512 + h * 64 + ch * 8); } \
            { int c = tid + 256; int row = c >> 3, ch = c & 7; stg1 = *reinterpret_cast<const uint4*>(p.kn + (tok0 + key0 + row) * 512 + h * 64 + ch * 8); } \
            { int c = tid; int row = c >> 2, ch = c & 3; stg2 = *reinterpret_cast<const uint4*>(p.kpeb + (tok0 + key0 + row) * 32 + ch * 8); } \
            { int c = tid; int row = c >> 3, ch = c & 7; stg3 = *reinterpret_cast<const uint4*>(p.vT + ((size_t)(b * 8 + h) * 64 + row) * SEQ + key0 + ch * 8); } \
            { int c = tid + 256; int row = c >> 3, ch = c & 7; stg4 = *reinterpret_cast<const uint4*>(p.vT + ((size_t)(b * 8 + h) * 64 + row) * SEQ + key0 + ch * 8); } \
        } while (0)
#define A_COMMIT(buf_) do { char* buf = (buf_); \
            { int c = tid; int row = c >> 3, ch = c & 7; *reinterpret_cast<uint4*>(buf + row * A_KRS + ch * 16) = stg0; } \
            { int c = tid + 256; int row = c >> 3, ch = c & 7; *reinterpret_cast<uint4*>(buf + row * A_KRS + ch * 16) = stg1; } \
            { int c = tid; int row = c >> 2, ch = c & 3; *reinterpret_cast<uint4*>(buf + row * A_KRS + 128 + ch * 16) = stg2; } \
            { int c = tid; int row = c >> 3, ch = c & 7; *reinterpret_cast<uint4*>(buf + A_KBYTES + row * A_VRS + ch * 16) = stg3; } \
            { int c = tid + 256; int row = c >> 3, ch = c & 7; *reinterpret_cast<uint4*>(buf + A_KBYTES + row * A_VRS + ch * 16) = stg4; } \
        } while (0)
        A_ISSUE(0);
        A_COMMIT(smem);
        __syncthreads();
        for (int kb = 0; kb < nkb; ++kb) {
            const char* kbuf = smem + (kb & 1) * A_BUF;
            const char* vbuf = kbuf + A_KBYTES;
            if (kb + 1 < nkb) A_ISSUE(kb + 1);
#pragma unroll
            for (int kh = 0; kh < 2; ++kh) {
                const int k0 = kb * 64 + kh * 32;
                if (k0 <= q0w + 31) {
                    f32x4 st[2][2];
#pragma unroll
                    for (int qt = 0; qt < 2; ++qt)
#pragma unroll
                        for (int kt = 0; kt < 2; ++kt) st[qt][kt] = f32x4{0.f, 0.f, 0.f, 0.f};
#pragma unroll
                    for (int s3 = 0; s3 < 3; ++s3)
#pragma unroll
                        for (int kt = 0; kt < 2; ++kt) {
                            bf16x8 kf = *reinterpret_cast<const bf16x8*>(kbuf + (kh * 32 + kt * 16 + fr) * A_KRS + (s3 * 32 + fq * 8) * 2);
#pragma unroll
                            for (int qt = 0; qt < 2; ++qt) st[qt][kt] = __builtin_amdgcn_mfma_f32_16x16x32_bf16(kf, qf[qt][s3], st[qt][kt], 0, 0, 0);
                        }
                    const bool need_mask = (k0 + 31 > q0w);
                    bf16x8 pf[2];
#pragma unroll
                    for (int qt = 0; qt < 2; ++qt) {
                        if (need_mask) {
                            const int qi = q0w + qt * 16 + fr;
#pragma unroll
                            for (int kt = 0; kt < 2; ++kt)
#pragma unroll
                                for (int r = 0; r < 4; ++r)
                                    if (k0 + kt * 16 + fq * 4 + r > qi) st[qt][kt][r] = -INFINITY;
                        }
                        float mx = fmaxf(fmaxf(fmaxf(st[qt][0][0], st[qt][0][1]), fmaxf(st[qt][0][2], st[qt][0][3])),
                                         fmaxf(fmaxf(st[qt][1][0], st[qt][1][1]), fmaxf(st[qt][1][2], st[qt][1][3])));
                        mx = fmaxf(mx, __shfl_xor(mx, 16));
                        mx = fmaxf(mx, __shfl_xor(mx, 32));
                        const float mnew = fmaxf(mrun[qt], mx);
                        const float corr = __builtin_amdgcn_exp2f(mrun[qt] - mnew);
                        float pv[8];
                        float rs = 0.f;
#pragma unroll
                        for (int kt = 0; kt < 2; ++kt)
#pragma unroll
                            for (int r = 0; r < 4; ++r) { pv[kt * 4 + r] = __builtin_amdgcn_exp2f(st[qt][kt][r] - mnew); rs += pv[kt * 4 + r]; }
                        rs += __shfl_xor(rs, 16);
                        rs += __shfl_xor(rs, 32);
                        lrun[qt] = lrun[qt] * corr + rs;
                        mrun[qt] = mnew;
#pragma unroll
                        for (int mt = 0; mt < 4; ++mt) { oacc[qt][mt][0] *= corr; oacc[qt][mt][1] *= corr; oacc[qt][mt][2] *= corr; oacc[qt][mt][3] *= corr; }
                        uint4 pk;
                        pk.x = pack_bf16(pv[0], pv[1]); pk.y = pack_bf16(pv[2], pv[3]); pk.z = pack_bf16(pv[4], pv[5]); pk.w = pack_bf16(pv[6], pv[7]);
                        pf[qt] = __builtin_bit_cast(bf16x8, pk);
                    }
#pragma unroll
                    for (int mt = 0; mt < 4; ++mt) {
                        const char* vp = vbuf + (mt * 16 + fr) * A_VRS + (kh * 32 + fq * 4) * 2;
                        uint2 lo = *reinterpret_cast<const uint2*>(vp);
                        uint2 hi = *reinterpret_cast<const uint2*>(vp + 32);
                        uint4 vv; vv.x = lo.x; vv.y = lo.y; vv.z = hi.x; vv.w = hi.y;
                        bf16x8 vf = __builtin_bit_cast(bf16x8, vv);
#pragma unroll
                        for (int qt = 0; qt < 2; ++qt) oacc[qt][mt] = __builtin_amdgcn_mfma_f32_16x16x32_bf16(vf, pf[qt], oacc[qt][mt], 0, 0, 0);
                    }
                }
            }
            if (kb + 1 < nkb) A_COMMIT(smem + ((kb + 1) & 1) * A_BUF);
            __syncthreads();
        }
#pragma unroll
        for (int qt = 0; qt < 2; ++qt) {
            const float inv = 1.f / lrun[qt];
            bf16_t* op = p.ob + (tok0 + q0w + qt * 16 + fr) * 512 + h * 64 + fq * 4;
#pragma unroll
            for (int mt = 0; mt < 4; ++mt) {
                uint2 w;
                w.x = pack_bf16(oacc[qt][mt][0] * inv, oacc[qt][mt][1] * inv);
                w.y = pack_bf16(oacc[qt][mt][2] * inv, oacc[qt][mt][3] * inv);
                *reinterpret_cast<uint2*>(op + mt * 16) = w;
            }
        }
    }
}
__device__ __forceinline__ void ph_qlat(const P& p, int layer) {
    const int tid_ = opaque_v((int)threadIdx.x); const int bid_ = opaque_s((int)blockIdx.x); (void)tid_; (void)bid_;
    VB_LOOP(NS * 8) {
        int bs = vb / 8, h = vb % 8;
        int r = tid_;
        const float* qp = p.q + (size_t)(NPT + bs) * 768 + h * 96;
        const float* w = p.w_kvb + (size_t)layer * 256 * 1024 + (size_t)r * 1024 + h * 128;
        float s = 0.f;
        for (int d = 0; d < 64; ++d) s += qp[d] * w[d];
        p.qlat[((size_t)bs * 8 + h) * 256 + r] = s * ATT_SCALE;
    }
}
__device__ __forceinline__ void ph_mix(const P& p, int layer) {
    const int tid_ = opaque_v((int)threadIdx.x); const int bid_ = opaque_s((int)blockIdx.x); (void)tid_; (void)bid_;
    const size_t n = (size_t)NT * DM;
    for (size_t i = (size_t)bid_ * NTHR + tid_; i < n; i += (size_t)gridDim.x * NTHR) {
        int t = (int)(i / DM), c = (int)(i % DM);
        float ga = bf2f(p.gab[(size_t)t * 2048 + c]);
        float gb = bf2f(p.gab[(size_t)t * 2048 + 1024 + c]);
        p.mixb[i] = f2bf(ga * p.ya[i] + gb * p.yb[i]);
    }
}

__device__ __forceinline__ float dot2bf(unsigned a, unsigned b, float c) {
    return __builtin_amdgcn_fdot2_f32_bf16(__builtin_bit_cast(bf16x2_t, a), __builtin_bit_cast(bf16x2_t, b), c, false);
}
typedef __attribute__((ext_vector_type(2))) float f32x2;
__device__ __forceinline__ void ph_convert_fp8(const float* src, unsigned char* dst, float* inv, int rows, const float* cscale) {
    const int tid = opaque_v((int)threadIdx.x); const int bid = opaque_s((int)blockIdx.x);
    const int wid = tid >> 6, lane = tid & 63;
    for (int r = bid * 4 + wid; r < rows; r += (int)gridDim.x * 4) {
        const float4* sp = reinterpret_cast<const float4*>(src + (size_t)r * DM + lane * 16);
        float4 a = sp[0], b = sp[1], c = sp[2], d = sp[3];
        if (cscale) {
            const float4* cp = reinterpret_cast<const float4*>(cscale + (size_t)(r / NEXP) * DM + lane * 16);
            const float4 ca = cp[0], cb = cp[1], cc = cp[2], cd = cp[3];
            a.x *= ca.x; a.y *= ca.y; a.z *= ca.z; a.w *= ca.w; b.x *= cb.x; b.y *= cb.y; b.z *= cb.z; b.w *= cb.w;
            c.x *= cc.x; c.y *= cc.y; c.z *= cc.z; c.w *= cc.w; d.x *= cd.x; d.y *= cd.y; d.z *= cd.z; d.w *= cd.w;
        }
        float mx = fmaxf(fmaxf(fmaxf(fabsf(a.x), fabsf(a.y)), fmaxf(fabsf(a.z), fabsf(a.w))), fmaxf(fmaxf(fabsf(b.x), fabsf(b.y)), fmaxf(fabsf(b.z), fabsf(b.w))));
        mx = fmaxf(mx, fmaxf(fmaxf(fmaxf(fabsf(c.x), fabsf(c.y)), fmaxf(fabsf(c.z), fabsf(c.w))), fmaxf(fmaxf(fabsf(d.x), fabsf(d.y)), fmaxf(fabsf(d.z), fabsf(d.w)))));
        mx = fmaxf(wave_max(mx), 1e-30f);
        const float sc = 224.f / mx;
        uint4 o; int w;
        w = 0; w = __builtin_amdgcn_cvt_pk_fp8_f32(a.x * sc, a.y * sc, w, false); w = __builtin_amdgcn_cvt_pk_fp8_f32(a.z * sc, a.w * sc, w, true); o.x = (unsigned)w;
        w = 0; w = __builtin_amdgcn_cvt_pk_fp8_f32(b.x * sc, b.y * sc, w, false); w = __builtin_amdgcn_cvt_pk_fp8_f32(b.z * sc, b.w * sc, w, true); o.y = (unsigned)w;
        w = 0; w = __builtin_amdgcn_cvt_pk_fp8_f32(c.x * sc, c.y * sc, w, false); w = __builtin_amdgcn_cvt_pk_fp8_f32(c.z * sc, c.w * sc, w, true); o.z = (unsigned)w;
        w = 0; w = __builtin_amdgcn_cvt_pk_fp8_f32(d.x * sc, d.y * sc, w, false); w = __builtin_amdgcn_cvt_pk_fp8_f32(d.z * sc, d.w * sc, w, true); o.w = (unsigned)w;
        *reinterpret_cast<uint4*>(dst + (size_t)r * DM + lane * 16) = o;
        if (lane == 0) inv[r] = mx / 224.f;
    }
}
#define FP8_UNPACK16(v_, f_) do { \
    f32x2 t_; \
    t_ = __builtin_amdgcn_cvt_pk_f32_fp8((int)(v_).x, false); f_[0] = t_[0]; f_[1] = t_[1]; t_ = __builtin_amdgcn_cvt_pk_f32_fp8((int)(v_).x, true); f_[2] = t_[0]; f_[3] = t_[1]; \
    t_ = __builtin_amdgcn_cvt_pk_f32_fp8((int)(v_).y, false); f_[4] = t_[0]; f_[5] = t_[1]; t_ = __builtin_amdgcn_cvt_pk_f32_fp8((int)(v_).y, true); f_[6] = t_[0]; f_[7] = t_[1]; \
    t_ = __builtin_amdgcn_cvt_pk_f32_fp8((int)(v_).z, false); f_[8] = t_[0]; f_[9] = t_[1]; t_ = __builtin_amdgcn_cvt_pk_f32_fp8((int)(v_).z, true); f_[10] = t_[0]; f_[11] = t_[1]; \
    t_ = __builtin_amdgcn_cvt_pk_f32_fp8((int)(v_).w, false); f_[12] = t_[0]; f_[13] = t_[1]; t_ = __builtin_amdgcn_cvt_pk_f32_fp8((int)(v_).w, true); f_[14] = t_[0]; f_[15] = t_[1]; \
} while (0)
__device__ __forceinline__ void ph_peer_experts3(const P& p, int layer, bool dry = false) {
    const int tid = opaque_v((int)threadIdx.x); const int bid = opaque_s((int)blockIdx.x);
    const int wid = tid >> 6, lane = tid & 63;
    const unsigned char* U = p.u8 + (size_t)layer * NEXP * DM;
    const unsigned char* V = p.v8 + (size_t)layer * NEXP * DM;
    const float* IU = p.uinv + (size_t)layer * NEXP;
    const float* IV = p.vinv + (size_t)layer * NEXP;
    for (int t = bid * 4 + wid; t < NT; t += (int)gridDim.x * 4) {
        float hx[16];
        {
            const uint4* hrow = reinterpret_cast<const uint4*>(p.xb + (size_t)t * DM + lane * 16);
            const uint4 h0 = hrow[0], h1 = hrow[1];
            hx[0] = bflo(h0.x); hx[1] = bfhi(h0.x); hx[2] = bflo(h0.y); hx[3] = bfhi(h0.y); hx[4] = bflo(h0.z); hx[5] = bfhi(h0.z); hx[6] = bflo(h0.w); hx[7] = bfhi(h0.w);
            hx[8] = bflo(h1.x); hx[9] = bfhi(h1.x); hx[10] = bflo(h1.y); hx[11] = bfhi(h1.y); hx[12] = bflo(h1.z); hx[13] = bfhi(h1.z); hx[14] = bflo(h1.w); hx[15] = bfhi(h1.w);
        }
        const int i0 = p.idx[(size_t)t * 128 + lane], i1 = p.idx[(size_t)t * 128 + 64 + lane];
        const float g0 = p.gate[(size_t)t * 128 + lane], g1 = p.gate[(size_t)t * 128 + 64 + lane];
        const float rs1 = rsqrtf(p.sumsq1[(size_t)layer * TP + t] * (1.f / DM) + EPSF);
        const float su0 = IU[i0] * rs1, su1 = IU[i1] * rs1;
        float w0 = 0.f, w1 = 0.f;
        uint4 nx[4];
#pragma unroll
        for (int j = 0; j < 4; ++j) nx[j] = *reinterpret_cast<const uint4*>(U + (size_t)__builtin_amdgcn_readlane(i0, j) * DM + lane * 16);
#pragma unroll 1
        for (int kk = 0; kk < 128; kk += 4) {
            uint4 cu[4];
#pragma unroll
            for (int j = 0; j < 4; ++j) cu[j] = nx[j];
            if (kk + 4 < 128) {
                const int ivn = (kk + 4 < 64) ? i0 : i1;
#pragma unroll
                for (int j = 0; j < 4; ++j) nx[j] = *reinterpret_cast<const uint4*>(U + (size_t)__builtin_amdgcn_readlane(ivn, (kk + 4 + j) & 63) * DM + lane * 16);
            }
            float sd[4];
#pragma unroll
            for (int j = 0; j < 4; ++j) {
                float f[16];
                FP8_UNPACK16(cu[j], f);
                float a = 0.f;
#pragma unroll
                for (int i = 0; i < 16; ++i) a += f[i] * hx[i];
                sd[j] = a;
            }
#pragma unroll
            for (int o = 32; o > 0; o >>= 1) {
#pragma unroll
                for (int j = 0; j < 4; ++j) sd[j] += __shfl_xor(sd[j], o);
            }
#pragma unroll
            for (int j = 0; j < 4; ++j) {
                if (lane == ((kk + j) & 63)) {
                    const float x = sd[j] * ((kk < 64) ? su0 : su1);
                    const float act = 0.5f * x * (1.f + erff(x * 0.70710678118654752f));
                    if (kk < 64) w0 = g0 * act; else w1 = g1 * act;
                }
            }
        }
        w0 *= IV[i0]; w1 *= IV[i1];
        float acc[16];
#pragma unroll
        for (int i = 0; i < 16; ++i) acc[i] = 0.f;
#pragma unroll
        for (int j = 0; j < 4; ++j) nx[j] = *reinterpret_cast<const uint4*>(V + (size_t)__builtin_amdgcn_readlane(i0, j) * DM + lane * 16);
#pragma unroll 1
        for (int kk = 0; kk < 128; kk += 4) {
            uint4 cu[4];
#pragma unroll
            for (int j = 0; j < 4; ++j) cu[j] = nx[j];
            if (kk + 4 < 128) {
                const int ivn = (kk + 4 < 64) ? i0 : i1;
#pragma unroll
                for (int j = 0; j < 4; ++j) nx[j] = *reinterpret_cast<const uint4*>(V + (size_t)__builtin_amdgcn_readlane(ivn, (kk + 4 + j) & 63) * DM + lane * 16);
            }
            const float wv = (kk < 64) ? w0 : w1;
#pragma unroll
            for (int j = 0; j < 4; ++j) {
                const float w = __builtin_bit_cast(float, __builtin_amdgcn_readlane(__builtin_bit_cast(int, wv), (kk + j) & 63));
                float f[16];
                FP8_UNPACK16(cu[j], f);
#pragma unroll
                for (int i = 0; i < 16; ++i) acc[i] += w * f[i];
            }
        }
        float4* xp = reinterpret_cast<float4*>(p.xres + (size_t)t * DM + lane * 16);
        float4 xv[4]; float ss = 0.f;
#pragma unroll
        for (int q4 = 0; q4 < 4; ++q4) {
            float4 x = xp[q4];
            x.x += acc[q4 * 4 + 0]; x.y += acc[q4 * 4 + 1]; x.z += acc[q4 * 4 + 2]; x.w += acc[q4 * 4 + 3];
            xv[q4] = x; ss += x.x * x.x + x.y * x.y + x.z * x.z + x.w * x.w;
        }
        ss = wave_sum(ss);
        const float rs2 = rsqrtf(ss * (1.f / DM) + EPSF);
        if (dry) { if (rs2 == 123.456f) p.rstd[t] = rs2; }
        else if (layer + 1 < DEPTH) {
#pragma unroll
            for (int q4 = 0; q4 < 4; ++q4) xp[q4] = xv[q4];
            uint4 b0, b1;
            b0.x = pack_bf16(xv[0].x, xv[0].y); b0.y = pack_bf16(xv[0].z, xv[0].w); b0.z = pack_bf16(xv[1].x, xv[1].y); b0.w = pack_bf16(xv[1].z, xv[1].w);
            b1.x = pack_bf16(xv[2].x, xv[2].y); b1.y = pack_bf16(xv[2].z, xv[2].w); b1.z = pack_bf16(xv[3].x, xv[3].y); b1.w = pack_bf16(xv[3].z, xv[3].w);
            uint4* bp = reinterpret_cast<uint4*>(p.xb + (size_t)t * DM + lane * 16);
            bp[0] = b0; bp[1] = b1;
            if (lane == 0) p.rstd[t] = rs2;
        } else {
            const float4* np = reinterpret_cast<const float4*>(p.norm_final + lane * 16);
            float4* op = reinterpret_cast<float4*>(p.out + O_YP + (size_t)t * DM + lane * 16);
#pragma unroll
            for (int q4 = 0; q4 < 4; ++q4) {
                const float4 g = np[q4];
                float4 y; y.x = xv[q4].x * rs2 * g.x; y.y = xv[q4].y * rs2 * g.y; y.z = xv[q4].z * rs2 * g.z; y.w = xv[q4].w * rs2 * g.w;
                op[q4] = y;
            }
        }
    }
}

#define S_RS 272
#define S_XT 0
#define S_HL (64 * S_RS)
#define S_BT (2 * 64 * S_RS)
#define S_ACS (2 * 64 * S_RS + 128 * S_RS)
#define S_DTL (S_ACS + 512)
#define S_WL (S_DTL + 512)
__device__ __forceinline__ void ph_ssd_chunk(const P& p, int layer, char* smem) {
    const int tid = opaque_v((int)threadIdx.x); const int bid = opaque_s((int)blockIdx.x);
    const int wid = tid >> 6, lane = tid & 63, fr = lane & 15, fq = lane >> 4;
    float* acs = reinterpret_cast<float*>(smem + S_ACS);
    float* dtl = reinterpret_cast<float*>(smem + S_DTL);
    float* wl = reinterpret_cast<float*>(smem + S_WL);
    for (int u = bid; u < NB * 16; u += (int)gridDim.x) {
        const int b = u >> 4, e = u & 15, g = e >> 3;
        const float A = -__expf(p.a_log[layer * 16 + e]);
        const float Dk = p.d_skip[layer * 16 + e];
        f32x4 hT[2][4];
#pragma unroll
        for (int i = 0; i < 2; ++i)
#pragma unroll
            for (int pt = 0; pt < 4; ++pt) hT[i][pt] = f32x4{0.f, 0.f, 0.f, 0.f};
#pragma unroll 1
        for (int c = 0; c < 16; ++c) {
            const size_t t0 = (size_t)b * SEQ + c * 128;
            if (wid == 0) {
                const float d0 = p.dt[(t0 + lane) * 16 + e], d1 = p.dt[(t0 + 64 + lane) * 16 + e];
                float s0 = d0 * A, s1 = d1 * A;
#pragma unroll
                for (int o = 1; o < 64; o <<= 1) {
                    float t0s = __shfl_up(s0, o), t1s = __shfl_up(s1, o);
                    if (lane >= o) { s0 += t0s; s1 += t1s; }
                }
                s1 += __shfl(s0, 63);
                const float aend = __shfl(s1, 63);
                acs[lane] = s0; acs[64 + lane] = s1; dtl[lane] = d0; dtl[64 + lane] = d1;
                wl[lane] = d0 * __expf(aend - s0); wl[64 + lane] = d1 * __expf(aend - s1);
            }
#pragma unroll
            for (int i = 0; i < 4; ++i) {
                const int id = tid + 256 * i, l = id & 127, pc = id >> 7;
                const uint4 v = *reinterpret_cast<const uint4*>(p.xbcb + (t0 + l) * CONVD + e * 64 + pc * 8);
                bf16_t* dst = reinterpret_cast<bf16_t*>(smem + S_XT + (pc * 8) * S_RS + l * 2);
                dst[0 * (S_RS / 2)] = (bf16_t)(v.x & 0xffff); dst[1 * (S_RS / 2)] = (bf16_t)(v.x >> 16);
                dst[2 * (S_RS / 2)] = (bf16_t)(v.y & 0xffff); dst[3 * (S_RS / 2)] = (bf16_t)(v.y >> 16);
                dst[4 * (S_RS / 2)] = (bf16_t)(v.z & 0xffff); dst[5 * (S_RS / 2)] = (bf16_t)(v.z >> 16);
                dst[6 * (S_RS / 2)] = (bf16_t)(v.w & 0xffff); dst[7 * (S_RS / 2)] = (bf16_t)(v.w >> 16);
            }
#pragma unroll
            for (int i = 0; i < 8; ++i) {
                const int id = tid + 256 * i, l = id & 127, nc = id >> 7;
                const uint4 v = *reinterpret_cast<const uint4*>(p.xbcb + (t0 + l) * CONVD + 1024 + g * 128 + nc * 8);
                bf16_t* dst = reinterpret_cast<bf16_t*>(smem + S_BT + (nc * 8) * S_RS + l * 2);
                dst[0 * (S_RS / 2)] = (bf16_t)(v.x & 0xffff); dst[1 * (S_RS / 2)] = (bf16_t)(v.x >> 16);
                dst[2 * (S_RS / 2)] = (bf16_t)(v.y & 0xffff); dst[3 * (S_RS / 2)] = (bf16_t)(v.y >> 16);
                dst[4 * (S_RS / 2)] = (bf16_t)(v.z & 0xffff); dst[5 * (S_RS / 2)] = (bf16_t)(v.z >> 16);
                dst[6 * (S_RS / 2)] = (bf16_t)(v.w & 0xffff); dst[7 * (S_RS / 2)] = (bf16_t)(v.w >> 16);
            }
#pragma unroll
            for (int i = 0; i < 2; ++i)
#pragma unroll
                for (int pt = 0; pt < 4; ++pt) {
                    uint2 w2;
                    w2.x = pack_bf16(hT[i][pt][0], hT[i][pt][1]); w2.y = pack_bf16(hT[i][pt][2], hT[i][pt][3]);
                    *reinterpret_cast<uint2*>(smem + S_HL + (pt * 16 + fr) * S_RS + (wid * 32 + i * 16 + fq * 4) * 2) = w2;
                }
            __syncthreads();
            bf16x8 cf[2][4];
#pragma unroll
            for (int j = 0; j < 2; ++j)
#pragma unroll
                for (int k = 0; k < 4; ++k)
                    cf[j][k] = *reinterpret_cast<const bf16x8*>(p.xbcb + (t0 + wid * 32 + j * 16 + fr) * CONVD + 1280 + g * 128 + k * 32 + fq * 8);
            f32x4 acc[4][2];
#pragma unroll
            for (int pt = 0; pt < 4; ++pt)
#pragma unroll
                for (int j = 0; j < 2; ++j) acc[pt][j] = f32x4{0.f, 0.f, 0.f, 0.f};
#pragma unroll
            for (int pt = 0; pt < 4; ++pt)
#pragma unroll
                for (int k = 0; k < 4; ++k) {
                    const bf16x8 hf = *reinterpret_cast<const bf16x8*>(smem + S_HL + (pt * 16 + fr) * S_RS + (k * 32 + fq * 8) * 2);
#pragma unroll
                    for (int j = 0; j < 2; ++j) acc[pt][j] = __builtin_amdgcn_mfma_f32_16x16x32_bf16(hf, cf[j][k], acc[pt][j], 0, 0, 0);
                }
            float alv[2];
#pragma unroll
            for (int j = 0; j < 2; ++j) {
                alv[j] = acs[wid * 32 + j * 16 + fr];
                const float el = __expf(alv[j]);
#pragma unroll
                for (int pt = 0; pt < 4; ++pt) { acc[pt][j][0] *= el; acc[pt][j][1] *= el; acc[pt][j][2] *= el; acc[pt][j][3] *= el; }
            }
#pragma unroll 1
            for (int ii = 0; ii <= wid; ++ii) {
                f32x4 cb[2][2];
#pragma unroll
                for (int si = 0; si < 2; ++si)
#pragma unroll
                    for (int j = 0; j < 2; ++j) cb[si][j] = f32x4{0.f, 0.f, 0.f, 0.f};
#pragma unroll
                for (int k = 0; k < 4; ++k)
#pragma unroll
                    for (int si = 0; si < 2; ++si) {
                        const bf16x8 bfr = *reinterpret_cast<const bf16x8*>(p.xbcb + (t0 + ii * 32 + si * 16 + fr) * CONVD + 1024 + g * 128 + k * 32 + fq * 8);
#pragma unroll
                        for (int j = 0; j < 2; ++j) cb[si][j] = __builtin_amdgcn_mfma_f32_16x16x32_bf16(bfr, cf[j][k], cb[si][j], 0, 0, 0);
                    }
                bf16x8 mf[2];
                {
                    float as8[8], ds8[8];
#pragma unroll
                    for (int si = 0; si < 2; ++si) {
                        const float4 a4 = *reinterpret_cast<const float4*>(acs + ii * 32 + si * 16 + fq * 4);
                        const float4 d4 = *reinterpret_cast<const float4*>(dtl + ii * 32 + si * 16 + fq * 4);
                        as8[si * 4 + 0] = a4.x; as8[si * 4 + 1] = a4.y; as8[si * 4 + 2] = a4.z; as8[si * 4 + 3] = a4.w;
                        ds8[si * 4 + 0] = d4.x; ds8[si * 4 + 1] = d4.y; ds8[si * 4 + 2] = d4.z; ds8[si * 4 + 3] = d4.w;
                    }
#pragma unroll
                    for (int j = 0; j < 2; ++j) {
                        const int lidx = wid * 32 + j * 16 + fr;
                        float mv[8];
#pragma unroll
                        for (int si = 0; si < 2; ++si)
#pragma unroll
                            for (int r = 0; r < 4; ++r) {
                                const int sidx = ii * 32 + si * 16 + fq * 4 + r;
                                const float dec = __expf(fminf(alv[j] - as8[si * 4 + r], 0.f)) * ds8[si * 4 + r];
                                mv[si * 4 + r] = (lidx >= sidx) ? cb[si][j][r] * dec : 0.f;
                            }
                        uint4 pk;
                        pk.x = pack_bf16(mv[0], mv[1]); pk.y = pack_bf16(mv[2], mv[3]); pk.z = pack_bf16(mv[4], mv[5]); pk.w = pack_bf16(mv[6], mv[7]);
                        mf[j] = __builtin_bit_cast(bf16x8, pk);
                    }
                }
#pragma unroll
                for (int pt = 0; pt < 4; ++pt) {
                    const char* xp = smem + S_XT + (pt * 16 + fr) * S_RS + (ii * 32 + fq * 4) * 2;
                    const uint2 lo = *reinterpret_cast<const uint2*>(xp);
                    const uint2 hi = *reinterpret_cast<const uint2*>(xp + 32);
                    uint4 xv; xv.x = lo.x; xv.y = lo.y; xv.z = hi.x; xv.w = hi.y;
                    const bf16x8 xf = __builtin_bit_cast(bf16x8, xv);
#pragma unroll
                    for (int j = 0; j < 2; ++j) acc[pt][j] = __builtin_amdgcn_mfma_f32_16x16x32_bf16(xf, mf[j], acc[pt][j], 0, 0, 0);
                }
            }
#pragma unroll
            for (int j = 0; j < 2; ++j) {
                const size_t tl = t0 + wid * 32 + j * 16 + fr;
#pragma unroll
                for (int pt = 0; pt < 4; ++pt) {
                    const uint2 xx = *reinterpret_cast<const uint2*>(p.xbcb + tl * CONVD + e * 64 + pt * 16 + fq * 4);
                    float4 y;
                    y.x = acc[pt][j][0] + Dk * bflo(xx.x); y.y = acc[pt][j][1] + Dk * bfhi(xx.x);
                    y.z = acc[pt][j][2] + Dk * bflo(xx.y); y.w = acc[pt][j][3] + Dk * bfhi(xx.y);
                    *reinterpret_cast<float4*>(p.yraw + tl * DM + e * 64 + pt * 16 + fq * 4) = y;
                }
            }
            {
                const float dec = __expf(acs[127]);
#pragma unroll
                for (int i = 0; i < 2; ++i)
#pragma unroll
                    for (int pt = 0; pt < 4; ++pt) { hT[i][pt][0] *= dec; hT[i][pt][1] *= dec; hT[i][pt][2] *= dec; hT[i][pt][3] *= dec; }
            }
#pragma unroll
            for (int k = 0; k < 4; ++k) {
                const float4 w0 = *reinterpret_cast<const float4*>(wl + k * 32 + fq * 8);
                const float4 w1 = *reinterpret_cast<const float4*>(wl + k * 32 + fq * 8 + 4);
                bf16x8 bt[2];
#pragma unroll
                for (int i = 0; i < 2; ++i) bt[i] = *reinterpret_cast<const bf16x8*>(smem + S_BT + (wid * 32 + i * 16 + fr) * S_RS + (k * 32 + fq * 8) * 2);
#pragma unroll
                for (int pt = 0; pt < 4; ++pt) {
                    const uint4 xr = *reinterpret_cast<const uint4*>(smem + S_XT + (pt * 16 + fr) * S_RS + (k * 32 + fq * 8) * 2);
                    uint4 xs;
                    xs.x = pack_bf16(bflo(xr.x) * w0.x, bfhi(xr.x) * w0.y); xs.y = pack_bf16(bflo(xr.y) * w0.z, bfhi(xr.y) * w0.w);
                    xs.z = pack_bf16(bflo(xr.z) * w1.x, bfhi(xr.z) * w1.y); xs.w = pack_bf16(bflo(xr.w) * w1.z, bfhi(xr.w) * w1.w);
                    const bf16x8 xsf = __builtin_bit_cast(bf16x8, xs);
#pragma unroll
                    for (int i = 0; i < 2; ++i) hT[i][pt] = __builtin_amdgcn_mfma_f32_16x16x32_bf16(bt[i], xsf, hT[i][pt], 0, 0, 0);
                }
            }
            __syncthreads();
        }
#pragma unroll
        for (int i = 0; i < 2; ++i)
#pragma unroll
            for (int pt = 0; pt < 4; ++pt) {
                float4 hv; hv.x = hT[i][pt][0]; hv.y = hT[i][pt][1]; hv.z = hT[i][pt][2]; hv.w = hT[i][pt][3];
                *reinterpret_cast<float4*>(p.out + O_SSMP + (((size_t)(layer * NB + b) * 16 + e) * 64 + pt * 16 + fr) * 128 + wid * 32 + i * 16 + fq * 4) = hv;
            }
    }
}


__device__ __forceinline__ int med3i(int a, int b, int c) { return max(min(a, b), min(max(a, b), c)); }
__device__ __forceinline__ int okey(float v) { int o = __float_as_int(v); return o ^ ((o >> 31) & 0x7fffffff); }
__device__ __forceinline__ float okey_inv(int o) { return __int_as_float(o ^ ((o >> 31) & 0x7fffffff)); }
#define TK_INSERT(L_, key_) do { const int k_ = (key_); \
    L_[15] = med3i(L_[14], L_[15], k_); L_[14] = med3i(L_[13], L_[14], k_); L_[13] = med3i(L_[12], L_[13], k_); L_[12] = med3i(L_[11], L_[12], k_); \
    L_[11] = med3i(L_[10], L_[11], k_); L_[10] = med3i(L_[9], L_[10], k_); L_[9] = med3i(L_[8], L_[9], k_); L_[8] = med3i(L_[7], L_[8], k_); \
    L_[7] = med3i(L_[6], L_[7], k_); L_[6] = med3i(L_[5], L_[6], k_); L_[5] = med3i(L_[4], L_[5], k_); L_[4] = med3i(L_[3], L_[4], k_); \
    L_[3] = med3i(L_[2], L_[3], k_); L_[2] = med3i(L_[1], L_[2], k_); L_[1] = med3i(L_[0], L_[1], k_); L_[0] = max(L_[0], k_); } while (0)
#define TK_INS2(a_, b_) do { const float sv_ = V1[a_] + V2[b_]; TK_INSERT(M, (okey(sv_) & ~255) | (255 - ((a_) * 16 + (b_)))); } while (0)
__device__ __forceinline__ void ph_peer_topk2(const P& p) {
    const int tid = opaque_v((int)threadIdx.x); const int bid = opaque_s((int)blockIdx.x);
    for (int pr = bid * NTHR + tid; pr < NT * 8; pr += (int)gridDim.x * NTHR) {
        const int t = pr >> 3, h = pr & 7;
        int L1[16], L2[16], M[16];
#pragma unroll
        for (int i = 0; i < 16; ++i) { L1[i] = (int)0x80000000; L2[i] = (int)0x80000000; M[i] = (int)0x80000000; }
        const float4* sp = reinterpret_cast<const float4*>(p.sc + (size_t)t * 2048 + h * 256);
#pragma unroll 2
        for (int k4 = 0; k4 < 32; ++k4) {
            const float4 v = sp[k4];
            const int kb = 127 - k4 * 4;
            TK_INSERT(L1, (okey(v.x) & ~127) | (kb - 0));
            TK_INSERT(L1, (okey(v.y) & ~127) | (kb - 1));
            TK_INSERT(L1, (okey(v.z) & ~127) | (kb - 2));
            TK_INSERT(L1, (okey(v.w) & ~127) | (kb - 3));
        }
#pragma unroll 2
        for (int k4 = 0; k4 < 32; ++k4) {
            const float4 v = sp[32 + k4];
            const int kb = 127 - k4 * 4;
            TK_INSERT(L2, (okey(v.x) & ~127) | (kb - 0));
            TK_INSERT(L2, (okey(v.y) & ~127) | (kb - 1));
            TK_INSERT(L2, (okey(v.z) & ~127) | (kb - 2));
            TK_INSERT(L2, (okey(v.w) & ~127) | (kb - 3));
        }
        float V1[16], V2[16];
#pragma unroll
        for (int i = 0; i < 16; ++i) { V1[i] = okey_inv(L1[i] & ~127); V2[i] = okey_inv(L2[i] & ~127); }
        TK_INS2(0, 0);
        TK_INS2(0, 1);
        TK_INS2(0, 2);
        TK_INS2(0, 3);
        TK_INS2(0, 4);
        TK_INS2(0, 5);
        TK_INS2(0, 6);
        TK_INS2(0, 7);
        TK_INS2(0, 8);
        TK_INS2(0, 9);
        TK_INS2(0, 10);
        TK_INS2(0, 11);
        TK_INS2(0, 12);
        TK_INS2(0, 13);
        TK_INS2(0, 14);
        TK_INS2(0, 15);
        TK_INS2(1, 0);
        TK_INS2(1, 1);
        TK_INS2(1, 2);
        TK_INS2(1, 3);
        TK_INS2(1, 4);
        TK_INS2(1, 5);
        TK_INS2(1, 6);
        TK_INS2(1, 7);
        TK_INS2(2, 0);
        TK_INS2(2, 1);
        TK_INS2(2, 2);
        TK_INS2(2, 3);
        TK_INS2(2, 4);
        TK_INS2(3, 0);
        TK_INS2(3, 1);
        TK_INS2(3, 2);
        TK_INS2(3, 3);
        TK_INS2(4, 0);
        TK_INS2(4, 1);
        TK_INS2(4, 2);
        TK_INS2(5, 0);
        TK_INS2(5, 1);
        TK_INS2(6, 0);
        TK_INS2(6, 1);
        TK_INS2(7, 0);
        TK_INS2(7, 1);
        TK_INS2(8, 0);
        TK_INS2(9, 0);
        TK_INS2(10, 0);
        TK_INS2(11, 0);
        TK_INS2(12, 0);
        TK_INS2(13, 0);
        TK_INS2(14, 0);
        TK_INS2(15, 0);
        float sv[16];
        int ex[16];
#pragma unroll
        for (int j = 0; j < 16; ++j) {
            const int c = 255 - (M[j] & 255);
            const int a = c >> 4, b = c & 15;
            int ka = L1[0], kb2 = L2[0];
            float va = V1[0], vb = V2[0];
#pragma unroll
            for (int i = 1; i < 16; ++i) {
                if (a == i) { ka = L1[i]; va = V1[i]; }
                if (b == i) { kb2 = L2[i]; vb = V2[i]; }
            }
            sv[j] = va + vb;
            ex[j] = (127 - (ka & 127)) * 128 + (127 - (kb2 & 127));
        }
        float sum = 0.f;
        float ev[16];
#pragma unroll
        for (int j = 0; j < 16; ++j) { ev[j] = __expf(sv[j] - sv[0]); sum += ev[j]; }
        const float inv = 1.f / sum;
        int* ip = p.idx + (size_t)t * 128 + h * 16;
        float* gp = p.gate + (size_t)t * 128 + h * 16;
#pragma unroll
        for (int j4 = 0; j4 < 4; ++j4) {
            *reinterpret_cast<int4*>(ip + j4 * 4) = make_int4(ex[j4 * 4], ex[j4 * 4 + 1], ex[j4 * 4 + 2], ex[j4 * 4 + 3]);
            *reinterpret_cast<float4*>(gp + j4 * 4) = make_float4(ev[j4 * 4] * inv, ev[j4 * 4 + 1] * inv, ev[j4 * 4 + 2] * inv, ev[j4 * 4 + 3] * inv);
        }
    }
}


#define D_RS 544
#define D_NCH 16
typedef __attribute__((ext_vector_type(4))) short s16x4;
__device__ __forceinline__ uint4 pack8(const float4 a, const float4 b, float sc) {
    uint4 r; r.x = pack_bf16(a.x * sc, a.y * sc); r.y = pack_bf16(a.z * sc, a.w * sc); r.z = pack_bf16(b.x * sc, b.y * sc); r.w = pack_bf16(b.z * sc, b.w * sc); return r;
}
__device__ __forceinline__ void ph_decode2(const P& p, int layer, char* smem) {
    const int tid = opaque_v((int)threadIdx.x); const int bid = opaque_s((int)blockIdx.x);
    const int wid = tid >> 6, lane = tid & 63, fr = lane & 15, fq = lane >> 4;
    char* vbuf = smem + wid * (16 * D_RS);
    const float L2E = 1.4426950408889634f;
    for (int u = bid; u < NS * D_NCH; u += (int)gridDim.x) {
        const int bs = u / D_NCH, ch = u % D_NCH;
        char* qls = smem + 4 * 16 * D_RS;
        {
            const int hh = fr & 7;
            const float zf = (fr < 8) ? 1.f : 0.f;
            const float* ql = p.qlat + ((size_t)bs * 8 + hh) * 256 + fq * 8;
            const float* qr = p.q + (size_t)(NPT + bs) * 768 + hh * 96 + 64 + fq * 8;
#pragma unroll
            for (int j = 0; j < 3; ++j) {
                const int s9 = wid + 4 * j;
                if (s9 < 8) {
                    const float4 a = *reinterpret_cast<const float4*>(ql + s9 * 32), b = *reinterpret_cast<const float4*>(ql + s9 * 32 + 4);
                    *reinterpret_cast<uint4*>(qls + (s9 * 64 + lane) * 16) = pack8(a, b, L2E * zf);
                } else if (s9 == 8) {
                    const float4 a = *reinterpret_cast<const float4*>(qr), b = *reinterpret_cast<const float4*>(qr + 4);
                    *reinterpret_cast<uint4*>(qls + (s9 * 64 + lane) * 16) = pack8(a, b, ATT_SCALE * L2E * zf);
                }
            }
        }
        __syncthreads();
        f32x4 oacc[16];
#pragma unroll
        for (int dt = 0; dt < 16; ++dt) oacc[dt] = f32x4{0.f, 0.f, 0.f, 0.f};
        float mrun = -INFINITY, lrun = 0.f;
        float4 raw[18];
#define D_ISSUE(ti_) do { const int ti = (ti_); const int pg = p.page_table[bs * NPAGES + ch * 8 + (ti >> 3)]; \
            const size_t krow = ((size_t)layer * NPOOL + pg) * PAGE + (ti & 7) * 16 + fr; \
            const float* lp = p.cache_lat + krow * KVL + fq * 8; const float* rp = p.cache_kr + krow * 32 + fq * 8; \
            _Pragma("unroll") for (int s9 = 0; s9 < 8; ++s9) { raw[2 * s9] = *reinterpret_cast<const float4*>(lp + s9 * 32); raw[2 * s9 + 1] = *reinterpret_cast<const float4*>(lp + s9 * 32 + 4); } \
            raw[16] = *reinterpret_cast<const float4*>(rp); raw[17] = *reinterpret_cast<const float4*>(rp + 4); } while (0)
#pragma unroll 1
        for (int it = 0; it < 16; ++it) {
            D_ISSUE(wid + 4 * it);
            bf16x8 kf[9];
#pragma unroll
            for (int s9 = 0; s9 < 9; ++s9) kf[s9] = __builtin_bit_cast(bf16x8, pack8(raw[2 * s9], raw[2 * s9 + 1], 1.f));
            f32x4 st = f32x4{0.f, 0.f, 0.f, 0.f};
#pragma unroll
            for (int s9 = 0; s9 < 9; ++s9) st = __builtin_amdgcn_mfma_f32_16x16x32_bf16(kf[s9], *reinterpret_cast<const bf16x8*>(qls + (s9 * 64 + lane) * 16), st, 0, 0, 0);
#pragma unroll
            for (int s9 = 0; s9 < 8; ++s9) *reinterpret_cast<bf16x8*>(vbuf + fr * D_RS + (s9 * 32 + fq * 8) * 2) = kf[s9];
            float mx = fmaxf(fmaxf(st[0], st[1]), fmaxf(st[2], st[3]));
            mx = fmaxf(mx, __shfl_xor(mx, 16));
            mx = fmaxf(mx, __shfl_xor(mx, 32));
            const float mnew = fmaxf(mrun, mx);
            const float corr = __builtin_amdgcn_exp2f(mrun - mnew);
            const float p0 = __builtin_amdgcn_exp2f(st[0] - mnew), p1 = __builtin_amdgcn_exp2f(st[1] - mnew);
            const float p2 = __builtin_amdgcn_exp2f(st[2] - mnew), p3 = __builtin_amdgcn_exp2f(st[3] - mnew);
            float rs = (p0 + p1) + (p2 + p3);
            rs += __shfl_xor(rs, 16);
            rs += __shfl_xor(rs, 32);
            lrun = lrun * corr + rs;
            mrun = mnew;
#pragma unroll
            for (int dt = 0; dt < 16; ++dt) { oacc[dt][0] *= corr; oacc[dt][1] *= corr; oacc[dt][2] *= corr; oacc[dt][3] *= corr; }
            uint4 pk; pk.x = pack_bf16(p0, p1); pk.y = pack_bf16(p2, p3); pk.z = 0u; pk.w = 0u;
            const bf16x8 pf = __builtin_bit_cast(bf16x8, pk);
            const char* tb = vbuf + (fq * 4 + (fr >> 2)) * D_RS + (fr & 3) * 8;
#pragma unroll
            for (int dt = 0; dt < 16; ++dt) {
                const s16x4 lo = __builtin_amdgcn_ds_read_tr16_b64_v4i16((__attribute__((address_space(3))) s16x4*)(tb + dt * 32));
                bf16x8 vf; vf[0] = lo[0]; vf[1] = lo[1]; vf[2] = lo[2]; vf[3] = lo[3]; vf[4] = 0; vf[5] = 0; vf[6] = 0; vf[7] = 0;
                oacc[dt] = __builtin_amdgcn_mfma_f32_16x16x32_bf16(vf, pf, oacc[dt], 0, 0, 0);
            }
        }
        __syncthreads();
        float* wm = reinterpret_cast<float*>(smem + 65536);
        float* wl = wm + 64;
        float* ob = reinterpret_cast<float*>(smem);
        if (fq == 0) { wm[wid * 16 + fr] = mrun; wl[wid * 16 + fr] = lrun; }
        if (fr < 8) {
#pragma unroll
            for (int dt = 0; dt < 16; ++dt) {
                float4 v; v.x = oacc[dt][0]; v.y = oacc[dt][1]; v.z = oacc[dt][2]; v.w = oacc[dt][3];
                *reinterpret_cast<float4*>(ob + ((size_t)wid * 8 + fr) * 256 + dt * 16 + fq * 4) = v;
            }
        }
        __syncthreads();
        {
            float* pp = p.part + ((size_t)bs * D_NCH + ch) * 8 * 258;
#pragma unroll
            for (int h = 0; h < 8; ++h) {
                const float m0 = wm[h], m1 = wm[16 + h], m2 = wm[32 + h], m3 = wm[48 + h];
                const float M = fmaxf(fmaxf(m0, m1), fmaxf(m2, m3));
                const float e0 = __builtin_amdgcn_exp2f(m0 - M), e1 = __builtin_amdgcn_exp2f(m1 - M), e2 = __builtin_amdgcn_exp2f(m2 - M), e3 = __builtin_amdgcn_exp2f(m3 - M);
                const float a = ob[(0 * 8 + h) * 256 + tid] * e0 + ob[(1 * 8 + h) * 256 + tid] * e1 + ob[(2 * 8 + h) * 256 + tid] * e2 + ob[(3 * 8 + h) * 256 + tid] * e3;
                pp[h * 258 + 2 + tid] = a;
                if (tid == 0) { pp[h * 258] = M; pp[h * 258 + 1] = wl[h] * e0 + wl[16 + h] * e1 + wl[32 + h] * e2 + wl[48 + h] * e3; }
            }
        }
        __syncthreads();
    }
}
__device__ __forceinline__ void ph_decode_comb2(const P& p, int layer, char* smem) {
    const int tid_ = opaque_v((int)threadIdx.x); const int bid_ = opaque_s((int)blockIdx.x);
    float* sw = (float*)smem;
    float* so = sw + 20;
    float* sLp = so + 256;
    VB_LOOP(NS * 8) {
        int bs = vb / 8, h = vb % 8, tid = tid_;
        const float* pb = p.part + (size_t)bs * D_NCH * 8 * 258 + h * 258;
        const float* latn = p.lat + (size_t)(NPT + bs) * KVL;
        if (tid < 64) {
            const float4 q4 = *reinterpret_cast<const float4*>(p.qlat + ((size_t)bs * 8 + h) * 256 + tid * 4);
            const float4 l4 = *reinterpret_cast<const float4*>(latn + tid * 4);
            float sn = q4.x * l4.x + q4.y * l4.y + q4.z * l4.z + q4.w * l4.w;
            if (tid < 32) sn += p.q[(size_t)(NPT + bs) * 768 + h * 96 + 64 + tid] * ATT_SCALE * p.kpe[(size_t)(NPT + bs) * 32 + tid];
            sn = wave_sum(sn) * 1.4426950408889634f;
            float m = sn;
            if (tid < D_NCH) m = fmaxf(m, pb[(size_t)tid * 8 * 258]);
            m = wave_max(m);
            float l = 0.f;
            if (tid < D_NCH) {
                float w = __builtin_amdgcn_exp2f(pb[(size_t)tid * 8 * 258] - m);
                sw[tid] = w;
                l = w * pb[(size_t)tid * 8 * 258 + 1];
            }
            const float wn = __builtin_amdgcn_exp2f(sn - m);
            if (tid == 0) { sw[D_NCH] = wn; l += wn; }
            l = wave_sum(l);
            if (tid == 0) sLp[0] = l;
        }
        __syncthreads();
        float a = sw[D_NCH] * latn[tid];
        for (int c = 0; c < D_NCH; ++c) a += sw[c] * pb[(size_t)c * 8 * 258 + 2 + tid];
        so[tid] = a / sLp[0];
        __syncthreads();
        if (tid < 64) {
            const float* w = p.w_kvb + (size_t)layer * 256 * 1024 + h * 128 + 64 + tid;
            float sacc = 0.f;
            for (int r = 0; r < 256; ++r) sacc += so[r] * w[(size_t)r * 1024];
            p.ob[(size_t)(NPT + bs) * 512 + h * 64 + tid] = f2bf(sacc);
        }
        __syncthreads();
    }
}


struct EpiInProj {
    bf16_t *gab, *zs, *xbr; float *dt, *cq, *ckv, *kr, *out;
    const float *b_gate, *dt_bias, *rstd; int layer;
    __device__ __forceinline__ void row4(int m, int n, float a0, float a1, float a2, float a3) const {
        const float rs = rstd[m];
        const float v0 = a0 * rs, v1 = a1 * rs, v2 = a2 * rs, v3 = a3 * rs;
        if (n < 2048) {
            const float4 b4 = *reinterpret_cast<const float4*>(b_gate + layer * 2048 + n);
            *reinterpret_cast<uint2*>(gab + (size_t)m * 2048 + n) = pack4(sigmoid_f(v0 + b4.x), sigmoid_f(v1 + b4.y), sigmoid_f(v2 + b4.z), sigmoid_f(v3 + b4.w));
        } else if (n < 3072) {
            *reinterpret_cast<uint2*>(zs + (size_t)m * DM + (n - 2048)) = pack4(silu_f(v0), silu_f(v1), silu_f(v2), silu_f(v3));
        } else if (n < 4608) {
            const int c = n - 3072;
            *reinterpret_cast<uint2*>(xbr + (size_t)m * CONVD + c) = pack4(v0, v1, v2, v3);
            if (m < NPT) { const int l = m & (SEQ - 1); if (l >= SEQ - 3) *reinterpret_cast<float4*>(out + O_CONVP + ((size_t)(layer * NB + (m >> 11)) * 3 + (l - (SEQ - 3))) * CONVD + c) = make_float4(v0, v1, v2, v3); }
            else if (m < NT) *reinterpret_cast<float4*>(out + O_CONVS + ((size_t)(layer * NS + (m - NPT)) * 3 + 2) * CONVD + c) = make_float4(v0, v1, v2, v3);
        } else if (n < 4624) {
            const float4 b4 = *reinterpret_cast<const float4*>(dt_bias + layer * 16 + (n - 4608));
            const float x0 = v0 + b4.x, x1 = v1 + b4.y, x2 = v2 + b4.z, x3 = v3 + b4.w;
            *reinterpret_cast<float4*>(dt + (size_t)m * 16 + (n - 4608)) = make_float4((x0 > 20.f) ? x0 : log1pf(__expf(x0)), (x1 > 20.f) ? x1 : log1pf(__expf(x1)),
                                                                                       (x2 > 20.f) ? x2 : log1pf(__expf(x2)), (x3 > 20.f) ? x3 : log1pf(__expf(x3)));
        } else if (n < 5008) { *reinterpret_cast<float4*>(cq + (size_t)m * QL + (n - 4624)) = make_float4(v0, v1, v2, v3); }
        else if (n < 5264) { *reinterpret_cast<float4*>(ckv + (size_t)m * KVL + (n - 5008)) = make_float4(v0, v1, v2, v3); }
        else if (n < 5296) { *reinterpret_cast<float4*>(kr + (size_t)m * 32 + (n - 5264)) = make_float4(v0, v1, v2, v3); }
    } EPI_ROWS };
__device__ __forceinline__ void ph_conv2(const P& p, int layer) {
    const int tid_ = opaque_v((int)threadIdx.x); const int bid_ = opaque_s((int)blockIdx.x);
    const int total = NT * (CONVD / 8);
    const float* cw = p.conv_w + (size_t)layer * 4 * CONVD;
    for (int i = bid_ * NTHR + tid_; i < total; i += (int)gridDim.x * NTHR) {
        const int t = i / (CONVD / 8), c0 = (i % (CONVD / 8)) * 8;
        float acc[8];
        {
            const float4 b0 = *reinterpret_cast<const float4*>(p.conv_b + layer * CONVD + c0), b1 = *reinterpret_cast<const float4*>(p.conv_b + layer * CONVD + c0 + 4);
            acc[0] = b0.x; acc[1] = b0.y; acc[2] = b0.z; acc[3] = b0.w; acc[4] = b1.x; acc[5] = b1.y; acc[6] = b1.z; acc[7] = b1.w;
        }
#pragma unroll
        for (int k = 0; k < 4; ++k) {
            float xv[8];
            bool have = true;
            if (t < NPT) {
                const int l = t & (SEQ - 1);
                if (l + k - 3 >= 0) {
                    const uint4 r = *reinterpret_cast<const uint4*>(p.xbr + (size_t)(t + k - 3) * CONVD + c0);
                    xv[0] = bflo(r.x); xv[1] = bfhi(r.x); xv[2] = bflo(r.y); xv[3] = bfhi(r.y); xv[4] = bflo(r.z); xv[5] = bfhi(r.z); xv[6] = bflo(r.w); xv[7] = bfhi(r.w);
                } else have = false;
            } else {
                if (k == 3) {
                    const uint4 r = *reinterpret_cast<const uint4*>(p.xbr + (size_t)t * CONVD + c0);
                    xv[0] = bflo(r.x); xv[1] = bfhi(r.x); xv[2] = bflo(r.y); xv[3] = bfhi(r.y); xv[4] = bflo(r.z); xv[5] = bfhi(r.z); xv[6] = bflo(r.w); xv[7] = bfhi(r.w);
                } else {
                    const float* pv = p.state_conv + ((size_t)(layer * NS + (t - NPT)) * 3 + k) * CONVD + c0;
                    const float4 a = *reinterpret_cast<const float4*>(pv), b = *reinterpret_cast<const float4*>(pv + 4);
                    xv[0] = a.x; xv[1] = a.y; xv[2] = a.z; xv[3] = a.w; xv[4] = b.x; xv[5] = b.y; xv[6] = b.z; xv[7] = b.w;
                    if (k >= 1) {
                        float* oc = p.out + O_CONVS + ((size_t)(layer * NS + (t - NPT)) * 3 + (k - 1)) * CONVD + c0;
                        *reinterpret_cast<float4*>(oc) = a; *reinterpret_cast<float4*>(oc + 4) = b;
                    }
                }
            }
            if (have) {
                const float4 w0 = *reinterpret_cast<const float4*>(cw + k * CONVD + c0), w1 = *reinterpret_cast<const float4*>(cw + k * CONVD + c0 + 4);
                acc[0] += xv[0] * w0.x; acc[1] += xv[1] * w0.y; acc[2] += xv[2] * w0.z; acc[3] += xv[3] * w0.w;
                acc[4] += xv[4] * w1.x; acc[5] += xv[5] * w1.y; acc[6] += xv[6] * w1.z; acc[7] += xv[7] * w1.w;
            }
        }
        uint4 o;
        o.x = pack_bf16(silu_f(acc[0]), silu_f(acc[1])); o.y = pack_bf16(silu_f(acc[2]), silu_f(acc[3]));
        o.z = pack_bf16(silu_f(acc[4]), silu_f(acc[5])); o.w = pack_bf16(silu_f(acc[6]), silu_f(acc[7]));
        *reinterpret_cast<uint4*>(p.xbcb + (size_t)t * CONVD + c0) = o;
    }
}

#if PROBE_BAR
#define BAR() do { xcd_barrier(bar); xcd_barrier(bar); } while (0)
#else
#define BAR() xcd_barrier(bar)
#endif
#define NPAD_IN 5376

__global__ void __launch_bounds__(256, 2) k_fwd(P p) {
    __shared__ uint4 xb_words;
    __shared__ __attribute__((aligned(16))) char smem[73728];
    if (threadIdx.x == 0) xb_words = make_uint4(0u, 0u, 0u, 0u);
    __syncthreads();
    XcdBarrier bar = xcd_barrier_post(p.bar, (volatile LAS unsigned*)&xb_words);

    ph_rope_table(p);
    ph_copy_x(p);
#pragma unroll 1
    for (int l = 0; l < DEPTH; ++l) {
        ph_convert_w(p.w_in + (size_t)l * DM * DIN, DM, DIN, NPAD_IN, p.wt_in + (size_t)l * NPAD_IN * DM, smem, p.norm_mix + l * DM);
        ph_convert_w(p.w_ssm_proj + (size_t)l * DM * DM, DM, DM, DM, p.wt_ssm + (size_t)l * DM * DM, smem);
        ph_convert_w(p.w_qb + (size_t)l * QL * 768, QL, 768, 768, p.wt_qb + (size_t)l * 768 * QL, smem);
        ph_convert_w(p.w_kvb + (size_t)l * KVL * 1024, KVL, 1024, 1024, p.wt_kvb + (size_t)l * 1024 * KVL, smem);
        ph_convert_w(p.w_mla_proj + (size_t)l * 512 * DM, 512, DM, DM, p.wt_mla + (size_t)l * DM * 512, smem);
        ph_convert_w(p.w_out + (size_t)l * DM * DM, DM, DM, DM, p.wt_out + (size_t)l * DM * DM, smem);
    }
    ph_convert_plain(p.peer_wq, p.wqb, (size_t)DEPTH * DM * 2048);
    ph_convert_plain(p.peer_keys, p.keysb, (size_t)DEPTH * 16 * 128 * 128);
#if PROBE_PRO2
#pragma unroll 1
    for (int l = 0; l < DEPTH; ++l) {
        ph_convert_w(p.w_in + (size_t)l * DM * DIN, DM, DIN, NPAD_IN, p.wt_in + (size_t)l * NPAD_IN * DM, smem, p.norm_mix + l * DM);
        ph_convert_w(p.w_ssm_proj + (size_t)l * DM * DM, DM, DM, DM, p.wt_ssm + (size_t)l * DM * DM, smem);
        ph_convert_w(p.w_qb + (size_t)l * QL * 768, QL, 768, 768, p.wt_qb + (size_t)l * 768 * QL, smem);
        ph_convert_w(p.w_kvb + (size_t)l * KVL * 1024, KVL, 1024, 1024, p.wt_kvb + (size_t)l * 1024 * KVL, smem);
        ph_convert_w(p.w_mla_proj + (size_t)l * 512 * DM, 512, DM, DM, p.wt_mla + (size_t)l * DM * 512, smem);
        ph_convert_w(p.w_out + (size_t)l * DM * DM, DM, DM, DM, p.wt_out + (size_t)l * DM * DM, smem);
    }
    ph_convert_plain(p.peer_wq, p.wqb, (size_t)DEPTH * DM * 2048);
    ph_copy_x(p);
#endif
    ph_convert_fp8(p.peer_u, p.u8, p.uinv, DEPTH * NEXP, p.norm_ffn);
    ph_convert_fp8(p.peer_v, p.v8, p.vinv, DEPTH * NEXP, nullptr);
#if PROBE_PRO
    ph_convert_fp8(p.peer_u, p.u8, p.uinv, DEPTH * NEXP, p.norm_ffn);
    ph_convert_fp8(p.peer_v, p.v8, p.vinv, DEPTH * NEXP, nullptr);
#endif
    BAR();
#pragma unroll 1
    for (int c = 0; c < DEPTH * 16; ++c) {
        const int l = c >> 4, hh = c & 15;
        gemm_bf16(p.keysb + (size_t)c * 128 * 128, 128, p.wqb + (size_t)l * DM * 2048 + hh * 128, 2048, 1, 8, 128, smem,
                  EpiStoreBfCol{p.wt_pq + (size_t)l * 2048 * DM + (size_t)hh * 128 * DM, DM, p.norm_ffn + l * DM}, (c & 7) + (c >> 3) * 64);
    }
#if PROBE_WEFF
#pragma unroll 1
    for (int c = 0; c < DEPTH * 16; ++c) {
        const int l = c >> 4, hh = c & 15;
        gemm_bf16(p.keysb + (size_t)c * 128 * 128, 128, p.wqb + (size_t)l * DM * 2048 + hh * 128, 2048, 1, 8, 128, smem,
                  EpiStoreBfCol{p.wt_pq + (size_t)l * 2048 * DM + (size_t)hh * 128 * DM, DM, p.norm_ffn + l * DM}, (c & 7) + (c >> 3) * 64);
    }
#endif
    BAR();
#pragma unroll 1
    for (int l = 0; l < DEPTH; ++l) {
        gemm_bf16(p.xb, DM, p.wt_in + (size_t)l * NPAD_IN * DM, DM, TP / 128, NPAD_IN / 128, DM, smem, EpiInProj{p.gab, p.zs, p.xbr, p.dt, p.cq, p.ckv, p.kr, p.out, p.b_gate, p.dt_bias, p.rstd, l});
#if PROBE_GEMM
        gemm_bf16(p.xb, DM, p.wt_in + (size_t)l * NPAD_IN * DM, DM, TP / 128, NPAD_IN / 128, DM, smem, EpiInProj{p.gab, p.zs, p.xbr, p.dt, p.cq, p.ckv, p.kr, p.out, p.b_gate, p.dt_bias, p.rstd, l});
#endif
        BAR();
        ph_conv2(p, l);
        ph_rmsnorm(p.cq, QL, p.q_norm + l * QL, nullptr, 0, p.qnb, QL, QL, TP);
        ph_lat_kpe(p, l);
#if PROBE_ELEM
        ph_conv2(p, l);
        ph_rmsnorm(p.cq, QL, p.q_norm + l * QL, nullptr, 0, p.qnb, QL, QL, TP);
        ph_lat_kpe(p, l);
#endif
        BAR();
        ph_ssd_chunk(p, l, smem);
#if PROBE_SSD
        ph_ssd_chunk(p, l, smem);
#endif
        ph_ssd_seq(p, l);
#if PROBE_MISC
        ph_ssd_seq(p, l);
#endif
        gemm_bf16(p.qnb, QL, p.wt_qb + (size_t)l * 768 * QL, QL, TP / 128, 768 / 128, QL, smem, EpiQRope{p.qb, p.q, p.rope}, 128);
        gemm_bf16(p.latb, KVL, p.wt_kvb + (size_t)l * 1024 * KVL, KVL, TP / 128, 1024 / 128, KVL, smem, EpiKV{p.kn, p.vT}, 128);
        BAR();
        ph_gate_norm(p, l);
#if PROBE_ELEM
        ph_gate_norm(p, l);
#endif
        ph_attn(p, smem);
#if PROBE_ATTN
        ph_attn(p, smem);
#endif
        ph_qlat(p, l);
#if PROBE_MISC
        ph_qlat(p, l);
#endif
        BAR();
        ph_decode2(p, l, smem);
#if PROBE_DEC
        ph_decode2(p, l, smem);
#endif
        BAR();
        ph_decode_comb2(p, l, smem);
#if PROBE_MISC
        ph_decode_comb2(p, l, smem);
#endif
        BAR();
        gemm_bf16(p.ynb, DM, p.wt_ssm + (size_t)l * DM * DM, DM, TP / 128, DM / 128, DM, smem, EpiGateA{p.ya, p.gab});
        gemm_bf16(p.ob, 512, p.wt_mla + (size_t)l * DM * 512, 512, TP / 128, DM / 128, 512, smem, EpiGateB{p.ya, p.gab, p.mixb});
#if PROBE_GEMM
        gemm_bf16(p.ynb, DM, p.wt_ssm + (size_t)l * DM * DM, DM, TP / 128, DM / 128, DM, smem, EpiGateA{p.ya, p.gab});
        gemm_bf16(p.ob, 512, p.wt_mla + (size_t)l * DM * 512, 512, TP / 128, DM / 128, 512, smem, EpiGateB{p.ya, p.gab, p.mixb});
#endif
        BAR();
        gemm_bf16(p.mixb, DM, p.wt_out + (size_t)l * DM * DM, DM, TP / 128, DM / 128, DM, smem, EpiResidRow{p.xres, p.xb, p.sumsq1 + (size_t)l * TP});
        BAR();
        gemm_bf16(p.xb, DM, p.wt_pq + (size_t)l * 2048 * DM, DM, TP / 128, 2048 / 128, DM, smem, EpiScaleRow{p.sc, 2048, p.sumsq1 + (size_t)l * TP});
#if PROBE_GEMM
        gemm_bf16(p.xb, DM, p.wt_pq + (size_t)l * 2048 * DM, DM, TP / 128, 2048 / 128, DM, smem, EpiScaleRow{p.sc, 2048, p.sumsq1 + (size_t)l * TP});
#endif
        BAR();
        ph_peer_topk2(p);
#if PROBE_TOPK
        ph_peer_topk2(p);
#endif
        BAR();
#if PROBE_EXP
        ph_peer_experts3(p, l, true);
#endif
        ph_peer_experts3(p, l);
        BAR();
    }
}

static inline char* carve_b(char*& cur, size_t bytes) {
    char* r = cur;
    cur += ((bytes + 255) / 256) * 256;
    return r;
}
static inline float* carve(char*& cur, size_t nfloats) { return (float*)carve_b(cur, nfloats * 4); }
static inline bf16_t* carve_h(char*& cur, size_t n) { return (bf16_t*)carve_b(cur, n * 2); }

extern "C" void kernel_launch(void* const* d_in, const int* in_sizes, int n_in,
                              void* d_out, int out_size, void* d_ws, size_t ws_size,
                              hipStream_t stream) {
    P p{};
    p.x_prompt = (const float*)d_in[0]; p.x_sample = (const float*)d_in[1];
    p.cache_lat = (const float*)d_in[2]; p.cache_kr = (const float*)d_in[3];
    p.state_ssm = (const float*)d_in[4]; p.state_conv = (const float*)d_in[5];
    p.page_table = (const int*)d_in[6];
    p.norm_mix = (const float*)d_in[7]; p.w_in = (const float*)d_in[8]; p.b_gate = (const float*)d_in[9];
    p.conv_w = (const float*)d_in[10]; p.conv_b = (const float*)d_in[11]; p.dt_bias = (const float*)d_in[12];
    p.a_log = (const float*)d_in[13]; p.d_skip = (const float*)d_in[14]; p.ssm_norm = (const float*)d_in[15];
    p.w_ssm_proj = (const float*)d_in[16]; p.q_norm = (const float*)d_in[17]; p.w_qb = (const float*)d_in[18];
    p.kv_norm = (const float*)d_in[19]; p.w_kvb = (const float*)d_in[20]; p.w_mla_proj = (const float*)d_in[21];
    p.w_out = (const float*)d_in[22]; p.norm_ffn = (const float*)d_in[23]; p.peer_wq = (const float*)d_in[24];
    p.peer_keys = (const float*)d_in[25]; p.peer_u = (const float*)d_in[26]; p.peer_v = (const float*)d_in[27];
    p.norm_final = (const float*)d_in[28];
    p.out = (float*)d_out;
    char* cur = (char*)d_ws;
    p.bar = (unsigned*)carve(cur, XCD_BAR_WORDS);
    p.sumsq1 = carve(cur, (size_t)DEPTH * TP);
    char* zero_begin = (char*)d_ws;
    char* zero_end = cur;
    p.xres = carve(cur, (size_t)TP * DM);
    p.cq = carve(cur, (size_t)TP * QL);
    p.ckv = carve(cur, (size_t)TP * KVL);
    p.kr = carve(cur, (size_t)TP * 32);
    p.dt = carve(cur, (size_t)TP * 16);
    p.yraw = carve(cur, (size_t)TP * DM);
    p.ya = carve(cur, (size_t)TP * DM);
    p.q = carve(cur, (size_t)TP * 768);
    p.lat = carve(cur, (size_t)TP * KVL);
    p.kpe = carve(cur, (size_t)TP * 32);
    p.sc = carve(cur, (size_t)TP * 2048);
    p.gate = carve(cur, (size_t)TP * 128);
    p.part = carve(cur, (size_t)NS * 129 * 8 * 258);
    p.qlat = carve(cur, (size_t)NS * 8 * 256);
    p.rope = carve(cur, (size_t)2 * 2049 * 16);
    p.idx = (int*)carve(cur, (size_t)TP * 128);
    p.xb = carve_h(cur, (size_t)TP * DM);
    p.rstd = carve(cur, (size_t)TP);
    p.ynb = carve_h(cur, (size_t)TP * DM);
    p.qnb = carve_h(cur, (size_t)TP * QL);
    p.latb = carve_h(cur, (size_t)TP * KVL);
    p.ob = carve_h(cur, (size_t)TP * 512);
    p.mixb = carve_h(cur, (size_t)TP * DM);
    p.qb = carve_h(cur, (size_t)TP * 768);
    p.kn = carve_h(cur, (size_t)TP * 512);
    p.kpeb = carve_h(cur, (size_t)TP * 32);
    p.vT = carve_h(cur, (size_t)NB * 8 * 64 * SEQ);
    p.xbcb = carve_h(cur, (size_t)TP * CONVD);
    p.xbr = carve_h(cur, (size_t)TP * CONVD);
    p.gab = carve_h(cur, (size_t)TP * 2048);
    p.zs = carve_h(cur, (size_t)TP * DM);
    p.wt_in = carve_h(cur, (size_t)DEPTH * NPAD_IN * DM);
    p.wt_ssm = carve_h(cur, (size_t)DEPTH * DM * DM);
    p.wt_qb = carve_h(cur, (size_t)DEPTH * 768 * QL);
    p.wt_kvb = carve_h(cur, (size_t)DEPTH * 1024 * KVL);
    p.wt_mla = carve_h(cur, (size_t)DEPTH * DM * 512);
    p.wt_out = carve_h(cur, (size_t)DEPTH * DM * DM);
    p.wt_pq = carve_h(cur, (size_t)DEPTH * 2048 * DM);
    p.wqb = carve_h(cur, (size_t)DEPTH * DM * 2048);
    p.keysb = carve_h(cur, (size_t)DEPTH * 16 * 128 * 128);
    p.u8 = (unsigned char*)carve_b(cur, (size_t)DEPTH * NEXP * DM);
    p.v8 = (unsigned char*)carve_b(cur, (size_t)DEPTH * NEXP * DM);
    p.uinv = carve(cur, (size_t)DEPTH * NEXP);
    p.vinv = carve(cur, (size_t)DEPTH * NEXP);

    (void)hipMemsetAsync(zero_begin, 0, (size_t)(zero_end - zero_begin), stream);

    static int grid = 0;
    if (!grid) {
        int dev = 0, cus = 0, per_cu = 0;
        (void)hipGetDevice(&dev);
        (void)hipDeviceGetAttribute(&cus, hipDeviceAttributeMultiprocessorCount, dev);
        (void)hipOccupancyMaxActiveBlocksPerMultiprocessor(&per_cu, k_fwd, 256, 0);
        if (per_cu > 2) per_cu = 2;
        if (per_cu < 1) per_cu = 1;
        grid = cus * per_cu;
    }
    k_fwd<<<grid, 256, 0, stream>>>(p);
}
```

```cpp
#include <hip/hip_runtime.h>
#include <stdint.h>

#define DM 1024
#define NB 8
#define SEQ 2048
#define NPT (NB * SEQ)
#define NS 32
#define NT (NPT + NS)
#define TP 16512
#define DEPTH 2
#define PAST 16384
#define PAGE 128
#define NPAGES 128
#define NPOOL 5120
#define DIN 5296
#define OFF_GA 0
#define OFF_GB 1024
#define OFF_Z 2048
#define OFF_XBC 3072
#define OFF_DT 4608
#define OFF_CQ 4624
#define OFF_CKV 5008
#define OFF_KR 5264
#define CONVD 1536
#define QL 384
#define KVL 256
#define NEXP 16384
#define EPSF 1e-6f
#define ATT_SCALE 0.10206207261596577f

#define O_YP 0
#define O_YS (O_YP + NPT * DM)
#define O_LATP (O_YS + NS * DM)
#define O_KRP (O_LATP + DEPTH * NPT * KVL)
#define O_SSMP (O_KRP + DEPTH * NPT * 32)
#define O_CONVP (O_SSMP + DEPTH * NB * 16 * 64 * 128)
#define O_LATS (O_CONVP + DEPTH * NB * 3 * CONVD)
#define O_KRS (O_LATS + DEPTH * NS * KVL)
#define O_SSMS (O_KRS + DEPTH * NS * 32)
#define O_CONVS (O_SSMS + DEPTH * NS * 16 * 64 * 128)

struct P {
    const float *x_prompt, *x_sample, *cache_lat, *cache_kr, *state_ssm, *state_conv;
    const int* page_table;
    const float *norm_mix, *w_in, *b_gate, *conv_w, *conv_b, *dt_bias, *a_log, *d_skip, *ssm_norm, *w_ssm_proj;
    const float *q_norm, *w_qb, *kv_norm, *w_kvb, *w_mla_proj, *w_out, *norm_ffn, *peer_wq, *peer_keys, *peer_u, *peer_v, *norm_final;
    float* out;
    float *xres, *h, *proj, *xbc, *dt, *yraw, *yn, *ya, *qn, *q, *lat, *kpe, *kv, *o, *yb, *mix, *pq, *sc, *gate, *part, *qlat, *rope;
    int* idx;
    unsigned* bar;
    unsigned short *hb, *ynb, *qnb, *latb, *ob, *mixb, *qb, *kn, *kpeb, *vT, *xbcb, *xbr, *gab, *zs;
    float *cq, *ckv, *kr, *rstd, *sumsq1;
    unsigned short* xb;
    unsigned* queue;
    int grid, pad_;
    unsigned short *wt_in, *wt_ssm, *wt_qb, *wt_kvb, *wt_mla, *wt_out, *wt_pq, *wqb, *keysb;
    unsigned char *u8, *v8;
    float *uinv, *vinv;
};

#define XB_TMO      128
#define XB_XCNT(j)  (256  + 64 * (j))
#define XB_XSUB(j)  (1280 + 64 * (j))
#define XB_XGEN(j)  (2304 + 64 * (j))
#define XB_TOP      3328
#define XB_TOPGEN   3392
#define XCD_BAR_WORDS 3456
#define XB_SPIN_CAP (1u << 18)
#define LAS __attribute__((address_space(3)))

__device__ __forceinline__ unsigned xb_ld(unsigned* p)              { return __hip_atomic_load(p, __ATOMIC_RELAXED, __HIP_MEMORY_SCOPE_AGENT); }
__device__ __forceinline__ unsigned xb_add(unsigned* p, unsigned v) { return __hip_atomic_fetch_add(p, v, __ATOMIC_RELAXED, __HIP_MEMORY_SCOPE_AGENT); }
__device__ __forceinline__ unsigned xb_xcc_id() { return (unsigned)__builtin_amdgcn_s_getreg((3 << 11) | 20) & 0xFu; }
#define XB_SPIN(cond, bar) do { unsigned _sp = 0; while (cond) { __builtin_amdgcn_s_sleep(1); \
    if ((++_sp & 255u) == 0u) { if (xb_ld(&(bar)[XB_TMO])) break; if (_sp > XB_SPIN_CAP) { atomicAdd(&(bar)[XB_TMO], 1u); break; } } } } while (0)

struct XcdBarrier {
    unsigned* bar; unsigned x;
    volatile LAS unsigned* st;
};

__device__ __forceinline__ XcdBarrier xcd_barrier_post(unsigned* bar, volatile LAS unsigned* st) {
    XcdBarrier b; b.bar = bar; b.x = xb_xcc_id(); b.st = st;
    if (threadIdx.x == 0) (void)xb_add(&bar[XB_XCNT(b.x)], 1u);
    return b;
}
__device__ __forceinline__ void xcd_barrier_complete(unsigned* bar, unsigned x, unsigned& nloc, unsigned& nx) {
    const unsigned G = gridDim.x * gridDim.y * gridDim.z;
    unsigned sum, cnt, mine, sp = 0u;
    for (;;) {
        sum = 0u; cnt = 0u; mine = 0u;
#pragma unroll
        for (unsigned j = 0; j < 16; ++j) { const unsigned c = xb_ld(&bar[XB_XCNT(j)]); sum += c; cnt += (c > 0u) ? 1u : 0u; mine = (j == x) ? c : mine; }
        if (sum == G) break;
        __builtin_amdgcn_s_sleep(1);
        if ((++sp & 255u) == 0u) { if (xb_ld(&bar[XB_TMO])) break; if (sp > XB_SPIN_CAP) { atomicAdd(&bar[XB_TMO], 1u); break; } }
    }
    nloc = mine > 0u ? mine : 1u; nx = cnt > 0u ? cnt : 1u;
}

__device__ __forceinline__ void xcd_barrier(const XcdBarrier& b) {
    asm volatile("s_waitcnt vmcnt(0)" ::: "memory");
    __syncthreads();
    if (threadIdx.x == 0) {
        unsigned* bar = b.bar;
        __builtin_amdgcn_s_waitcnt(0);
        unsigned nloc = b.st[0], nx = b.st[1];
        if (nloc == 0u) { xcd_barrier_complete(bar, b.x, nloc, nx); b.st[0] = nloc; b.st[1] = nx; }
        const unsigned old = xb_add(&bar[XB_XSUB(b.x)], 1u);
        const unsigned gen = old / nloc;
        if (old + 1u == (gen + 1u) * nloc) {
            __builtin_amdgcn_fence(__ATOMIC_RELEASE, "agent");
            asm volatile("s_waitcnt vmcnt(0)" ::: "memory");
            const unsigned og = xb_add(&bar[XB_TOP], 1u);
            const unsigned tg = og / nx;
            if (og + 1u == (tg + 1u) * nx) xb_add(&bar[XB_TOPGEN], 1u);
            else XB_SPIN(xb_ld(&bar[XB_TOPGEN]) == tg, bar);
            __builtin_amdgcn_fence(__ATOMIC_ACQUIRE, "agent");
            xb_add(&bar[XB_XGEN(b.x)], 1u);
            asm volatile("s_waitcnt vmcnt(0)" ::: "memory");
        } else {
            XB_SPIN(xb_ld(&bar[XB_XGEN(b.x)]) == gen, bar);
            __builtin_amdgcn_fence(__ATOMIC_ACQUIRE, "agent");
            asm volatile("s_waitcnt vmcnt(0)" ::: "memory");
        }
    }
    __syncthreads();
}


__device__ __forceinline__ float wave_sum(float v) {
#pragma unroll
    for (int o = 32; o > 0; o >>= 1) v += __shfl_xor(v, o);
    return v;
}
__device__ __forceinline__ float wave_max(float v) {
#pragma unroll
    for (int o = 32; o > 0; o >>= 1) v = fmaxf(v, __shfl_xor(v, o));
    return v;
}
__device__ __forceinline__ float sigmoid_f(float x) { return __builtin_amdgcn_rcpf(1.f + __expf(-x)); }
__device__ __forceinline__ float silu_f(float x) { return x * sigmoid_f(x); }


__device__ __forceinline__ int opaque_v(int x) { asm volatile("" : "+v"(x)); return x; }
__device__ __forceinline__ int opaque_s(int x) { asm volatile("" : "+s"(x)); return x; }

#ifndef PROBE_GEMM
#define PROBE_GEMM 0
#endif
#ifndef PROBE_TOPK
#define PROBE_TOPK 0
#endif
#ifndef PROBE_ATTN
#define PROBE_ATTN 0
#endif
#ifndef PROBE_DEC
#define PROBE_DEC 0
#endif
#ifndef PROBE_SSD
#define PROBE_SSD 0
#endif
#ifndef PROBE_ELEM
#define PROBE_ELEM 0
#endif
#ifndef PROBE_EXP
#define PROBE_EXP 0
#endif
#ifndef PROBE_PRO2
#define PROBE_PRO2 0
#endif
#ifndef PROBE_WEFF
#define PROBE_WEFF 0
#endif
#ifndef PROBE_MISC
#define PROBE_MISC 0
#endif
#ifndef PROBE_BAR
#define PROBE_BAR 0
#endif
#ifndef PROBE_TWICE
#define PROBE_TWICE 0
#endif
#ifndef PROBE_PRO
#define PROBE_PRO 0
#endif
#define NTHR 256
#define VB_LOOP(n) for (int vb = bid_; vb < (n); vb += GX)


typedef unsigned short bf16_t;
using bf16x8 = __attribute__((ext_vector_type(8))) short;
using f32x4 = __attribute__((ext_vector_type(4))) float;
typedef __attribute__((ext_vector_type(2))) __bf16 bf16x2_t;
__device__ __forceinline__ bf16_t f2bf(float f) { __bf16 h = (__bf16)f; return __builtin_bit_cast(unsigned short, h); }
__device__ __forceinline__ unsigned pack_bf16(float a, float b) { bf16x2_t r; r[0] = (__bf16)a; r[1] = (__bf16)b; return __builtin_bit_cast(unsigned, r); }
__device__ __forceinline__ float bf2f(bf16_t h) { return __uint_as_float(((unsigned)h) << 16); }
__device__ __forceinline__ float bflo(unsigned d) { return __uint_as_float(d << 16); }
__device__ __forceinline__ float bfhi(unsigned d) { return __uint_as_float(d & 0xffff0000u); }

__device__ __forceinline__ int lds_byte(int r, int c) {
    int st = (r >> 4) * 2 + (c >> 5), rr = r & 15, cc = c & 31, ob = rr * 64 + cc * 2;
    return st * 1024 + (ob ^ (((ob >> 9) & 1) << 5));
}
__device__ __forceinline__ void stage_rc(int b, int& R, int& C) {
    int st = b / 1024, sb = b % 1024, swz = sb ^ (((sb >> 9) & 1) << 5);
    R = (st >> 1) * 16 + swz / 64; C = (st & 1) * 32 + (swz % 64) / 2;
}
template <bool PERM>
__device__ __forceinline__ void stage_tile(const bf16_t* base, int ld, int row0, int k0, char* dst, int tid) {
#pragma unroll
    for (int i = 0; i < 4; ++i) {
        int b = tid * 16 + i * 4096;
        int R, C; stage_rc(b, R, C);
        if (PERM) R = (R & 64) + 4 * (R & 15) + ((R >> 4) & 3);
        const bf16_t* src = base + (size_t)(row0 + R) * ld + k0 + C;
        __builtin_amdgcn_global_load_lds((const unsigned*)src, (unsigned*)(dst + b), 16, 0, 0);
    }
}
__device__ __forceinline__ void tile_map(int id, int mtiles, int ntiles, int& mt, int& nt) {
    const int fg = mtiles >> 3, full = fg * ntiles * 8;
    if (id < full) { const int mg = id / (ntiles * 8), r = id % (ntiles * 8); nt = r >> 3; mt = mg * 8 + (r & 7); }
    else { const int rem = mtiles & 7, r = id - full; nt = r / rem; mt = fg * 8 + r % rem; }
}
template <class Epi>
__device__ __forceinline__ void gemm_bf16(const bf16_t* A, int lda, const bf16_t* Bt, int ldb, int mtiles, int ntiles, int K, char* smem, Epi epi, const int GX, int vb0 = 0) {
    const int tid = opaque_v((int)threadIdx.x);
    int bid0 = (int)blockIdx.x - vb0;
    while (bid0 < 0) bid0 += GX;
    const int bid = opaque_s(__builtin_amdgcn_readfirstlane(bid0));
    const int wid = tid >> 6, lane = tid & 63, wm = wid >> 1, wn = wid & 1, fr = lane & 15, fq = lane >> 4;
    const int nk = K / 64, total = mtiles * ntiles, G = GX;
    const bool xcd = (G & 7) == 0;
    const int nq = G >> 3;
    for (int st = 0;; ++st) {
        const int id = xcd ? ((st * 8 + (bid & 7)) * nq + (bid >> 3)) : (st * G + bid);
        if (st * G >= total) break;
        if (id >= total) continue;
        int mt, nt; tile_map(id, mtiles, ntiles, mt, nt);
        const int m0 = mt * 128, n0 = nt * 128;
        f32x4 acc[4][4];
#pragma unroll
        for (int i = 0; i < 4; ++i)
#pragma unroll
            for (int j = 0; j < 4; ++j) acc[i][j] = f32x4{0.f, 0.f, 0.f, 0.f};
        stage_tile<false>(A, lda, m0, 0, smem, tid);
        stage_tile<true>(Bt, ldb, n0, 0, smem + 16384, tid);
        for (int kt = 0; kt < nk; ++kt) {
            asm volatile("s_waitcnt vmcnt(0)" ::: "memory");
            __syncthreads();
            if (kt + 1 < nk) {
                char* nb = smem + ((kt + 1) & 1) * 32768;
                stage_tile<false>(A, lda, m0, (kt + 1) * 64, nb, tid);
                stage_tile<true>(Bt, ldb, n0, (kt + 1) * 64, nb + 16384, tid);
            }
            const char* ab = smem + (kt & 1) * 32768;
            const char* bb = ab + 16384;
#pragma unroll
            for (int s2 = 0; s2 < 2; ++s2) {
                bf16x8 a[4], b[4];
#pragma unroll
                for (int i = 0; i < 4; ++i) a[i] = *reinterpret_cast<const bf16x8*>(ab + lds_byte(wm * 64 + i * 16 + fr, s2 * 32 + fq * 8));
#pragma unroll
                for (int j = 0; j < 4; ++j) b[j] = *reinterpret_cast<const bf16x8*>(bb + lds_byte(wn * 64 + j * 16 + fr, s2 * 32 + fq * 8));
#pragma unroll
                for (int i = 0; i < 4; ++i)
#pragma unroll
                    for (int j = 0; j < 4; ++j) acc[i][j] = __builtin_amdgcn_mfma_f32_16x16x32_bf16(a[i], b[j], acc[i][j], 0, 0, 0);
            }
        }
#pragma unroll
        for (int i = 0; i < 4; ++i) epi.blk(m0 + wm * 64 + i * 16 + fq * 4, n0 + wn * 64 + fr * 4, acc[i]);
        __syncthreads();
    }
}
#define EPI_ROWS __device__ __forceinline__ void blk(int m, int n, const f32x4 (&c)[4]) const { \
    row4(m + 0, n, c[0][0], c[1][0], c[2][0], c[3][0]); row4(m + 1, n, c[0][1], c[1][1], c[2][1], c[3][1]); \
    row4(m + 2, n, c[0][2], c[1][2], c[2][2], c[3][2]); row4(m + 3, n, c[0][3], c[1][3], c[2][3], c[3][3]); }
__device__ __forceinline__ uint2 pack4(float a, float b, float c, float d) { uint2 r; r.x = pack_bf16(a, b); r.y = pack_bf16(c, d); return r; }
struct EpiGateA { float* ya; const bf16_t* gab;
    __device__ __forceinline__ void row4(int m, int n, float v0, float v1, float v2, float v3) const {
        const uint2 g = *reinterpret_cast<const uint2*>(gab + (size_t)m * 2048 + n);
        *reinterpret_cast<float4*>(ya + (size_t)m * DM + n) = make_float4(bflo(g.x) * v0, bfhi(g.x) * v1, bflo(g.y) * v2, bfhi(g.y) * v3);
    } EPI_ROWS };
struct EpiGateB { const float* ya; const bf16_t* gab; bf16_t* mixb;
    __device__ __forceinline__ void row4(int m, int n, float v0, float v1, float v2, float v3) const {
        const uint2 g = *reinterpret_cast<const uint2*>(gab + (size_t)m * 2048 + 1024 + n);
        const float4 y = *reinterpret_cast<const float4*>(ya + (size_t)m * DM + n);
        *reinterpret_cast<uint2*>(mixb + (size_t)m * DM + n) = pack4(y.x + bflo(g.x) * v0, y.y + bfhi(g.x) * v1, y.z + bflo(g.y) * v2, y.w + bfhi(g.y) * v3);
    } EPI_ROWS };
struct EpiStore { float* C; int ldc; int N;
    __device__ __forceinline__ void row4(int m, int n, float v0, float v1, float v2, float v3) const { if (n < N) *reinterpret_cast<float4*>(C + (size_t)m * ldc + n) = make_float4(v0, v1, v2, v3); } EPI_ROWS };
struct EpiStoreBfCol { bf16_t* C; int ldc; const float* cs;
    __device__ __forceinline__ void row4(int m, int n, float v0, float v1, float v2, float v3) const {
        const float4 c4 = *reinterpret_cast<const float4*>(cs + n);
        *reinterpret_cast<uint2*>(C + (size_t)m * ldc + n) = pack4(v0 * c4.x, v1 * c4.y, v2 * c4.z, v3 * c4.w);
    } EPI_ROWS };
struct EpiScaleRow { float* C; int ldc; const float* sumsq;
    __device__ __forceinline__ void row4(int m, int n, float v0, float v1, float v2, float v3) const {
        const float rs = rsqrtf(sumsq[m] * (1.f / DM) + EPSF);
        *reinterpret_cast<float4*>(C + (size_t)m * ldc + n) = make_float4(v0 * rs, v1 * rs, v2 * rs, v3 * rs);
    } EPI_ROWS };
struct EpiResidRow { float* xres; bf16_t* xb; float* sumsq;
    __device__ __forceinline__ void row4(int m, int n, float v0, float v1, float v2, float v3) const {
        float4* xp = reinterpret_cast<float4*>(xres + (size_t)m * DM + n);
        float4 x = *xp;
        x.x += v0; x.y += v1; x.z += v2; x.w += v3;
        *xp = x;
        *reinterpret_cast<uint2*>(xb + (size_t)m * DM + n) = pack4(x.x, x.y, x.z, x.w);
        float ss = x.x * x.x + x.y * x.y + x.z * x.z + x.w * x.w;
        ss += __shfl_xor(ss, 1); ss += __shfl_xor(ss, 2); ss += __shfl_xor(ss, 4); ss += __shfl_xor(ss, 8);
        if ((threadIdx.x & 15) == 0) atomicAdd(sumsq + m, ss);
    } EPI_ROWS };
struct EpiQRope { bf16_t* qb; float* q; const float* rope;
    __device__ __forceinline__ void row4(int m, int n, float v0, float v1, float v2, float v3) const {
        const float o0 = __shfl_xor(v0, 4), o1 = __shfl_xor(v1, 4), o2 = __shfl_xor(v2, 4), o3 = __shfl_xor(v3, 4);
        const int d = n % 96;
        float r0 = v0, r1 = v1, r2 = v2, r3 = v3;
        if (d >= 64) {
            const int pi = (m < NPT) ? (m & (SEQ - 1)) : 2048;
            const int dd = d - 64, jj = dd & 15;
            const float4 cs = *reinterpret_cast<const float4*>(rope + pi * 16 + jj);
            const float4 sn = *reinterpret_cast<const float4*>(rope + 2049 * 16 + pi * 16 + jj);
            if (dd < 16) { r0 = v0 * cs.x - o0 * sn.x; r1 = v1 * cs.y - o1 * sn.y; r2 = v2 * cs.z - o2 * sn.z; r3 = v3 * cs.w - o3 * sn.w; }
            else { r0 = o0 * sn.x + v0 * cs.x; r1 = o1 * sn.y + v1 * cs.y; r2 = o2 * sn.z + v2 * cs.z; r3 = o3 * sn.w + v3 * cs.w; }
        }
        const float qsc = ATT_SCALE * 1.4426950408889634f;
        *reinterpret_cast<uint2*>(qb + (size_t)m * 768 + n) = pack4(r0 * qsc, r1 * qsc, r2 * qsc, r3 * qsc);
        if (m >= NPT) *reinterpret_cast<float4*>(q + (size_t)m * 768 + n) = make_float4(r0, r1, r2, r3);
    } EPI_ROWS };
struct EpiStoreBf { bf16_t* C; int ldc;
    __device__ __forceinline__ void row4(int m, int n, float v0, float v1, float v2, float v3) const { *reinterpret_cast<uint2*>(C + (size_t)m * ldc + n) = pack4(v0, v1, v2, v3); } EPI_ROWS };
__device__ __forceinline__ void ph_convert_plain(const float* src, bf16_t* dst, size_t n, const int GX) {
    const int tid = opaque_v((int)threadIdx.x); const int bid = opaque_s((int)blockIdx.x);
    for (size_t i = ((size_t)bid * NTHR + tid) * 4; i < n; i += (size_t)GX * NTHR * 4) {
        float4 v = *(const float4*)(src + i);
        ushort4 o; o.x = f2bf(v.x); o.y = f2bf(v.y); o.z = f2bf(v.z); o.w = f2bf(v.w);
        *(ushort4*)(dst + i) = o;
    }
}
__device__ __forceinline__ void ph_convert_w(const float* W, int K, int N, int Npad, bf16_t* Bt, char* smem, const int GX, const float* kscale = nullptr) {
    const int tid = opaque_v((int)threadIdx.x); const int bid = opaque_s((int)blockIdx.x);
    float (*t)[65] = (float (*)[65])smem;
    int tk = K / 64, tn = Npad / 64;
    for (int vb = bid; vb < tk * tn; vb += GX) {
        int k0 = (vb % tk) * 64, n0 = (vb / tk) * 64;
        for (int i = tid; i < 64 * 64; i += NTHR) {
            int kk = i >> 6, nn = i & 63;
            t[kk][nn] = (n0 + nn < N) ? W[(size_t)(k0 + kk) * N + n0 + nn] * (kscale ? kscale[k0 + kk] : 1.f) : 0.f;
        }
        __syncthreads();
        for (int i = tid; i < 64 * 64; i += NTHR) {
            int nn = i >> 6, kk = i & 63;
            Bt[(size_t)(n0 + nn) * K + k0 + kk] = f2bf(t[kk][nn]);
        }
        __syncthreads();
    }
}

__device__ __forceinline__ void ph_rope_table(const P& p) {
    const int GX = p.grid;
    const int tid_ = opaque_v((int)threadIdx.x); const int bid_ = opaque_s((int)blockIdx.x); (void)tid_; (void)bid_;
    for (int i = bid_ * NTHR + tid_; i < 2049 * 16; i += GX * NTHR) {
        int pi = i / 16, j = i % 16;
        float pos = (pi == 2048) ? 16384.f : (float)pi;
        float inv = powf(10000.f, -(float)j / 16.f);
        float ang = pos * inv;
        p.rope[i] = (float)cos((double)ang);
        p.rope[2049 * 16 + i] = (float)sin((double)ang);
    }
}
__device__ __forceinline__ void ph_copy_x(const P& p) {
    const int GX = p.grid;
    const int tid_ = opaque_v((int)threadIdx.x); const int bid_ = opaque_s((int)blockIdx.x);
    const int wid = tid_ >> 6, lane = tid_ & 63;
    for (int t = bid_ * 4 + wid; t < NT; t += GX * 4) {
        const float* src = (t < NPT) ? (p.x_prompt + (size_t)t * DM) : (p.x_sample + (size_t)(t - NPT) * DM);
        const float4* sp = reinterpret_cast<const float4*>(src + lane * 16);
        float4 v[4]; float ss = 0.f;
#pragma unroll
        for (int q4 = 0; q4 < 4; ++q4) { v[q4] = sp[q4]; ss += v[q4].x * v[q4].x + v[q4].y * v[q4].y + v[q4].z * v[q4].z + v[q4].w * v[q4].w; }
        ss = wave_sum(ss);
        float4* xp = reinterpret_cast<float4*>(p.xres + (size_t)t * DM + lane * 16);
#pragma unroll
        for (int q4 = 0; q4 < 4; ++q4) xp[q4] = v[q4];
        uint4 b0, b1;
        b0.x = pack_bf16(v[0].x, v[0].y); b0.y = pack_bf16(v[0].z, v[0].w); b0.z = pack_bf16(v[1].x, v[1].y); b0.w = pack_bf16(v[1].z, v[1].w);
        b1.x = pack_bf16(v[2].x, v[2].y); b1.y = pack_bf16(v[2].z, v[2].w); b1.z = pack_bf16(v[3].x, v[3].y); b1.w = pack_bf16(v[3].z, v[3].w);
        uint4* bp = reinterpret_cast<uint4*>(p.xb + (size_t)t * DM + lane * 16);
        bp[0] = b0; bp[1] = b1;
        if (lane == 0) p.rstd[t] = rsqrtf(ss * (1.f / DM) + EPSF);
    }
}
__device__ __forceinline__ void ph_rmsnorm(const float* in, int ldi, const float* w, float* out, int ldo, bf16_t* outb, int ldob, int D, int rows, const int GX) {
    const int tid_ = opaque_v((int)threadIdx.x); const int bid_ = opaque_s((int)blockIdx.x); (void)tid_; (void)bid_;
    VB_LOOP((rows + 3) / 4) {
        int row = vb * 4 + (tid_ >> 6);
        int lane = tid_ & 63;
        if (row < rows) {
            const float* x = in + (size_t)row * ldi;
            float s = 0.f;
            for (int c = lane; c < D; c += 64) { float v = x[c]; s += v * v; }
            s = wave_sum(s);
            float r = rsqrtf(s / (float)D + EPSF);
            for (int c = lane; c < D; c += 64) {
                float v = x[c] * r * w[c];
                if (out) out[(size_t)row * ldo + c] = v;
                if (outb) outb[(size_t)row * ldob + c] = f2bf(v);
            }
        }
    }
}
__device__ __forceinline__ void ph_ssd_seq(const P& p, int layer) {
    const int GX = p.grid;
    const int tid_ = opaque_v((int)threadIdx.x); const int bid_ = opaque_s((int)blockIdx.x); (void)tid_; (void)bid_;
    VB_LOOP(NS * 16) {
        int seq = NB + vb / 16, e = vb % 16, g = e / 8;
        int pp = tid_ >> 2, nq = tid_ & 3;
        float A = -expf(p.a_log[layer * 16 + e]);
        float Dk = p.d_skip[layer * 16 + e];
        float s[32];
        int t0, L;
        float* hout;
        if (seq < NB) {
            t0 = seq * SEQ; L = SEQ;
#pragma unroll
            for (int j = 0; j < 32; ++j) s[j] = 0.f;
            hout = p.out + O_SSMP + (((size_t)(layer * NB + seq) * 16 + e) * 64 + pp) * 128 + nq * 32;
        } else {
            int bs = seq - NB;
            t0 = NPT + bs; L = 1;
            const float* h0 = p.state_ssm + (((size_t)(layer * NS + bs) * 16 + e) * 64 + pp) * 128 + nq * 32;
#pragma unroll
            for (int j = 0; j < 32; ++j) s[j] = h0[j];
            hout = p.out + O_SSMS + (((size_t)(layer * NS + bs) * 16 + e) * 64 + pp) * 128 + nq * 32;
        }
        for (int l = 0; l < L; ++l) {
            int t = t0 + l;
            float dt = p.dt[t * 16 + e];
            float dA = expf(dt * A);
            const bf16_t* xr = p.xbcb + (size_t)t * CONVD;
            float xv = bf2f(xr[e * 64 + pp]);
            float xdt = xv * dt;
            const bf16_t* Bp = xr + 1024 + g * 128 + nq * 32;
            const bf16_t* Cp = xr + 1280 + g * 128 + nq * 32;
            float ys = 0.f;
#pragma unroll
            for (int j4 = 0; j4 < 8; ++j4) {
                float4 b, c;
                b.x = bf2f(Bp[j4 * 4]); b.y = bf2f(Bp[j4 * 4 + 1]); b.z = bf2f(Bp[j4 * 4 + 2]); b.w = bf2f(Bp[j4 * 4 + 3]);
                c.x = bf2f(Cp[j4 * 4]); c.y = bf2f(Cp[j4 * 4 + 1]); c.z = bf2f(Cp[j4 * 4 + 2]); c.w = bf2f(Cp[j4 * 4 + 3]);
                s[j4 * 4 + 0] = s[j4 * 4 + 0] * dA + xdt * b.x; ys += c.x * s[j4 * 4 + 0];
                s[j4 * 4 + 1] = s[j4 * 4 + 1] * dA + xdt * b.y; ys += c.y * s[j4 * 4 + 1];
                s[j4 * 4 + 2] = s[j4 * 4 + 2] * dA + xdt * b.z; ys += c.z * s[j4 * 4 + 2];
                s[j4 * 4 + 3] = s[j4 * 4 + 3] * dA + xdt * b.w; ys += c.w * s[j4 * 4 + 3];
            }
            ys += __shfl_xor(ys, 1);
            ys += __shfl_xor(ys, 2);
            if (nq == 0) p.yraw[(size_t)t * DM + e * 64 + pp] = ys + Dk * xv;
        }
#pragma unroll
        for (int j = 0; j < 32; ++j) hout[j] = s[j];
    }
}
__device__ __forceinline__ void ph_gate_norm(const P& p, int layer) {
    const int GX = p.grid;
    const int tid_ = opaque_v((int)threadIdx.x); const int bid_ = opaque_s((int)blockIdx.x); (void)tid_; (void)bid_;
    VB_LOOP((NT * 2 + 3) / 4) {
        int w = vb * 4 + (tid_ >> 6);
        int lane = tid_ & 63;
        if (w < NT * 2) {
            int t = w >> 1, g = w & 1;
            float v[8];
            float ss = 0.f;
#pragma unroll
            for (int j = 0; j < 8; ++j) {
                int c = g * 512 + j * 64 + lane;
                float y = p.yraw[(size_t)t * DM + c];
                v[j] = y * bf2f(p.zs[(size_t)t * DM + c]);
                ss += v[j] * v[j];
            }
            ss = wave_sum(ss);
            float r = rsqrtf(ss / 512.f + EPSF);
#pragma unroll
            for (int j = 0; j < 8; ++j) {
                int c = g * 512 + j * 64 + lane;
                p.ynb[(size_t)t * DM + c] = f2bf(v[j] * r * p.ssm_norm[layer * DM + c]);
            }
        }
    }
}
__device__ __forceinline__ void ph_lat_kpe(const P& p, int layer) {
    const int GX = p.grid;
    const int tid_ = opaque_v((int)threadIdx.x); const int bid_ = opaque_s((int)blockIdx.x);
    VB_LOOP((NT + 3) / 4) {
        int t = vb * 4 + (tid_ >> 6);
        int lane = tid_ & 63;
        if (t < NT) {
            const float4 c4 = *reinterpret_cast<const float4*>(p.ckv + (size_t)t * KVL + lane * 4);
            float ss = wave_sum(c4.x * c4.x + c4.y * c4.y + c4.z * c4.z + c4.w * c4.w);
            const float r = rsqrtf(ss * (1.f / KVL) + EPSF);
            const float4 g4 = *reinterpret_cast<const float4*>(p.kv_norm + layer * KVL + lane * 4);
            const float4 l4 = make_float4(c4.x * r * g4.x, c4.y * r * g4.y, c4.z * r * g4.z, c4.w * r * g4.w);
            *reinterpret_cast<float4*>(p.lat + (size_t)t * KVL + lane * 4) = l4;
            *reinterpret_cast<uint2*>(p.latb + (size_t)t * KVL + lane * 4) = pack4(l4.x, l4.y, l4.z, l4.w);
            float* ol = (t < NPT) ? (p.out + O_LATP + ((size_t)layer * NPT + t) * KVL) : (p.out + O_LATS + ((size_t)layer * NS + (t - NPT)) * KVL);
            *reinterpret_cast<float4*>(ol + lane * 4) = l4;
            if (lane < 16) {
                int pi = (t < NPT) ? (t % SEQ) : 2048;
                const float* cs = p.rope + pi * 16;
                const float* sn = p.rope + 2049 * 16 + pi * 16;
                const float* kr = p.kr + (size_t)t * 32;
                float x1 = kr[lane], x2 = kr[16 + lane];
                float o1 = x1 * cs[lane] - x2 * sn[lane];
                float o2 = x1 * sn[lane] + x2 * cs[lane];
                p.kpe[(size_t)t * 32 + lane] = o1;
                p.kpe[(size_t)t * 32 + 16 + lane] = o2;
                p.kpeb[(size_t)t * 32 + lane] = f2bf(o1);
                p.kpeb[(size_t)t * 32 + 16 + lane] = f2bf(o2);
                float* ok = (t < NPT) ? (p.out + O_KRP + ((size_t)layer * NPT + t) * 32) : (p.out + O_KRS + ((size_t)layer * NS + (t - NPT)) * 32);
                ok[lane] = o1; ok[16 + lane] = o2;
            }
        }
    }
}

#define A_KRS 208
#define A_VRS 144
#define A_KBYTES (64 * A_KRS)
#define A_BUF (64 * A_KRS + 64 * A_VRS)
struct EpiKV { bf16_t* kn; bf16_t* vT;
    __device__ __forceinline__ void blk(int m, int n, const f32x4 (&c)[4]) const {
        const int h = n >> 7, j = n & 127;
        if (j < 64) {
#pragma unroll
            for (int r = 0; r < 4; ++r) *reinterpret_cast<uint2*>(kn + (size_t)(m + r) * 512 + h * 64 + j) = pack4(c[0][r], c[1][r], c[2][r], c[3][r]);
        } else if (m < NPT) {
#pragma unroll
            for (int jj = 0; jj < 4; ++jj)
                *reinterpret_cast<uint2*>(vT + ((size_t)((m >> 11) * 8 + h) * 64 + (j - 64 + jj)) * SEQ + (m & (SEQ - 1))) = pack4(c[jj][0], c[jj][1], c[jj][2], c[jj][3]);
        }
    } };
__device__ __forceinline__ void attn_unit(const P& p, char* smem, int o, int tid) {
    const int wid = tid >> 6, lane = tid & 63, fr = lane & 15, fq = lane >> 4;
    {
        const int qblk = 15 - (o >> 6), bh = o & 63, b = bh >> 3, h = bh & 7;
        const int q0w = qblk * 128 + wid * 32;
        const size_t tok0 = (size_t)b * SEQ;
        bf16x8 qf[2][3];
#pragma unroll
        for (int qt = 0; qt < 2; ++qt)
#pragma unroll
            for (int s3 = 0; s3 < 3; ++s3)
                qf[qt][s3] = *reinterpret_cast<const bf16x8*>(p.qb + (tok0 + q0w + qt * 16 + fr) * 768 + h * 96 + s3 * 32 + fq * 8);
        f32x4 oacc[2][4];
        float mrun[2], lrun[2];
#pragma unroll
        for (int qt = 0; qt < 2; ++qt) {
            mrun[qt] = -INFINITY; lrun[qt] = 0.f;
#pragma unroll
            for (int mt = 0; mt < 4; ++mt) oacc[qt][mt] = f32x4{0.f, 0.f, 0.f, 0.f};
        }
        const int nkb = 2 * qblk + 2;
        uint4 stg0, stg1, stg2, stg3, stg4;
#define A_ISSUE(kb_) do { const size_t key0 = (size_t)(kb_) * 64; \
            { int c = tid; int row = c >> 3, ch = c & 7; stg0 = *reinterpret_cast<const uint4*>(p.kn + (tok0 + key0 + row) * 512 + h * 64 + ch * 8); } \
            { int c = tid + 256; int row = c >> 3, ch = c & 7; stg1 = *reinterpret_cast<const uint4*>(p.kn + (tok0 + key0 + row) * 512 + h * 64 + ch * 8); } \
            { int c = tid; int row = c >> 2, ch = c & 3; stg2 = *reinterpret_cast<const uint4*>(p.kpeb + (tok0 + key0 + row) * 32 + ch * 8); } \
            { int c = tid; int row = c >> 3, ch = c & 7; stg3 = *reinterpret_cast<const uint4*>(p.vT + ((size_t)(b * 8 + h) * 64 + row) * SEQ + key0 + ch * 8); } \
            { int c = tid + 256; int row = c >> 3, ch = c & 7; stg4 = *reinterpret_cast<const uint4*>(p.vT + ((size_t)(b * 8 + h) * 64 + row) * SEQ + key0 + ch * 8); } \
        } while (0)
#define A_COMMIT(buf_) do { char* buf = (buf_); \
            { int c = tid; int row = c >> 3, ch = c & 7; *reinterpret_cast<uint4*>(buf + row * A_KRS + ch * 16) = stg0; } \
            { int c = tid + 256; int row = c >> 3, ch = c & 7; *reinterpret_cast<uint4*>(buf + row * A_KRS + ch * 16) = stg1; } \
            { int c = tid; int row = c >> 2, ch = c & 3; *reinterpret_cast<uint4*>(buf + row * A_KRS + 128 + ch * 16) = stg2; } \
            { int c = tid; int row = c >> 3, ch = c & 7; *reinterpret_cast<uint4*>(buf + A_KBYTES + row * A_VRS + ch * 16) = stg3; } \
            { int c = tid + 256; int row = c >> 3, ch = c & 7; *reinterpret_cast<uint4*>(buf + A_KBYTES + row * A_VRS + ch * 16) = stg4; } \
        } while (0)
        A_ISSUE(0);
        A_COMMIT(smem);
        __syncthreads();
        for (int kb = 0; kb < nkb; ++kb) {
            const char* kbuf = smem + (kb & 1) * A_BUF;
            const char* vbuf = kbuf + A_KBYTES;
            if (kb + 1 < nkb) A_ISSUE(kb + 1);
#pragma unroll
            for (int kh = 0; kh < 2; ++kh) {
                const int k0 = kb * 64 + kh * 32;
                if (k0 <= q0w + 31) {
                    f32x4 st[2][2];
#pragma unroll
                    for (int qt = 0; qt < 2; ++qt)
#pragma unroll
                        for (int kt = 0; kt < 2; ++kt) st[qt][kt] = f32x4{0.f, 0.f, 0.f, 0.f};
#pragma unroll
                    for (int s3 = 0; s3 < 3; ++s3)
#pragma unroll
                        for (int kt = 0; kt < 2; ++kt) {
                            bf16x8 kf = *reinterpret_cast<const bf16x8*>(kbuf + (kh * 32 + kt * 16 + fr) * A_KRS + (s3 * 32 + fq * 8) * 2);
#pragma unroll
                            for (int qt = 0; qt < 2; ++qt) st[qt][kt] = __builtin_amdgcn_mfma_f32_16x16x32_bf16(kf, qf[qt][s3], st[qt][kt], 0, 0, 0);
                        }
                    const bool need_mask = (k0 + 31 > q0w);
                    bf16x8 pf[2];
#pragma unroll
                    for (int qt = 0; qt < 2; ++qt) {
                        if (need_mask) {
                            const int qi = q0w + qt * 16 + fr;
#pragma unroll
                            for (int kt = 0; kt < 2; ++kt)
#pragma unroll
                                for (int r = 0; r < 4; ++r)
                                    if (k0 + kt * 16 + fq * 4 + r > qi) st[qt][kt][r] = -INFINITY;
                        }
                        float mx = fmaxf(fmaxf(fmaxf(st[qt][0][0], st[qt][0][1]), fmaxf(st[qt][0][2], st[qt][0][3])),
                                         fmaxf(fmaxf(st[qt][1][0], st[qt][1][1]), fmaxf(st[qt][1][2], st[qt][1][3])));
                        mx = fmaxf(mx, __shfl_xor(mx, 16));
                        mx = fmaxf(mx, __shfl_xor(mx, 32));
                        const float mnew = fmaxf(mrun[qt], mx);
                        const float corr = __builtin_amdgcn_exp2f(mrun[qt] - mnew);
                        float pv[8];
                        float rs = 0.f;
#pragma unroll
                        for (int kt = 0; kt < 2; ++kt)
#pragma unroll
                            for (int r = 0; r < 4; ++r) { pv[kt * 4 + r] = __builtin_amdgcn_exp2f(st[qt][kt][r] - mnew); rs += pv[kt * 4 + r]; }
                        rs += __shfl_xor(rs, 16);
                        rs += __shfl_xor(rs, 32);
                        lrun[qt] = lrun[qt] * corr + rs;
                        mrun[qt] = mnew;
#pragma unroll
                        for (int mt = 0; mt < 4; ++mt) { oacc[qt][mt][0] *= corr; oacc[qt][mt][1] *= corr; oacc[qt][mt][2] *= corr; oacc[qt][mt][3] *= corr; }
                        uint4 pk;
                        pk.x = pack_bf16(pv[0], pv[1]); pk.y = pack_bf16(pv[2], pv[3]); pk.z = pack_bf16(pv[4], pv[5]); pk.w = pack_bf16(pv[6], pv[7]);
                        pf[qt] = __builtin_bit_cast(bf16x8, pk);
                    }
#pragma unroll
                    for (int mt = 0; mt < 4; ++mt) {
                        const char* vp = vbuf + (mt * 16 + fr) * A_VRS + (kh * 32 + fq * 4) * 2;
                        uint2 lo = *reinterpret_cast<const uint2*>(vp);
                        uint2 hi = *reinterpret_cast<const uint2*>(vp + 32);
                        uint4 vv; vv.x = lo.x; vv.y = lo.y; vv.z = hi.x; vv.w = hi.y;
                        bf16x8 vf = __builtin_bit_cast(bf16x8, vv);
#pragma unroll
                        for (int qt = 0; qt < 2; ++qt) oacc[qt][mt] = __builtin_amdgcn_mfma_f32_16x16x32_bf16(vf, pf[qt], oacc[qt][mt], 0, 0, 0);
                    }
                }
            }
            if (kb + 1 < nkb) A_COMMIT(smem + ((kb + 1) & 1) * A_BUF);
            __syncthreads();
        }
#pragma unroll
        for (int qt = 0; qt < 2; ++qt) {
            const float inv = 1.f / lrun[qt];
            bf16_t* op = p.ob + (tok0 + q0w + qt * 16 + fr) * 512 + h * 64 + fq * 4;
#pragma unroll
            for (int mt = 0; mt < 4; ++mt) {
                uint2 w;
                w.x = pack_bf16(oacc[qt][mt][0] * inv, oacc[qt][mt][1] * inv);
                w.y = pack_bf16(oacc[qt][mt][2] * inv, oacc[qt][mt][3] * inv);
                *reinterpret_cast<uint2*>(op + mt * 16) = w;
            }
        }
    }
}
__device__ __forceinline__ void ph_qlat(const P& p, int layer) {
    const int GX = p.grid;
    const int tid_ = opaque_v((int)threadIdx.x); const int bid_ = opaque_s((int)blockIdx.x); (void)tid_; (void)bid_;
    VB_LOOP(NS * 8) {
        int bs = vb / 8, h = vb % 8;
        int r = tid_;
        const float* qp = p.q + (size_t)(NPT + bs) * 768 + h * 96;
        const float* w = p.w_kvb + (size_t)layer * 256 * 1024 + (size_t)r * 1024 + h * 128;
        float s = 0.f;
        for (int d = 0; d < 64; ++d) s += qp[d] * w[d];
        p.qlat[((size_t)bs * 8 + h) * 256 + r] = s * ATT_SCALE;
    }
}
__device__ __forceinline__ void ph_mix(const P& p, int layer) {
    const int GX = p.grid;
    const int tid_ = opaque_v((int)threadIdx.x); const int bid_ = opaque_s((int)blockIdx.x); (void)tid_; (void)bid_;
    const size_t n = (size_t)NT * DM;
    for (size_t i = (size_t)bid_ * NTHR + tid_; i < n; i += (size_t)GX * NTHR) {
        int t = (int)(i / DM), c = (int)(i % DM);
        float ga = bf2f(p.gab[(size_t)t * 2048 + c]);
        float gb = bf2f(p.gab[(size_t)t * 2048 + 1024 + c]);
        p.mixb[i] = f2bf(ga * p.ya[i] + gb * p.yb[i]);
    }
}

__device__ __forceinline__ float dot2bf(unsigned a, unsigned b, float c) {
    return __builtin_amdgcn_fdot2_f32_bf16(__builtin_bit_cast(bf16x2_t, a), __builtin_bit_cast(bf16x2_t, b), c, false);
}
typedef __attribute__((ext_vector_type(2))) float f32x2;
__device__ __forceinline__ void ph_convert_fp8(const float* src, unsigned char* dst, float* inv, int rows, const float* cscale, const int GX) {
    const int tid = opaque_v((int)threadIdx.x); const int bid = opaque_s((int)blockIdx.x);
    const int wid = tid >> 6, lane = tid & 63;
    for (int r = bid * 4 + wid; r < rows; r += GX * 4) {
        const float4* sp = reinterpret_cast<const float4*>(src + (size_t)r * DM + lane * 16);
        float4 a = sp[0], b = sp[1], c = sp[2], d = sp[3];
        if (cscale) {
            const float4* cp = reinterpret_cast<const float4*>(cscale + (size_t)(r / NEXP) * DM + lane * 16);
            const float4 ca = cp[0], cb = cp[1], cc = cp[2], cd = cp[3];
            a.x *= ca.x; a.y *= ca.y; a.z *= ca.z; a.w *= ca.w; b.x *= cb.x; b.y *= cb.y; b.z *= cb.z; b.w *= cb.w;
            c.x *= cc.x; c.y *= cc.y; c.z *= cc.z; c.w *= cc.w; d.x *= cd.x; d.y *= cd.y; d.z *= cd.z; d.w *= cd.w;
        }
        float mx = fmaxf(fmaxf(fmaxf(fabsf(a.x), fabsf(a.y)), fmaxf(fabsf(a.z), fabsf(a.w))), fmaxf(fmaxf(fabsf(b.x), fabsf(b.y)), fmaxf(fabsf(b.z), fabsf(b.w))));
        mx = fmaxf(mx, fmaxf(fmaxf(fmaxf(fabsf(c.x), fabsf(c.y)), fmaxf(fabsf(c.z), fabsf(c.w))), fmaxf(fmaxf(fabsf(d.x), fabsf(d.y)), fmaxf(fabsf(d.z), fabsf(d.w)))));
        mx = fmaxf(wave_max(mx), 1e-30f);
        const float sc = 224.f / mx;
        uint4 o; int w;
        w = 0; w = __builtin_amdgcn_cvt_pk_fp8_f32(a.x * sc, a.y * sc, w, false); w = __builtin_amdgcn_cvt_pk_fp8_f32(a.z * sc, a.w * sc, w, true); o.x = (unsigned)w;
        w = 0; w = __builtin_amdgcn_cvt_pk_fp8_f32(b.x * sc, b.y * sc, w, false); w = __builtin_amdgcn_cvt_pk_fp8_f32(b.z * sc, b.w * sc, w, true); o.y = (unsigned)w;
        w = 0; w = __builtin_amdgcn_cvt_pk_fp8_f32(c.x * sc, c.y * sc, w, false); w = __builtin_amdgcn_cvt_pk_fp8_f32(c.z * sc, c.w * sc, w, true); o.z = (unsigned)w;
        w = 0; w = __builtin_amdgcn_cvt_pk_fp8_f32(d.x * sc, d.y * sc, w, false); w = __builtin_amdgcn_cvt_pk_fp8_f32(d.z * sc, d.w * sc, w, true); o.w = (unsigned)w;
        *reinterpret_cast<uint4*>(dst + (size_t)r * DM + lane * 16) = o;
        if (lane == 0) inv[r] = mx / 224.f;
    }
}
#define FP8_UNPACK16(v_, f_) do { \
    f32x2 t_; \
    t_ = __builtin_amdgcn_cvt_pk_f32_fp8((int)(v_).x, false); f_[0] = t_[0]; f_[1] = t_[1]; t_ = __builtin_amdgcn_cvt_pk_f32_fp8((int)(v_).x, true); f_[2] = t_[0]; f_[3] = t_[1]; \
    t_ = __builtin_amdgcn_cvt_pk_f32_fp8((int)(v_).y, false); f_[4] = t_[0]; f_[5] = t_[1]; t_ = __builtin_amdgcn_cvt_pk_f32_fp8((int)(v_).y, true); f_[6] = t_[0]; f_[7] = t_[1]; \
    t_ = __builtin_amdgcn_cvt_pk_f32_fp8((int)(v_).z, false); f_[8] = t_[0]; f_[9] = t_[1]; t_ = __builtin_amdgcn_cvt_pk_f32_fp8((int)(v_).z, true); f_[10] = t_[0]; f_[11] = t_[1]; \
    t_ = __builtin_amdgcn_cvt_pk_f32_fp8((int)(v_).w, false); f_[12] = t_[0]; f_[13] = t_[1]; t_ = __builtin_amdgcn_cvt_pk_f32_fp8((int)(v_).w, true); f_[14] = t_[0]; f_[15] = t_[1]; \
} while (0)
__device__ __forceinline__ void ph_peer_experts3(const P& p, int layer, bool dry = false) {
    const int GX = p.grid;
    const int tid = opaque_v((int)threadIdx.x); const int bid = opaque_s((int)blockIdx.x);
    const int wid = tid >> 6, lane = tid & 63;
    const unsigned char* U = p.u8 + (size_t)layer * NEXP * DM;
    const unsigned char* V = p.v8 + (size_t)layer * NEXP * DM;
    const float* IU = p.uinv + (size_t)layer * NEXP;
    const float* IV = p.vinv + (size_t)layer * NEXP;
    for (int t = bid * 4 + wid; t < NT; t += GX * 4) {
        float hx[16];
        {
            const uint4* hrow = reinterpret_cast<const uint4*>(p.xb + (size_t)t * DM + lane * 16);
            const uint4 h0 = hrow[0], h1 = hrow[1];
            hx[0] = bflo(h0.x); hx[1] = bfhi(h0.x); hx[2] = bflo(h0.y); hx[3] = bfhi(h0.y); hx[4] = bflo(h0.z); hx[5] = bfhi(h0.z); hx[6] = bflo(h0.w); hx[7] = bfhi(h0.w);
            hx[8] = bflo(h1.x); hx[9] = bfhi(h1.x); hx[10] = bflo(h1.y); hx[11] = bfhi(h1.y); hx[12] = bflo(h1.z); hx[13] = bfhi(h1.z); hx[14] = bflo(h1.w); hx[15] = bfhi(h1.w);
        }
        const int i0 = p.idx[(size_t)t * 128 + lane], i1 = p.idx[(size_t)t * 128 + 64 + lane];
        const float g0 = p.gate[(size_t)t * 128 + lane], g1 = p.gate[(size_t)t * 128 + 64 + lane];
        const float rs1 = rsqrtf(p.sumsq1[(size_t)layer * TP + t] * (1.f / DM) + EPSF);
        const float su0 = IU[i0] * rs1, su1 = IU[i1] * rs1;
        float w0 = 0.f, w1 = 0.f;
        uint4 nx[4];
#pragma unroll
        for (int j = 0; j < 4; ++j) nx[j] = *reinterpret_cast<const uint4*>(U + (size_t)__builtin_amdgcn_readlane(i0, j) * DM + lane * 16);
#pragma unroll 1
        for (int kk = 0; kk < 128; kk += 4) {
            uint4 cu[4];
#pragma unroll
            for (int j = 0; j < 4; ++j) cu[j] = nx[j];
            if (kk + 4 < 128) {
                const int ivn = (kk + 4 < 64) ? i0 : i1;
#pragma unroll
                for (int j = 0; j < 4; ++j) nx[j] = *reinterpret_cast<const uint4*>(U + (size_t)__builtin_amdgcn_readlane(ivn, (kk + 4 + j) & 63) * DM + lane * 16);
            }
            float sd[4];
#pragma unroll
            for (int j = 0; j < 4; ++j) {
                float f[16];
                FP8_UNPACK16(cu[j], f);
                float a = 0.f;
#pragma unroll
                for (int i = 0; i < 16; ++i) a += f[i] * hx[i];
                sd[j] = a;
            }
#pragma unroll
            for (int o = 32; o > 0; o >>= 1) {
#pragma unroll
                for (int j = 0; j < 4; ++j) sd[j] += __shfl_xor(sd[j], o);
            }
#pragma unroll
            for (int j = 0; j < 4; ++j) {
                if (lane == ((kk + j) & 63)) {
                    const float x = sd[j] * ((kk < 64) ? su0 : su1);
                    const float act = 0.5f * x * (1.f + erff(x * 0.70710678118654752f));
                    if (kk < 64) w0 = g0 * act; else w1 = g1 * act;
                }
            }
        }
        w0 *= IV[i0]; w1 *= IV[i1];
        float acc[16];
#pragma unroll
        for (int i = 0; i < 16; ++i) acc[i] = 0.f;
#pragma unroll
        for (int j = 0; j < 4; ++j) nx[j] = *reinterpret_cast<const uint4*>(V + (size_t)__builtin_amdgcn_readlane(i0, j) * DM + lane * 16);
#pragma unroll 1
        for (int kk = 0; kk < 128; kk += 4) {
            uint4 cu[4];
#pragma unroll
            for (int j = 0; j < 4; ++j) cu[j] = nx[j];
            if (kk + 4 < 128) {
                const int ivn = (kk + 4 < 64) ? i0 : i1;
#pragma unroll
                for (int j = 0; j < 4; ++j) nx[j] = *reinterpret_cast<const uint4*>(V + (size_t)__builtin_amdgcn_readlane(ivn, (kk + 4 + j) & 63) * DM + lane * 16);
            }
            const float wv = (kk < 64) ? w0 : w1;
#pragma unroll
            for (int j = 0; j < 4; ++j) {
                const float w = __builtin_bit_cast(float, __builtin_amdgcn_readlane(__builtin_bit_cast(int, wv), (kk + j) & 63));
                float f[16];
                FP8_UNPACK16(cu[j], f);
#pragma unroll
                for (int i = 0; i < 16; ++i) acc[i] += w * f[i];
            }
        }
        float4* xp = reinterpret_cast<float4*>(p.xres + (size_t)t * DM + lane * 16);
        float4 xv[4]; float ss = 0.f;
#pragma unroll
        for (int q4 = 0; q4 < 4; ++q4) {
            float4 x = xp[q4];
            x.x += acc[q4 * 4 + 0]; x.y += acc[q4 * 4 + 1]; x.z += acc[q4 * 4 + 2]; x.w += acc[q4 * 4 + 3];
            xv[q4] = x; ss += x.x * x.x + x.y * x.y + x.z * x.z + x.w * x.w;
        }
        ss = wave_sum(ss);
        const float rs2 = rsqrtf(ss * (1.f / DM) + EPSF);
        if (dry) { if (rs2 == 123.456f) p.rstd[t] = rs2; }
        else if (layer + 1 < DEPTH) {
#pragma unroll
            for (int q4 = 0; q4 < 4; ++q4) xp[q4] = xv[q4];
            uint4 b0, b1;
            b0.x = pack_bf16(xv[0].x, xv[0].y); b0.y = pack_bf16(xv[0].z, xv[0].w); b0.z = pack_bf16(xv[1].x, xv[1].y); b0.w = pack_bf16(xv[1].z, xv[1].w);
            b1.x = pack_bf16(xv[2].x, xv[2].y); b1.y = pack_bf16(xv[2].z, xv[2].w); b1.z = pack_bf16(xv[3].x, xv[3].y); b1.w = pack_bf16(xv[3].z, xv[3].w);
            uint4* bp = reinterpret_cast<uint4*>(p.xb + (size_t)t * DM + lane * 16);
            bp[0] = b0; bp[1] = b1;
            if (lane == 0) p.rstd[t] = rs2;
        } else {
            const float4* np = reinterpret_cast<const float4*>(p.norm_final + lane * 16);
            float4* op = reinterpret_cast<float4*>(p.out + O_YP + (size_t)t * DM + lane * 16);
#pragma unroll
            for (int q4 = 0; q4 < 4; ++q4) {
                const float4 g = np[q4];
                float4 y; y.x = xv[q4].x * rs2 * g.x; y.y = xv[q4].y * rs2 * g.y; y.z = xv[q4].z * rs2 * g.z; y.w = xv[q4].w * rs2 * g.w;
                op[q4] = y;
            }
        }
    }
}

typedef __attribute__((ext_vector_type(4))) short s16x4;
#define S_XS 160
#define S_BS 288
#define S_HS 272
#define S_XR 0
#define S_BR (128 * S_XS)
#define S_HL (128 * S_XS + 128 * S_BS)
#define S_ACS (128 * S_XS + 128 * S_BS + 64 * S_HS)
#define S_DTL (S_ACS + 512)
#define S_WL (S_DTL + 512)
typedef __attribute__((address_space(3))) s16x4* lds_tr_ptr;
__device__ __forceinline__ bf16x8 tr_pair(const char* a0, const char* a1) {
    const s16x4 lo = __builtin_amdgcn_ds_read_tr16_b64_v4i16((lds_tr_ptr)a0);
    const s16x4 hi = __builtin_amdgcn_ds_read_tr16_b64_v4i16((lds_tr_ptr)a1);
    bf16x8 r; r[0] = lo[0]; r[1] = lo[1]; r[2] = lo[2]; r[3] = lo[3]; r[4] = hi[0]; r[5] = hi[1]; r[6] = hi[2]; r[7] = hi[3];
    return r;
}
__device__ __forceinline__ void ph_ssd_chunk(const P& p, int layer, char* smem) {
    const int GX = p.grid;
    const int tid = opaque_v((int)threadIdx.x); const int bid = opaque_s((int)blockIdx.x);
    const int wid = tid >> 6, lane = tid & 63, fr = lane & 15, fq = lane >> 4;
    float* acs = reinterpret_cast<float*>(smem + S_ACS);
    float* dtl = reinterpret_cast<float*>(smem + S_DTL);
    float* wl = reinterpret_cast<float*>(smem + S_WL);
    const int trr = fr >> 2, trc = (fr & 3) * 8;
    for (int u = bid; u < NB * 16; u += GX) {
        const int b = u >> 4, e = u & 15, g = e >> 3;
        const float A = -__expf(p.a_log[layer * 16 + e]);
        const float Dk = p.d_skip[layer * 16 + e];
        f32x4 hT[2][4];
#pragma unroll
        for (int i = 0; i < 2; ++i)
#pragma unroll
            for (int pt = 0; pt < 4; ++pt) hT[i][pt] = f32x4{0.f, 0.f, 0.f, 0.f};
#pragma unroll 1
        for (int c = 0; c < 16; ++c) {
            const size_t t0 = (size_t)b * SEQ + c * 128;
            if (wid == 0) {
                const float d0 = p.dt[(t0 + lane) * 16 + e], d1 = p.dt[(t0 + 64 + lane) * 16 + e];
                float s0 = d0 * A, s1 = d1 * A;
#pragma unroll
                for (int o = 1; o < 64; o <<= 1) {
                    float t0s = __shfl_up(s0, o), t1s = __shfl_up(s1, o);
                    if (lane >= o) { s0 += t0s; s1 += t1s; }
                }
                s1 += __shfl(s0, 63);
                const float aend = __shfl(s1, 63);
                acs[lane] = s0; acs[64 + lane] = s1; dtl[lane] = d0; dtl[64 + lane] = d1;
                wl[lane] = d0 * __expf(aend - s0); wl[64 + lane] = d1 * __expf(aend - s1);
            }
#pragma unroll
            for (int i = 0; i < 4; ++i) {
                const int id = tid + 256 * i, l = id >> 3, pc = id & 7;
                *reinterpret_cast<uint4*>(smem + S_XR + l * S_XS + pc * 16) = *reinterpret_cast<const uint4*>(p.xbcb + (t0 + l) * CONVD + e * 64 + pc * 8);
            }
#pragma unroll
            for (int i = 0; i < 8; ++i) {
                const int id = tid + 256 * i, l = id >> 4, nc = id & 15;
                *reinterpret_cast<uint4*>(smem + S_BR + l * S_BS + nc * 16) = *reinterpret_cast<const uint4*>(p.xbcb + (t0 + l) * CONVD + 1024 + g * 128 + nc * 8);
            }
#pragma unroll
            for (int i = 0; i < 2; ++i)
#pragma unroll
                for (int pt = 0; pt < 4; ++pt) {
                    uint2 w2;
                    w2.x = pack_bf16(hT[i][pt][0], hT[i][pt][1]); w2.y = pack_bf16(hT[i][pt][2], hT[i][pt][3]);
                    *reinterpret_cast<uint2*>(smem + S_HL + (pt * 16 + fr) * S_HS + (wid * 32 + i * 16 + fq * 4) * 2) = w2;
                }
            bf16x8 cf[2][4];
#pragma unroll
            for (int j = 0; j < 2; ++j)
#pragma unroll
                for (int k = 0; k < 4; ++k)
                    cf[j][k] = *reinterpret_cast<const bf16x8*>(p.xbcb + (t0 + wid * 32 + j * 16 + fr) * CONVD + 1280 + g * 128 + k * 32 + fq * 8);
            __syncthreads();
            f32x4 acc[4][2];
#pragma unroll
            for (int pt = 0; pt < 4; ++pt)
#pragma unroll
                for (int j = 0; j < 2; ++j) acc[pt][j] = f32x4{0.f, 0.f, 0.f, 0.f};
#pragma unroll
            for (int pt = 0; pt < 4; ++pt)
#pragma unroll
                for (int k = 0; k < 4; ++k) {
                    const bf16x8 hf = *reinterpret_cast<const bf16x8*>(smem + S_HL + (pt * 16 + fr) * S_HS + (k * 32 + fq * 8) * 2);
#pragma unroll
                    for (int j = 0; j < 2; ++j) acc[pt][j] = __builtin_amdgcn_mfma_f32_16x16x32_bf16(hf, cf[j][k], acc[pt][j], 0, 0, 0);
                }
            float alv[2];
#pragma unroll
            for (int j = 0; j < 2; ++j) {
                alv[j] = acs[wid * 32 + j * 16 + fr];
                const float el = __expf(alv[j]);
#pragma unroll
                for (int pt = 0; pt < 4; ++pt) { acc[pt][j][0] *= el; acc[pt][j][1] *= el; acc[pt][j][2] *= el; acc[pt][j][3] *= el; }
            }
#pragma unroll 1
            for (int ii = 0; ii <= wid; ++ii) {
                f32x4 cb[2][2];
#pragma unroll
                for (int si = 0; si < 2; ++si)
#pragma unroll
                    for (int j = 0; j < 2; ++j) cb[si][j] = f32x4{0.f, 0.f, 0.f, 0.f};
#pragma unroll
                for (int k = 0; k < 4; ++k)
#pragma unroll
                    for (int si = 0; si < 2; ++si) {
                        const bf16x8 bfr = *reinterpret_cast<const bf16x8*>(smem + S_BR + (ii * 32 + si * 16 + fr) * S_BS + (k * 32 + fq * 8) * 2);
#pragma unroll
                        for (int j = 0; j < 2; ++j) cb[si][j] = __builtin_amdgcn_mfma_f32_16x16x32_bf16(bfr, cf[j][k], cb[si][j], 0, 0, 0);
                    }
                bf16x8 mf[2];
                {
                    float as8[8], ds8[8];
#pragma unroll
                    for (int si = 0; si < 2; ++si) {
                        const float4 a4 = *reinterpret_cast<const float4*>(acs + ii * 32 + si * 16 + fq * 4);
                        const float4 d4 = *reinterpret_cast<const float4*>(dtl + ii * 32 + si * 16 + fq * 4);
                        as8[si * 4 + 0] = a4.x; as8[si * 4 + 1] = a4.y; as8[si * 4 + 2] = a4.z; as8[si * 4 + 3] = a4.w;
                        ds8[si * 4 + 0] = d4.x; ds8[si * 4 + 1] = d4.y; ds8[si * 4 + 2] = d4.z; ds8[si * 4 + 3] = d4.w;
                    }
#pragma unroll
                    for (int j = 0; j < 2; ++j) {
                        const int lidx = wid * 32 + j * 16 + fr;
                        float mv[8];
#pragma unroll
                        for (int si = 0; si < 2; ++si)
#pragma unroll
                            for (int r = 0; r < 4; ++r) {
                                const int sidx = ii * 32 + si * 16 + fq * 4 + r;
                                const float dec = __expf(fminf(alv[j] - as8[si * 4 + r], 0.f)) * ds8[si * 4 + r];
                                mv[si * 4 + r] = (lidx >= sidx) ? cb[si][j][r] * dec : 0.f;
                            }
                        uint4 pk;
                        pk.x = pack_bf16(mv[0], mv[1]); pk.y = pack_bf16(mv[2], mv[3]); pk.z = pack_bf16(mv[4], mv[5]); pk.w = pack_bf16(mv[6], mv[7]);
                        mf[j] = __builtin_bit_cast(bf16x8, pk);
                    }
                }
#pragma unroll
                for (int pt = 0; pt < 4; ++pt) {
                    const char* xa = smem + S_XR + (ii * 32 + fq * 4 + trr) * S_XS + pt * 32 + trc;
                    const bf16x8 xf = tr_pair(xa, xa + 16 * S_XS);
#pragma unroll
                    for (int j = 0; j < 2; ++j) acc[pt][j] = __builtin_amdgcn_mfma_f32_16x16x32_bf16(xf, mf[j], acc[pt][j], 0, 0, 0);
                }
            }
#pragma unroll
            for (int j = 0; j < 2; ++j) {
                const int ll = wid * 32 + j * 16 + fr;
                const size_t tl = t0 + ll;
#pragma unroll
                for (int pt = 0; pt < 4; ++pt) {
                    const uint2 xx = *reinterpret_cast<const uint2*>(smem + S_XR + ll * S_XS + (pt * 16 + fq * 4) * 2);
                    float4 y;
                    y.x = acc[pt][j][0] + Dk * bflo(xx.x); y.y = acc[pt][j][1] + Dk * bfhi(xx.x);
                    y.z = acc[pt][j][2] + Dk * bflo(xx.y); y.w = acc[pt][j][3] + Dk * bfhi(xx.y);
                    *reinterpret_cast<float4*>(p.yraw + tl * DM + e * 64 + pt * 16 + fq * 4) = y;
                }
            }
            {
                const float dec = __expf(acs[127]);
#pragma unroll
                for (int i = 0; i < 2; ++i)
#pragma unroll
                    for (int pt = 0; pt < 4; ++pt) { hT[i][pt][0] *= dec; hT[i][pt][1] *= dec; hT[i][pt][2] *= dec; hT[i][pt][3] *= dec; }
            }
#pragma unroll
            for (int k = 0; k < 4; ++k) {
                const float4 w0 = *reinterpret_cast<const float4*>(wl + k * 32 + fq * 8);
                const float4 w1 = *reinterpret_cast<const float4*>(wl + k * 32 + fq * 8 + 4);
                bf16x8 bt[2];
#pragma unroll
                for (int i = 0; i < 2; ++i) {
                    const char* ba = smem + S_BR + (k * 32 + fq * 8 + trr) * S_BS + (wid * 32 + i * 16) * 2 + trc;
                    bt[i] = tr_pair(ba, ba + 4 * S_BS);
                }
#pragma unroll
                for (int pt = 0; pt < 4; ++pt) {
                    const char* xa = smem + S_XR + (k * 32 + fq * 8 + trr) * S_XS + pt * 32 + trc;
                    const uint4 xr = __builtin_bit_cast(uint4, tr_pair(xa, xa + 4 * S_XS));
                    uint4 xs;
                    xs.x = pack_bf16(bflo(xr.x) * w0.x, bfhi(xr.x) * w0.y); xs.y = pack_bf16(bflo(xr.y) * w0.z, bfhi(xr.y) * w0.w);
                    xs.z = pack_bf16(bflo(xr.z) * w1.x, bfhi(xr.z) * w1.y); xs.w = pack_bf16(bflo(xr.w) * w1.z, bfhi(xr.w) * w1.w);
                    const bf16x8 xsf = __builtin_bit_cast(bf16x8, xs);
#pragma unroll
                    for (int i = 0; i < 2; ++i) hT[i][pt] = __builtin_amdgcn_mfma_f32_16x16x32_bf16(bt[i], xsf, hT[i][pt], 0, 0, 0);
                }
            }
            __syncthreads();
        }
#pragma unroll
        for (int i = 0; i < 2; ++i)
#pragma unroll
            for (int pt = 0; pt < 4; ++pt) {
                float4 hv; hv.x = hT[i][pt][0]; hv.y = hT[i][pt][1]; hv.z = hT[i][pt][2]; hv.w = hT[i][pt][3];
                *reinterpret_cast<float4*>(p.out + O_SSMP + (((size_t)(layer * NB + b) * 16 + e) * 64 + pt * 16 + fr) * 128 + wid * 32 + i * 16 + fq * 4) = hv;
            }
    }
}

__device__ __forceinline__ int med3i(int a, int b, int c) { return max(min(a, b), min(max(a, b), c)); }
__device__ __forceinline__ int okey(float v) { int o = __float_as_int(v); return o ^ ((o >> 31) & 0x7fffffff); }
__device__ __forceinline__ float okey_inv(int o) { return __int_as_float(o ^ ((o >> 31) & 0x7fffffff)); }
#define TK_INSERT(L_, key_) do { const int k_ = (key_); \
    L_[15] = med3i(L_[14], L_[15], k_); L_[14] = med3i(L_[13], L_[14], k_); L_[13] = med3i(L_[12], L_[13], k_); L_[12] = med3i(L_[11], L_[12], k_); \
    L_[11] = med3i(L_[10], L_[11], k_); L_[10] = med3i(L_[9], L_[10], k_); L_[9] = med3i(L_[8], L_[9], k_); L_[8] = med3i(L_[7], L_[8], k_); \
    L_[7] = med3i(L_[6], L_[7], k_); L_[6] = med3i(L_[5], L_[6], k_); L_[5] = med3i(L_[4], L_[5], k_); L_[4] = med3i(L_[3], L_[4], k_); \
    L_[3] = med3i(L_[2], L_[3], k_); L_[2] = med3i(L_[1], L_[2], k_); L_[1] = med3i(L_[0], L_[1], k_); L_[0] = max(L_[0], k_); } while (0)
#define TK_INS2(a_, b_) do { const float sv_ = V1[a_] + V2[b_]; TK_INSERT(M, (okey(sv_) & ~255) | (255 - ((a_) * 16 + (b_)))); } while (0)
__device__ __forceinline__ void ph_peer_topk2(const P& p) {
    const int GX = p.grid;
    const int tid = opaque_v((int)threadIdx.x); const int bid = opaque_s((int)blockIdx.x);
    for (int pr = bid * NTHR + tid; pr < NT * 8; pr += GX * NTHR) {
        const int t = pr >> 3, h = pr & 7;
        int L1[16], L2[16], M[16];
#pragma unroll
        for (int i = 0; i < 16; ++i) { L1[i] = (int)0x80000000; L2[i] = (int)0x80000000; M[i] = (int)0x80000000; }
        const float4* sp = reinterpret_cast<const float4*>(p.sc + (size_t)t * 2048 + h * 256);
#pragma unroll 2
        for (int k4 = 0; k4 < 32; ++k4) {
            const float4 v = sp[k4];
            const int kb = 127 - k4 * 4;
            TK_INSERT(L1, (okey(v.x) & ~127) | (kb - 0));
            TK_INSERT(L1, (okey(v.y) & ~127) | (kb - 1));
            TK_INSERT(L1, (okey(v.z) & ~127) | (kb - 2));
            TK_INSERT(L1, (okey(v.w) & ~127) | (kb - 3));
        }
#pragma unroll 2
        for (int k4 = 0; k4 < 32; ++k4) {
            const float4 v = sp[32 + k4];
            const int kb = 127 - k4 * 4;
            TK_INSERT(L2, (okey(v.x) & ~127) | (kb - 0));
            TK_INSERT(L2, (okey(v.y) & ~127) | (kb - 1));
            TK_INSERT(L2, (okey(v.z) & ~127) | (kb - 2));
            TK_INSERT(L2, (okey(v.w) & ~127) | (kb - 3));
        }
        float V1[16], V2[16];
#pragma unroll
        for (int i = 0; i < 16; ++i) { V1[i] = okey_inv(L1[i] & ~127); V2[i] = okey_inv(L2[i] & ~127); }
        TK_INS2(0, 0);
        TK_INS2(0, 1);
        TK_INS2(0, 2);
        TK_INS2(0, 3);
        TK_INS2(0, 4);
        TK_INS2(0, 5);
        TK_INS2(0, 6);
        TK_INS2(0, 7);
        TK_INS2(0, 8);
        TK_INS2(0, 9);
        TK_INS2(0, 10);
        TK_INS2(0, 11);
        TK_INS2(0, 12);
        TK_INS2(0, 13);
        TK_INS2(0, 14);
        TK_INS2(0, 15);
        TK_INS2(1, 0);
        TK_INS2(1, 1);
        TK_INS2(1, 2);
        TK_INS2(1, 3);
        TK_INS2(1, 4);
        TK_INS2(1, 5);
        TK_INS2(1, 6);
        TK_INS2(1, 7);
        TK_INS2(2, 0);
        TK_INS2(2, 1);
        TK_INS2(2, 2);
        TK_INS2(2, 3);
        TK_INS2(2, 4);
        TK_INS2(3, 0);
        TK_INS2(3, 1);
        TK_INS2(3, 2);
        TK_INS2(3, 3);
        TK_INS2(4, 0);
        TK_INS2(4, 1);
        TK_INS2(4, 2);
        TK_INS2(5, 0);
        TK_INS2(5, 1);
        TK_INS2(6, 0);
        TK_INS2(6, 1);
        TK_INS2(7, 0);
        TK_INS2(7, 1);
        TK_INS2(8, 0);
        TK_INS2(9, 0);
        TK_INS2(10, 0);
        TK_INS2(11, 0);
        TK_INS2(12, 0);
        TK_INS2(13, 0);
        TK_INS2(14, 0);
        TK_INS2(15, 0);
        float sv[16];
        int ex[16];
#pragma unroll
        for (int j = 0; j < 16; ++j) {
            const int c = 255 - (M[j] & 255);
            const int a = c >> 4, b = c & 15;
            int ka = L1[0], kb2 = L2[0];
            float va = V1[0], vb = V2[0];
#pragma unroll
            for (int i = 1; i < 16; ++i) {
                if (a == i) { ka = L1[i]; va = V1[i]; }
                if (b == i) { kb2 = L2[i]; vb = V2[i]; }
            }
            sv[j] = va + vb;
            ex[j] = (127 - (ka & 127)) * 128 + (127 - (kb2 & 127));
        }
        float sum = 0.f;
        float ev[16];
#pragma unroll
        for (int j = 0; j < 16; ++j) { ev[j] = __expf(sv[j] - sv[0]); sum += ev[j]; }
        const float inv = 1.f / sum;
        int* ip = p.idx + (size_t)t * 128 + h * 16;
        float* gp = p.gate + (size_t)t * 128 + h * 16;
#pragma unroll
        for (int j4 = 0; j4 < 4; ++j4) {
            *reinterpret_cast<int4*>(ip + j4 * 4) = make_int4(ex[j4 * 4], ex[j4 * 4 + 1], ex[j4 * 4 + 2], ex[j4 * 4 + 3]);
            *reinterpret_cast<float4*>(gp + j4 * 4) = make_float4(ev[j4 * 4] * inv, ev[j4 * 4 + 1] * inv, ev[j4 * 4 + 2] * inv, ev[j4 * 4 + 3] * inv);
        }
    }
}


#define D_RS 544
#define D_NCH 16
__device__ __forceinline__ uint4 pack8(const float4 a, const float4 b, float sc) {
    uint4 r; r.x = pack_bf16(a.x * sc, a.y * sc); r.y = pack_bf16(a.z * sc, a.w * sc); r.z = pack_bf16(b.x * sc, b.y * sc); r.w = pack_bf16(b.z * sc, b.w * sc); return r;
}
__device__ __forceinline__ void decode_unit(const P& p, int layer, char* smem, int u, int tid) {
    const int wid = tid >> 6, lane = tid & 63, fr = lane & 15, fq = lane >> 4;
    char* vbuf = smem + wid * (16 * D_RS);
    const float L2E = 1.4426950408889634f;
    {
        const int bs = u / D_NCH, ch = u % D_NCH;
        float* qls_f = reinterpret_cast<float*>(smem + 4 * 16 * D_RS + 9 * 64 * 16);
        {
            const float* wr = p.w_kvb + (size_t)layer * 256 * 1024 + (size_t)tid * 1024;
            const float* qrow = p.q + (size_t)(NPT + bs) * 768;
#pragma unroll 1
            for (int h = 0; h < 8; ++h) {
                float a = 0.f;
#pragma unroll
                for (int d4 = 0; d4 < 16; ++d4) {
                    const float4 w4 = *reinterpret_cast<const float4*>(wr + h * 128 + d4 * 4);
                    const float4 q4 = *reinterpret_cast<const float4*>(qrow + h * 96 + d4 * 4);
                    a += w4.x * q4.x + w4.y * q4.y + w4.z * q4.z + w4.w * q4.w;
                }
                qls_f[h * 256 + tid] = a * ATT_SCALE;
            }
        }
        __syncthreads();
        char* qls = smem + 4 * 16 * D_RS;
        {
            const int hh = fr & 7;
            const float zf = (fr < 8) ? 1.f : 0.f;
            const float* ql = qls_f + hh * 256 + fq * 8;
            const float* qr = p.q + (size_t)(NPT + bs) * 768 + hh * 96 + 64 + fq * 8;
#pragma unroll
            for (int j = 0; j < 3; ++j) {
                const int s9 = wid + 4 * j;
                if (s9 < 8) {
                    const float4 a = *reinterpret_cast<const float4*>(ql + s9 * 32), b = *reinterpret_cast<const float4*>(ql + s9 * 32 + 4);
                    *reinterpret_cast<uint4*>(qls + (s9 * 64 + lane) * 16) = pack8(a, b, L2E * zf);
                } else if (s9 == 8) {
                    const float4 a = *reinterpret_cast<const float4*>(qr), b = *reinterpret_cast<const float4*>(qr + 4);
                    *reinterpret_cast<uint4*>(qls + (s9 * 64 + lane) * 16) = pack8(a, b, ATT_SCALE * L2E * zf);
                }
            }
        }
        __syncthreads();
        f32x4 oacc[16];
#pragma unroll
        for (int dt = 0; dt < 16; ++dt) oacc[dt] = f32x4{0.f, 0.f, 0.f, 0.f};
        float mrun = -INFINITY, lrun = 0.f;
#pragma unroll 1
        for (int it = 0; it < 16; ++it) {
            const int ti = wid + 4 * it;
            const int pg = p.page_table[bs * NPAGES + ch * 8 + (ti >> 3)];
            const size_t krow = ((size_t)layer * NPOOL + pg) * PAGE + (ti & 7) * 16 + fr;
            const float* lp = p.cache_lat + krow * KVL + fq * 8;
            const float* rp = p.cache_kr + krow * 32 + fq * 8;
            bf16x8 kf[9];
            {
                float4 raw[10];
#pragma unroll
                for (int s9 = 0; s9 < 5; ++s9) { raw[2 * s9] = *reinterpret_cast<const float4*>(lp + s9 * 32); raw[2 * s9 + 1] = *reinterpret_cast<const float4*>(lp + s9 * 32 + 4); }
#pragma unroll
                for (int s9 = 0; s9 < 5; ++s9) kf[s9] = __builtin_bit_cast(bf16x8, pack8(raw[2 * s9], raw[2 * s9 + 1], 1.f));
            }
            {
                float4 raw[8];
#pragma unroll
                for (int s9 = 0; s9 < 3; ++s9) { raw[2 * s9] = *reinterpret_cast<const float4*>(lp + (5 + s9) * 32); raw[2 * s9 + 1] = *reinterpret_cast<const float4*>(lp + (5 + s9) * 32 + 4); }
                raw[6] = *reinterpret_cast<const float4*>(rp); raw[7] = *reinterpret_cast<const float4*>(rp + 4);
#pragma unroll
                for (int s9 = 0; s9 < 4; ++s9) kf[5 + s9] = __builtin_bit_cast(bf16x8, pack8(raw[2 * s9], raw[2 * s9 + 1], 1.f));
            }
            f32x4 st = f32x4{0.f, 0.f, 0.f, 0.f};
#pragma unroll
            for (int s9 = 0; s9 < 9; ++s9) st = __builtin_amdgcn_mfma_f32_16x16x32_bf16(kf[s9], *reinterpret_cast<const bf16x8*>(qls + (s9 * 64 + lane) * 16), st, 0, 0, 0);
#pragma unroll
            for (int s9 = 0; s9 < 8; ++s9) *reinterpret_cast<bf16x8*>(vbuf + fr * D_RS + (s9 * 32 + fq * 8) * 2) = kf[s9];
            float mx = fmaxf(fmaxf(st[0], st[1]), fmaxf(st[2], st[3]));
            mx = fmaxf(mx, __shfl_xor(mx, 16));
            mx = fmaxf(mx, __shfl_xor(mx, 32));
            const float mnew = fmaxf(mrun, mx);
            const float corr = __builtin_amdgcn_exp2f(mrun - mnew);
            const float p0 = __builtin_amdgcn_exp2f(st[0] - mnew), p1 = __builtin_amdgcn_exp2f(st[1] - mnew);
            const float p2 = __builtin_amdgcn_exp2f(st[2] - mnew), p3 = __builtin_amdgcn_exp2f(st[3] - mnew);
            float rs = (p0 + p1) + (p2 + p3);
            rs += __shfl_xor(rs, 16);
            rs += __shfl_xor(rs, 32);
            lrun = lrun * corr + rs;
            mrun = mnew;
#pragma unroll
            for (int dt = 0; dt < 16; ++dt) { oacc[dt][0] *= corr; oacc[dt][1] *= corr; oacc[dt][2] *= corr; oacc[dt][3] *= corr; }
            uint4 pk; pk.x = pack_bf16(p0, p1); pk.y = pack_bf16(p2, p3); pk.z = 0u; pk.w = 0u;
            const bf16x8 pf = __builtin_bit_cast(bf16x8, pk);
            const char* tb = vbuf + (fq * 4 + (fr >> 2)) * D_RS + (fr & 3) * 8;
#pragma unroll
            for (int dt = 0; dt < 16; ++dt) {
                const s16x4 lo = __builtin_amdgcn_ds_read_tr16_b64_v4i16((__attribute__((address_space(3))) s16x4*)(tb + dt * 32));
                bf16x8 vf; vf[0] = lo[0]; vf[1] = lo[1]; vf[2] = lo[2]; vf[3] = lo[3]; vf[4] = 0; vf[5] = 0; vf[6] = 0; vf[7] = 0;
                oacc[dt] = __builtin_amdgcn_mfma_f32_16x16x32_bf16(vf, pf, oacc[dt], 0, 0, 0);
            }
        }
        __syncthreads();
        float* wm = reinterpret_cast<float*>(smem + 65536);
        float* wl = wm + 64;
        float* ob = reinterpret_cast<float*>(smem);
        if (fq == 0) { wm[wid * 16 + fr] = mrun; wl[wid * 16 + fr] = lrun; }
        if (fr < 8) {
#pragma unroll
            for (int dt = 0; dt < 16; ++dt) {
                float4 v; v.x = oacc[dt][0]; v.y = oacc[dt][1]; v.z = oacc[dt][2]; v.w = oacc[dt][3];
                *reinterpret_cast<float4*>(ob + ((size_t)wid * 8 + fr) * 256 + dt * 16 + fq * 4) = v;
            }
        }
        __syncthreads();
        {
            float* pp = p.part + ((size_t)bs * D_NCH + ch) * 8 * 258;
#pragma unroll
            for (int h = 0; h < 8; ++h) {
                const float m0 = wm[h], m1 = wm[16 + h], m2 = wm[32 + h], m3 = wm[48 + h];
                const float M = fmaxf(fmaxf(m0, m1), fmaxf(m2, m3));
                const float e0 = __builtin_amdgcn_exp2f(m0 - M), e1 = __builtin_amdgcn_exp2f(m1 - M), e2 = __builtin_amdgcn_exp2f(m2 - M), e3 = __builtin_amdgcn_exp2f(m3 - M);
                const float a = ob[(0 * 8 + h) * 256 + tid] * e0 + ob[(1 * 8 + h) * 256 + tid] * e1 + ob[(2 * 8 + h) * 256 + tid] * e2 + ob[(3 * 8 + h) * 256 + tid] * e3;
                pp[h * 258 + 2 + tid] = a;
                if (tid == 0) { pp[h * 258] = M; pp[h * 258 + 1] = wl[h] * e0 + wl[16 + h] * e1 + wl[32 + h] * e2 + wl[48 + h] * e3; }
            }
        }
        __syncthreads();
    }
}
__device__ __forceinline__ void ph_attn_dec(const P& p, int layer, char* smem, unsigned* queue) {
    const int tid = opaque_v((int)threadIdx.x);
    unsigned* qslot = reinterpret_cast<unsigned*>(smem + 76000);
    for (;;) {
        __syncthreads();
        if (tid == 0) *qslot = __hip_atomic_fetch_add(queue, 1u, __ATOMIC_RELAXED, __HIP_MEMORY_SCOPE_AGENT);
        __syncthreads();
        const int o = (int)__builtin_amdgcn_readfirstlane((int)*qslot);
        if (o >= 1536) break;
        const int k3 = o / 3, r3 = o - 3 * k3;
        if (r3 == 0) decode_unit(p, layer, smem, k3, tid);
        else attn_unit(p, smem, 2 * k3 + r3 - 1, tid);
    }
}
__device__ __forceinline__ void ph_decode_comb2(const P& p, int layer, char* smem) {
    const int GX = p.grid;
    const int tid_ = opaque_v((int)threadIdx.x); const int bid_ = opaque_s((int)blockIdx.x);
    float* sw = (float*)smem;
    float* so = sw + 20;
    float* sLp = so + 256;
    VB_LOOP(NS * 8) {
        int bs = vb / 8, h = vb % 8, tid = tid_;
        const float* pb = p.part + (size_t)bs * D_NCH * 8 * 258 + h * 258;
        const float* latn = p.lat + (size_t)(NPT + bs) * KVL;
        if (tid < 64) {
            const float4 q4 = *reinterpret_cast<const float4*>(p.qlat + ((size_t)bs * 8 + h) * 256 + tid * 4);
            const float4 l4 = *reinterpret_cast<const float4*>(latn + tid * 4);
            float sn = q4.x * l4.x + q4.y * l4.y + q4.z * l4.z + q4.w * l4.w;
            if (tid < 32) sn += p.q[(size_t)(NPT + bs) * 768 + h * 96 + 64 + tid] * ATT_SCALE * p.kpe[(size_t)(NPT + bs) * 32 + tid];
            sn = wave_sum(sn) * 1.4426950408889634f;
            float m = sn;
            if (tid < D_NCH) m = fmaxf(m, pb[(size_t)tid * 8 * 258]);
            m = wave_max(m);
            float l = 0.f;
            if (tid < D_NCH) {
                float w = __builtin_amdgcn_exp2f(pb[(size_t)tid * 8 * 258] - m);
                sw[tid] = w;
                l = w * pb[(size_t)tid * 8 * 258 + 1];
            }
            const float wn = __builtin_amdgcn_exp2f(sn - m);
            if (tid == 0) { sw[D_NCH] = wn; l += wn; }
            l = wave_sum(l);
            if (tid == 0) sLp[0] = l;
        }
        __syncthreads();
        float a = sw[D_NCH] * latn[tid];
        for (int c = 0; c < D_NCH; ++c) a += sw[c] * pb[(size_t)c * 8 * 258 + 2 + tid];
        so[tid] = a / sLp[0];
        __syncthreads();
        if (tid < 64) {
            const float* w = p.w_kvb + (size_t)layer * 256 * 1024 + h * 128 + 64 + tid;
            float sacc = 0.f;
            for (int r = 0; r < 256; ++r) sacc += so[r] * w[(size_t)r * 1024];
            p.ob[(size_t)(NPT + bs) * 512 + h * 64 + tid] = f2bf(sacc);
        }
        __syncthreads();
    }
}


struct EpiInProj {
    bf16_t *gab, *zs, *xbr; float *dt, *cq, *ckv, *kr, *out;
    const float *b_gate, *dt_bias, *rstd; int layer;
    __device__ __forceinline__ void row4(int m, int n, float a0, float a1, float a2, float a3) const {
        const float rs = rstd[m];
        const float v0 = a0 * rs, v1 = a1 * rs, v2 = a2 * rs, v3 = a3 * rs;
        if (n < 2048) {
            const float4 b4 = *reinterpret_cast<const float4*>(b_gate + layer * 2048 + n);
            *reinterpret_cast<uint2*>(gab + (size_t)m * 2048 + n) = pack4(sigmoid_f(v0 + b4.x), sigmoid_f(v1 + b4.y), sigmoid_f(v2 + b4.z), sigmoid_f(v3 + b4.w));
        } else if (n < 3072) {
            *reinterpret_cast<uint2*>(zs + (size_t)m * DM + (n - 2048)) = pack4(silu_f(v0), silu_f(v1), silu_f(v2), silu_f(v3));
        } else if (n < 4608) {
            const int c = n - 3072;
            *reinterpret_cast<uint2*>(xbr + (size_t)m * CONVD + c) = pack4(v0, v1, v2, v3);
            if (m < NPT) { const int l = m & (SEQ - 1); if (l >= SEQ - 3) *reinterpret_cast<float4*>(out + O_CONVP + ((size_t)(layer * NB + (m >> 11)) * 3 + (l - (SEQ - 3))) * CONVD + c) = make_float4(v0, v1, v2, v3); }
            else if (m < NT) *reinterpret_cast<float4*>(out + O_CONVS + ((size_t)(layer * NS + (m - NPT)) * 3 + 2) * CONVD + c) = make_float4(v0, v1, v2, v3);
        } else if (n < 4624) {
            const float4 b4 = *reinterpret_cast<const float4*>(dt_bias + layer * 16 + (n - 4608));
            const float x0 = v0 + b4.x, x1 = v1 + b4.y, x2 = v2 + b4.z, x3 = v3 + b4.w;
            *reinterpret_cast<float4*>(dt + (size_t)m * 16 + (n - 4608)) = make_float4((x0 > 20.f) ? x0 : log1pf(__expf(x0)), (x1 > 20.f) ? x1 : log1pf(__expf(x1)),
                                                                                       (x2 > 20.f) ? x2 : log1pf(__expf(x2)), (x3 > 20.f) ? x3 : log1pf(__expf(x3)));
        } else if (n < 5008) { *reinterpret_cast<float4*>(cq + (size_t)m * QL + (n - 4624)) = make_float4(v0, v1, v2, v3); }
        else if (n < 5264) { *reinterpret_cast<float4*>(ckv + (size_t)m * KVL + (n - 5008)) = make_float4(v0, v1, v2, v3); }
        else if (n < 5296) { *reinterpret_cast<float4*>(kr + (size_t)m * 32 + (n - 5264)) = make_float4(v0, v1, v2, v3); }
    } EPI_ROWS };
__device__ __forceinline__ void ph_conv2(const P& p, int layer) {
    const int GX = p.grid;
    const int tid_ = opaque_v((int)threadIdx.x); const int bid_ = opaque_s((int)blockIdx.x);
    const int total = NT * (CONVD / 8);
    const float* cw = p.conv_w + (size_t)layer * 4 * CONVD;
    for (int i = bid_ * NTHR + tid_; i < total; i += GX * NTHR) {
        const int t = i / (CONVD / 8), c0 = (i % (CONVD / 8)) * 8;
        float acc[8];
        {
            const float4 b0 = *reinterpret_cast<const float4*>(p.conv_b + layer * CONVD + c0), b1 = *reinterpret_cast<const float4*>(p.conv_b + layer * CONVD + c0 + 4);
            acc[0] = b0.x; acc[1] = b0.y; acc[2] = b0.z; acc[3] = b0.w; acc[4] = b1.x; acc[5] = b1.y; acc[6] = b1.z; acc[7] = b1.w;
        }
#pragma unroll
        for (int k = 0; k < 4; ++k) {
            float xv[8];
            bool have = true;
            if (t < NPT) {
                const int l = t & (SEQ - 1);
                if (l + k - 3 >= 0) {
                    const uint4 r = *reinterpret_cast<const uint4*>(p.xbr + (size_t)(t + k - 3) * CONVD + c0);
                    xv[0] = bflo(r.x); xv[1] = bfhi(r.x); xv[2] = bflo(r.y); xv[3] = bfhi(r.y); xv[4] = bflo(r.z); xv[5] = bfhi(r.z); xv[6] = bflo(r.w); xv[7] = bfhi(r.w);
                } else have = false;
            } else {
                if (k == 3) {
                    const uint4 r = *reinterpret_cast<const uint4*>(p.xbr + (size_t)t * CONVD + c0);
                    xv[0] = bflo(r.x); xv[1] = bfhi(r.x); xv[2] = bflo(r.y); xv[3] = bfhi(r.y); xv[4] = bflo(r.z); xv[5] = bfhi(r.z); xv[6] = bflo(r.w); xv[7] = bfhi(r.w);
                } else {
                    const float* pv = p.state_conv + ((size_t)(layer * NS + (t - NPT)) * 3 + k) * CONVD + c0;
                    const float4 a = *reinterpret_cast<const float4*>(pv), b = *reinterpret_cast<const float4*>(pv + 4);
                    xv[0] = a.x; xv[1] = a.y; xv[2] = a.z; xv[3] = a.w; xv[4] = b.x; xv[5] = b.y; xv[6] = b.z; xv[7] = b.w;
                    if (k >= 1) {
                        float* oc = p.out + O_CONVS + ((size_t)(layer * NS + (t - NPT)) * 3 + (k - 1)) * CONVD + c0;
                        *reinterpret_cast<float4*>(oc) = a; *reinterpret_cast<float4*>(oc + 4) = b;
                    }
                }
            }
            if (have) {
                const float4 w0 = *reinterpret_cast<const float4*>(cw + k * CONVD + c0), w1 = *reinterpret_cast<const float4*>(cw + k * CONVD + c0 + 4);
                acc[0] += xv[0] * w0.x; acc[1] += xv[1] * w0.y; acc[2] += xv[2] * w0.z; acc[3] += xv[3] * w0.w;
                acc[4] += xv[4] * w1.x; acc[5] += xv[5] * w1.y; acc[6] += xv[6] * w1.z; acc[7] += xv[7] * w1.w;
            }
        }
        uint4 o;
        o.x = pack_bf16(silu_f(acc[0]), silu_f(acc[1])); o.y = pack_bf16(silu_f(acc[2]), silu_f(acc[3]));
        o.z = pack_bf16(silu_f(acc[4]), silu_f(acc[5])); o.w = pack_bf16(silu_f(acc[6]), silu_f(acc[7]));
        *reinterpret_cast<uint4*>(p.xbcb + (size_t)t * CONVD + c0) = o;
    }
}

__device__ __forceinline__ void bar_sync(const XcdBarrier& b0) {
    XcdBarrier b = b0;
    unsigned long long bp = (unsigned long long)b.bar; asm volatile("" : "+s"(bp)); b.bar = (unsigned*)bp;
    unsigned bx = b.x; asm volatile("" : "+s"(bx)); b.x = bx;
    xcd_barrier(b);
}
#if PROBE_BAR
#define BAR() do { bar_sync(bar); bar_sync(bar); } while (0)
#else
#define BAR() bar_sync(bar)
#endif
#define NPAD_IN 5376

__global__ void __launch_bounds__(256, 2) k_fwd(P p) {
    __shared__ uint4 xb_words;
    __shared__ __attribute__((aligned(16))) char smem[76800];
    if (threadIdx.x == 0) xb_words = make_uint4(0u, 0u, 0u, 0u);
    __syncthreads();
    XcdBarrier bar = xcd_barrier_post(p.bar, (volatile LAS unsigned*)&xb_words);

#if PROBE_TWICE
#pragma unroll 1
    for (int rep_ = 0; rep_ < 2; ++rep_) {
    if (rep_) { for (int i = blockIdx.x * NTHR + threadIdx.x; i < DEPTH * TP; i += p.grid * NTHR) p.sumsq1[i] = 0.f; BAR(); }
#endif
    ph_rope_table(p);
    ph_copy_x(p);
#pragma unroll 1
    for (int l = 0; l < DEPTH; ++l) {
        ph_convert_w(p.w_in + (size_t)l * DM * DIN, DM, DIN, NPAD_IN, p.wt_in + (size_t)l * NPAD_IN * DM, smem, p.grid, p.norm_mix + l * DM);
        ph_convert_w(p.w_ssm_proj + (size_t)l * DM * DM, DM, DM, DM, p.wt_ssm + (size_t)l * DM * DM, smem, p.grid);
        ph_convert_w(p.w_qb + (size_t)l * QL * 768, QL, 768, 768, p.wt_qb + (size_t)l * 768 * QL, smem, p.grid);
        ph_convert_w(p.w_kvb + (size_t)l * KVL * 1024, KVL, 1024, 1024, p.wt_kvb + (size_t)l * 1024 * KVL, smem, p.grid);
        ph_convert_w(p.w_mla_proj + (size_t)l * 512 * DM, 512, DM, DM, p.wt_mla + (size_t)l * DM * 512, smem, p.grid);
        ph_convert_w(p.w_out + (size_t)l * DM * DM, DM, DM, DM, p.wt_out + (size_t)l * DM * DM, smem, p.grid);
    }
    ph_convert_plain(p.peer_wq, p.wqb, (size_t)DEPTH * DM * 2048, p.grid);
    ph_convert_plain(p.peer_keys, p.keysb, (size_t)DEPTH * 16 * 128 * 128, p.grid);
#if PROBE_PRO2
#pragma unroll 1
    for (int l = 0; l < DEPTH; ++l) {
        ph_convert_w(p.w_in + (size_t)l * DM * DIN, DM, DIN, NPAD_IN, p.wt_in + (size_t)l * NPAD_IN * DM, smem, p.grid, p.norm_mix + l * DM);
        ph_convert_w(p.w_ssm_proj + (size_t)l * DM * DM, DM, DM, DM, p.wt_ssm + (size_t)l * DM * DM, smem, p.grid);
        ph_convert_w(p.w_qb + (size_t)l * QL * 768, QL, 768, 768, p.wt_qb + (size_t)l * 768 * QL, smem, p.grid);
        ph_convert_w(p.w_kvb + (size_t)l * KVL * 1024, KVL, 1024, 1024, p.wt_kvb + (size_t)l * 1024 * KVL, smem, p.grid);
        ph_convert_w(p.w_mla_proj + (size_t)l * 512 * DM, 512, DM, DM, p.wt_mla + (size_t)l * DM * 512, smem, p.grid);
        ph_convert_w(p.w_out + (size_t)l * DM * DM, DM, DM, DM, p.wt_out + (size_t)l * DM * DM, smem, p.grid);
    }
    ph_convert_plain(p.peer_wq, p.wqb, (size_t)DEPTH * DM * 2048, p.grid);
    ph_copy_x(p);
#endif
    ph_convert_fp8(p.peer_u, p.u8, p.uinv, DEPTH * NEXP, p.norm_ffn, p.grid);
    ph_convert_fp8(p.peer_v, p.v8, p.vinv, DEPTH * NEXP, nullptr, p.grid);
#if PROBE_PRO
    ph_convert_fp8(p.peer_u, p.u8, p.uinv, DEPTH * NEXP, p.norm_ffn, p.grid);
    ph_convert_fp8(p.peer_v, p.v8, p.vinv, DEPTH * NEXP, nullptr, p.grid);
#endif
    BAR();
#pragma unroll 1
    for (int c = 0; c < DEPTH * 16; ++c) {
        const int l = c >> 4, hh = c & 15;
        gemm_bf16(p.keysb + (size_t)c * 128 * 128, 128, p.wqb + (size_t)l * DM * 2048 + hh * 128, 2048, 1, 8, 128, smem,
                  EpiStoreBfCol{p.wt_pq + (size_t)l * 2048 * DM + (size_t)hh * 128 * DM, DM, p.norm_ffn + l * DM}, p.grid, (c & 7) + (c >> 3) * 64);
    }
#if PROBE_WEFF
#pragma unroll 1
    for (int c = 0; c < DEPTH * 16; ++c) {
        const int l = c >> 4, hh = c & 15;
        gemm_bf16(p.keysb + (size_t)c * 128 * 128, 128, p.wqb + (size_t)l * DM * 2048 + hh * 128, 2048, 1, 8, 128, smem,
                  EpiStoreBfCol{p.wt_pq + (size_t)l * 2048 * DM + (size_t)hh * 128 * DM, DM, p.norm_ffn + l * DM}, p.grid, (c & 7) + (c >> 3) * 64);
    }
#endif
    BAR();
#pragma unroll 1
    for (int l = 0; l < DEPTH; ++l) {
        gemm_bf16(p.xb, DM, p.wt_in + (size_t)l * NPAD_IN * DM, DM, TP / 128, NPAD_IN / 128, DM, smem, EpiInProj{p.gab, p.zs, p.xbr, p.dt, p.cq, p.ckv, p.kr, p.out, p.b_gate, p.dt_bias, p.rstd, l}, p.grid);
#if PROBE_GEMM
        gemm_bf16(p.xb, DM, p.wt_in + (size_t)l * NPAD_IN * DM, DM, TP / 128, NPAD_IN / 128, DM, smem, EpiInProj{p.gab, p.zs, p.xbr, p.dt, p.cq, p.ckv, p.kr, p.out, p.b_gate, p.dt_bias, p.rstd, l}, p.grid);
#endif
        BAR();
        ph_conv2(p, l);
        ph_rmsnorm(p.cq, QL, p.q_norm + l * QL, nullptr, 0, p.qnb, QL, QL, TP, p.grid);
        ph_lat_kpe(p, l);
#if PROBE_ELEM
        ph_conv2(p, l);
        ph_rmsnorm(p.cq, QL, p.q_norm + l * QL, nullptr, 0, p.qnb, QL, QL, TP, p.grid);
        ph_lat_kpe(p, l);
#endif
        BAR();
        ph_ssd_seq(p, l);
#if PROBE_MISC
        ph_ssd_seq(p, l);
#endif
        gemm_bf16(p.qnb, QL, p.wt_qb + (size_t)l * 768 * QL, QL, TP / 128, 768 / 128, QL, smem, EpiQRope{p.qb, p.q, p.rope}, p.grid);
        gemm_bf16(p.latb, KVL, p.wt_kvb + (size_t)l * 1024 * KVL, KVL, TP / 128, 1024 / 128, KVL, smem, EpiKV{p.kn, p.vT}, p.grid);
        BAR();
        ph_ssd_chunk(p, l, smem);
#if PROBE_SSD
        ph_ssd_chunk(p, l, smem);
#endif
        ph_qlat(p, l);
        ph_attn_dec(p, l, smem, p.queue + l * 64);
#if PROBE_ATTN
        ph_attn_dec(p, l, smem, p.queue + (DEPTH + l) * 64);
#endif
        BAR();
        ph_decode_comb2(p, l, smem);
        ph_gate_norm(p, l);
#if PROBE_ELEM
        ph_gate_norm(p, l);
#endif
        BAR();
        gemm_bf16(p.ynb, DM, p.wt_ssm + (size_t)l * DM * DM, DM, TP / 128, DM / 128, DM, smem, EpiGateA{p.ya, p.gab}, p.grid);
        gemm_bf16(p.ob, 512, p.wt_mla + (size_t)l * DM * 512, 512, TP / 128, DM / 128, 512, smem, EpiGateB{p.ya, p.gab, p.mixb}, p.grid);
#if PROBE_GEMM
        gemm_bf16(p.ynb, DM, p.wt_ssm + (size_t)l * DM * DM, DM, TP / 128, DM / 128, DM, smem, EpiGateA{p.ya, p.gab}, p.grid);
        gemm_bf16(p.ob, 512, p.wt_mla + (size_t)l * DM * 512, 512, TP / 128, DM / 128, 512, smem, EpiGateB{p.ya, p.gab, p.mixb}, p.grid);
#endif
        BAR();
        gemm_bf16(p.mixb, DM, p.wt_out + (size_t)l * DM * DM, DM, TP / 128, DM / 128, DM, smem, EpiResidRow{p.xres, p.xb, p.sumsq1 + (size_t)l * TP}, p.grid);
        BAR();
        gemm_bf16(p.xb, DM, p.wt_pq + (size_t)l * 2048 * DM, DM, TP / 128, 2048 / 128, DM, smem, EpiScaleRow{p.sc, 2048, p.sumsq1 + (size_t)l * TP}, p.grid);
#if PROBE_GEMM
        gemm_bf16(p.xb, DM, p.wt_pq + (size_t)l * 2048 * DM, DM, TP / 128, 2048 / 128, DM, smem, EpiScaleRow{p.sc, 2048, p.sumsq1 + (size_t)l * TP}, p.grid);
#endif
        BAR();
        ph_peer_topk2(p);
#if PROBE_TOPK
        ph_peer_topk2(p);
#endif
        BAR();
#if PROBE_EXP
        ph_peer_experts3(p, l, true);
#endif
        ph_peer_experts3(p, l);
        BAR();
    }
#if PROBE_TWICE
    }
#endif
}

static inline char* carve_b(char*& cur, size_t bytes) {
    char* r = cur;
    cur += ((bytes + 255) / 256) * 256;
    return r;
}
static inline float* carve(char*& cur, size_t nfloats) { return (float*)carve_b(cur, nfloats * 4); }
static inline bf16_t* carve_h(char*& cur, size_t n) { return (bf16_t*)carve_b(cur, n * 2); }

extern "C" void kernel_launch(void* const* d_in, const int* in_sizes, int n_in,
                              void* d_out, int out_size, void* d_ws, size_t ws_size,
                              hipStream_t stream) {
    P p{};
    p.x_prompt = (const float*)d_in[0]; p.x_sample = (const float*)d_in[1];
    p.cache_lat = (const float*)d_in[2]; p.cache_kr = (const float*)d_in[3];
    p.state_ssm = (const float*)d_in[4]; p.state_conv = (const float*)d_in[5];
    p.page_table = (const int*)d_in[6];
    p.norm_mix = (const float*)d_in[7]; p.w_in = (const float*)d_in[8]; p.b_gate = (const float*)d_in[9];
    p.conv_w = (const float*)d_in[10]; p.conv_b = (const float*)d_in[11]; p.dt_bias = (const float*)d_in[12];
    p.a_log = (const float*)d_in[13]; p.d_skip = (const float*)d_in[14]; p.ssm_norm = (const float*)d_in[15];
    p.w_ssm_proj = (const float*)d_in[16]; p.q_norm = (const float*)d_in[17]; p.w_qb = (const float*)d_in[18];
    p.kv_norm = (const float*)d_in[19]; p.w_kvb = (const float*)d_in[20]; p.w_mla_proj = (const float*)d_in[21];
    p.w_out = (const float*)d_in[22]; p.norm_ffn = (const float*)d_in[23]; p.peer_wq = (const float*)d_in[24];
    p.peer_keys = (const float*)d_in[25]; p.peer_u = (const float*)d_in[26]; p.peer_v = (const float*)d_in[27];
    p.norm_final = (const float*)d_in[28];
    p.out = (float*)d_out;
    char* cur = (char*)d_ws;
    p.bar = (unsigned*)carve(cur, XCD_BAR_WORDS);
    p.sumsq1 = carve(cur, (size_t)DEPTH * TP);
    p.queue = (unsigned*)carve(cur, 4 * DEPTH * 64);
    char* zero_begin = (char*)d_ws;
    char* zero_end = cur;
    p.xres = carve(cur, (size_t)TP * DM);
    p.cq = carve(cur, (size_t)TP * QL);
    p.ckv = carve(cur, (size_t)TP * KVL);
    p.kr = carve(cur, (size_t)TP * 32);
    p.dt = carve(cur, (size_t)TP * 16);
    p.yraw = carve(cur, (size_t)TP * DM);
    p.ya = carve(cur, (size_t)TP * DM);
    p.q = carve(cur, (size_t)TP * 768);
    p.lat = carve(cur, (size_t)TP * KVL);
    p.kpe = carve(cur, (size_t)TP * 32);
    p.sc = carve(cur, (size_t)TP * 2048);
    p.gate = carve(cur, (size_t)TP * 128);
    p.part = carve(cur, (size_t)NS * 129 * 8 * 258);
    p.qlat = carve(cur, (size_t)NS * 8 * 256);
    p.rope = carve(cur, (size_t)2 * 2049 * 16);
    p.idx = (int*)carve(cur, (size_t)TP * 128);
    p.xb = carve_h(cur, (size_t)TP * DM);
    p.rstd = carve(cur, (size_t)TP);
    p.ynb = carve_h(cur, (size_t)TP * DM);
    p.qnb = carve_h(cur, (size_t)TP * QL);
    p.latb = carve_h(cur, (size_t)TP * KVL);
    p.ob = carve_h(cur, (size_t)TP * 512);
    p.mixb = carve_h(cur, (size_t)TP * DM);
    p.qb = carve_h(cur, (size_t)TP * 768);
    p.kn = carve_h(cur, (size_t)TP * 512);
    p.kpeb = carve_h(cur, (size_t)TP * 32);
    p.vT = carve_h(cur, (size_t)NB * 8 * 64 * SEQ);
    p.xbcb = carve_h(cur, (size_t)TP * CONVD);
    p.xbr = carve_h(cur, (size_t)TP * CONVD);
    p.gab = carve_h(cur, (size_t)TP * 2048);
    p.zs = carve_h(cur, (size_t)TP * DM);
    p.wt_in = carve_h(cur, (size_t)DEPTH * NPAD_IN * DM);
    p.wt_ssm = carve_h(cur, (size_t)DEPTH * DM * DM);
    p.wt_qb = carve_h(cur, (size_t)DEPTH * 768 * QL);
    p.wt_kvb = carve_h(cur, (size_t)DEPTH * 1024 * KVL);
    p.wt_mla = carve_h(cur, (size_t)DEPTH * DM * 512);
    p.wt_out = carve_h(cur, (size_t)DEPTH * DM * DM);
    p.wt_pq = carve_h(cur, (size_t)DEPTH * 2048 * DM);
    p.wqb = carve_h(cur, (size_t)DEPTH * DM * 2048);
    p.keysb = carve_h(cur, (size_t)DEPTH * 16 * 128 * 128);
    p.u8 = (unsigned char*)carve_b(cur, (size_t)DEPTH * NEXP * DM);
    p.v8 = (unsigned char*)carve_b(cur, (size_t)DEPTH * NEXP * DM);
    p.uinv = carve(cur, (size_t)DEPTH * NEXP);
    p.vinv = carve(cur, (size_t)DEPTH * NEXP);

    (void)hipMemsetAsync(zero_begin, 0, (size_t)(zero_end - zero_begin), stream);

    static int grid = 0;
    if (!grid) {
        int dev = 0, cus = 0, per_cu = 0;
        (void)hipGetDevice(&dev);
        (void)hipDeviceGetAttribute(&cus, hipDeviceAttributeMultiprocessorCount, dev);
        (void)hipOccupancyMaxActiveBlocksPerMultiprocessor(&per_cu, k_fwd, 256, 0);
        if (per_cu > 2) per_cu = 2;
        if (per_cu < 1) per_cu = 1;
        grid = cus * per_cu;
    }
    p.grid = grid;
    k_fwd<<<grid, 256, 0, stream>>>(p);
}
```

```cpp
#include <hip/hip_runtime.h>
#include <stdint.h>

#define DM 1024
#define NB 8
#define SEQ 2048
#define NPT (NB * SEQ)
#define NS 32
#define NT (NPT + NS)
#define TP 16512
#define DEPTH 2
#define PAST 16384
#define PAGE 128
#define NPAGES 128
#define NPOOL 5120
#define DIN 5296
#define OFF_GA 0
#define OFF_GB 1024
#define OFF_Z 2048
#define OFF_XBC 3072
#define OFF_DT 4608
#define OFF_CQ 4624
#define OFF_CKV 5008
#define OFF_KR 5264
#define CONVD 1536
#define QL 384
#define KVL 256
#define NEXP 16384
#define EPSF 1e-6f
#define ATT_SCALE 0.10206207261596577f

#define O_YP 0
#define O_YS (O_YP + NPT * DM)
#define O_LATP (O_YS + NS * DM)
#define O_KRP (O_LATP + DEPTH * NPT * KVL)
#define O_SSMP (O_KRP + DEPTH * NPT * 32)
#define O_CONVP (O_SSMP + DEPTH * NB * 16 * 64 * 128)
#define O_LATS (O_CONVP + DEPTH * NB * 3 * CONVD)
#define O_KRS (O_LATS + DEPTH * NS * KVL)
#define O_SSMS (O_KRS + DEPTH * NS * 32)
#define O_CONVS (O_SSMS + DEPTH * NS * 16 * 64 * 128)

struct P {
    const float *x_prompt, *x_sample, *cache_lat, *cache_kr, *state_ssm, *state_conv;
    const int* page_table;
    const float *norm_mix, *w_in, *b_gate, *conv_w, *conv_b, *dt_bias, *a_log, *d_skip, *ssm_norm, *w_ssm_proj;
    const float *q_norm, *w_qb, *kv_norm, *w_kvb, *w_mla_proj, *w_out, *norm_ffn, *peer_wq, *peer_keys, *peer_u, *peer_v, *norm_final;
    float* out;
    float *xres, *h, *proj, *xbc, *dt, *yraw, *yn, *ya, *qn, *q, *lat, *kpe, *kv, *o, *yb, *mix, *pq, *sc, *gate, *part, *qlat, *rope;
    int* idx;
    unsigned* bar;
    unsigned short *hb, *ynb, *qnb, *latb, *ob, *mixb, *qb, *kn, *kpeb, *vT, *xbcb, *xbr, *gab, *zs;
    float *cq, *ckv, *kr, *rstd, *sumsq1;
    unsigned short* xb;
    unsigned* queue;
    float *ssq, *sskv, *ssy;
    unsigned short *cqb, *ckvb, *ygb;
    int grid, pad_;
    unsigned short *wt_in, *wt_ssm, *wt_qb, *wt_kvb, *wt_mla, *wt_out, *wt_pq, *wqb, *keysb;
    unsigned char *u8, *v8;
    float *uinv, *vinv;
};

#define XB_TMO      128
#define XB_XCNT(j)  (256  + 64 * (j))
#define XB_XSUB(j)  (1280 + 64 * (j))
#define XB_XGEN(j)  (2304 + 64 * (j))
#define XB_TOP      3328
#define XB_TOPGEN   3392
#define XCD_BAR_WORDS 3456
#define XB_SPIN_CAP (1u << 18)
#define LAS __attribute__((address_space(3)))

__device__ __forceinline__ unsigned xb_ld(unsigned* p)              { return __hip_atomic_load(p, __ATOMIC_RELAXED, __HIP_MEMORY_SCOPE_AGENT); }
__device__ __forceinline__ unsigned xb_add(unsigned* p, unsigned v) { return __hip_atomic_fetch_add(p, v, __ATOMIC_RELAXED, __HIP_MEMORY_SCOPE_AGENT); }
__device__ __forceinline__ unsigned xb_xcc_id() { return (unsigned)__builtin_amdgcn_s_getreg((3 << 11) | 20) & 0xFu; }
#define XB_SPIN(cond, bar) do { unsigned _sp = 0; while (cond) { __builtin_amdgcn_s_sleep(1); \
    if ((++_sp & 255u) == 0u) { if (xb_ld(&(bar)[XB_TMO])) break; if (_sp > XB_SPIN_CAP) { atomicAdd(&(bar)[XB_TMO], 1u); break; } } } } while (0)

struct XcdBarrier {
    unsigned* bar; unsigned x;
    volatile LAS unsigned* st;
};

__device__ __forceinline__ XcdBarrier xcd_barrier_post(unsigned* bar, volatile LAS unsigned* st) {
    XcdBarrier b; b.bar = bar; b.x = xb_xcc_id(); b.st = st;
    if (threadIdx.x == 0) (void)xb_add(&bar[XB_XCNT(b.x)], 1u);
    return b;
}
__device__ __forceinline__ void xcd_barrier_complete(unsigned* bar, unsigned x, unsigned& nloc, unsigned& nx) {
    const unsigned G = gridDim.x * gridDim.y * gridDim.z;
    unsigned sum, cnt, mine, sp = 0u;
    for (;;) {
        sum = 0u; cnt = 0u; mine = 0u;
#pragma unroll
        for (unsigned j = 0; j < 16; ++j) { const unsigned c = xb_ld(&bar[XB_XCNT(j)]); sum += c; cnt += (c > 0u) ? 1u : 0u; mine = (j == x) ? c : mine; }
        if (sum == G) break;
        __builtin_amdgcn_s_sleep(1);
        if ((++sp & 255u) == 0u) { if (xb_ld(&bar[XB_TMO])) break; if (sp > XB_SPIN_CAP) { atomicAdd(&bar[XB_TMO], 1u); break; } }
    }
    nloc = mine > 0u ? mine : 1u; nx = cnt > 0u ? cnt : 1u;
}

__device__ __forceinline__ void xcd_barrier(const XcdBarrier& b) {
    asm volatile("s_waitcnt vmcnt(0)" ::: "memory");
    __syncthreads();
    if (threadIdx.x == 0) {
        unsigned* bar = b.bar;
        __builtin_amdgcn_s_waitcnt(0);
        unsigned nloc = b.st[0], nx = b.st[1];
        if (nloc == 0u) { xcd_barrier_complete(bar, b.x, nloc, nx); b.st[0] = nloc; b.st[1] = nx; }
        const unsigned old = xb_add(&bar[XB_XSUB(b.x)], 1u);
        const unsigned gen = old / nloc;
        if (old + 1u == (gen + 1u) * nloc) {
            __builtin_amdgcn_fence(__ATOMIC_RELEASE, "agent");
            asm volatile("s_waitcnt vmcnt(0)" ::: "memory");
            const unsigned og = xb_add(&bar[XB_TOP], 1u);
            const unsigned tg = og / nx;
            if (og + 1u == (tg + 1u) * nx) xb_add(&bar[XB_TOPGEN], 1u);
            else XB_SPIN(xb_ld(&bar[XB_TOPGEN]) == tg, bar);
            __builtin_amdgcn_fence(__ATOMIC_ACQUIRE, "agent");
            xb_add(&bar[XB_XGEN(b.x)], 1u);
            asm volatile("s_waitcnt vmcnt(0)" ::: "memory");
        } else {
            XB_SPIN(xb_ld(&bar[XB_XGEN(b.x)]) == gen, bar);
            __builtin_amdgcn_fence(__ATOMIC_ACQUIRE, "agent");
            asm volatile("s_waitcnt vmcnt(0)" ::: "memory");
        }
    }
    __syncthreads();
}


__device__ __forceinline__ float wave_sum(float v) {
#pragma unroll
    for (int o = 32; o > 0; o >>= 1) v += __shfl_xor(v, o);
    return v;
}
__device__ __forceinline__ float wave_max(float v) {
#pragma unroll
    for (int o = 32; o > 0; o >>= 1) v = fmaxf(v, __shfl_xor(v, o));
    return v;
}
__device__ __forceinline__ float sigmoid_f(float x) { return __builtin_amdgcn_rcpf(1.f + __expf(-x)); }
__device__ __forceinline__ float silu_f(float x) { return x * sigmoid_f(x); }


__device__ __forceinline__ int opaque_v(int x) { asm volatile("" : "+v"(x)); return x; }
__device__ __forceinline__ int opaque_s(int x) { asm volatile("" : "+s"(x)); return x; }

#ifndef PROBE_GEMM
#define PROBE_GEMM 0
#endif
#ifndef PROBE_TOPK
#define PROBE_TOPK 0
#endif
#ifndef PROBE_ATTN
#define PROBE_ATTN 0
#endif
#ifndef PROBE_DEC
#define PROBE_DEC 0
#endif
#ifndef PROBE_SSD
#define PROBE_SSD 0
#endif
#ifndef PROBE_ELEM
#define PROBE_ELEM 0
#endif
#ifndef PROBE_EXP
#define PROBE_EXP 0
#endif
#ifndef PROBE_PRO2
#define PROBE_PRO2 0
#endif
#ifndef PROBE_WEFF
#define PROBE_WEFF 0
#endif
#ifndef PROBE_MISC
#define PROBE_MISC 0
#endif
#ifndef PROBE_BAR
#define PROBE_BAR 0
#endif
#ifndef PROBE_TWICE
#define PROBE_TWICE 0
#endif
#ifndef PROBE_PRO
#define PROBE_PRO 0
#endif
#define NTHR 256
#define VB_LOOP(n) for (int vb = bid_; vb < (n); vb += GX)


typedef unsigned short bf16_t;
using bf16x8 = __attribute__((ext_vector_type(8))) short;
using f32x4 = __attribute__((ext_vector_type(4))) float;
typedef __attribute__((ext_vector_type(2))) __bf16 bf16x2_t;
__device__ __forceinline__ bf16_t f2bf(float f) { __bf16 h = (__bf16)f; return __builtin_bit_cast(unsigned short, h); }
__device__ __forceinline__ unsigned pack_bf16(float a, float b) { bf16x2_t r; r[0] = (__bf16)a; r[1] = (__bf16)b; return __builtin_bit_cast(unsigned, r); }
__device__ __forceinline__ float bf2f(bf16_t h) { return __uint_as_float(((unsigned)h) << 16); }
__device__ __forceinline__ float bflo(unsigned d) { return __uint_as_float(d << 16); }
__device__ __forceinline__ float bfhi(unsigned d) { return __uint_as_float(d & 0xffff0000u); }

__device__ __forceinline__ int lds_byte(int r, int c) {
    int st = (r >> 4) * 2 + (c >> 5), rr = r & 15, cc = c & 31, ob = rr * 64 + cc * 2;
    return st * 1024 + (ob ^ (((ob >> 9) & 1) << 5));
}
__device__ __forceinline__ void stage_rc(int b, int& R, int& C) {
    int st = b / 1024, sb = b % 1024, swz = sb ^ (((sb >> 9) & 1) << 5);
    R = (st >> 1) * 16 + swz / 64; C = (st & 1) * 32 + (swz % 64) / 2;
}
template <bool PERM>
__device__ __forceinline__ void stage_tile(const bf16_t* base, int ld, int row0, int k0, char* dst, int tid, bool extra = false) {
#pragma unroll
    for (int i = 0; i < 4; ++i) {
        int b = tid * 16 + i * 4096;
        int R, C; stage_rc(b, R, C);
        if (PERM) R = (R & 64) + 4 * (R & 15) + ((R >> 4) & 3);
        const bf16_t* src = base + (size_t)(row0 + R) * ld + k0 + C;
        __builtin_amdgcn_global_load_lds((const unsigned*)src, (unsigned*)(dst + b), 16, 0, 0);
    }
    if (extra) {
        int b = tid * 16 + 16384;
        int R, C; stage_rc(b, R, C);
        const bf16_t* src = base + (size_t)(row0 + R) * ld + k0 + C;
        __builtin_amdgcn_global_load_lds((const unsigned*)src, (unsigned*)(dst + b), 16, 0, 0);
    }
}
__device__ __forceinline__ void tile_map(int id, int mtiles, int ntiles, int& mt, int& nt) {
    const int fg = mtiles >> 3, full = fg * ntiles * 8;
    if (id < full) { const int mg = id / (ntiles * 8), r = id % (ntiles * 8); nt = r >> 3; mt = mg * 8 + (r & 7); }
    else { const int rem = mtiles & 7, r = id - full; nt = r / rem; mt = fg * 8 + r % rem; }
}
#define G_ABYTES 20480
#define G_STAGE (G_ABYTES + 16384)
template <bool TALL = false, class Epi>
__device__ __forceinline__ void gemm_bf16(const bf16_t* A, int lda, const bf16_t* Bt, int ldb, int mtiles, int ntiles, int K, char* smem, Epi epi, const int GX, int vb0 = 0, int tall_mt = -1,
                                          const float* midk = nullptr) {
    const int tid = opaque_v((int)threadIdx.x);
    int bid0 = (int)blockIdx.x - vb0;
    while (bid0 < 0) bid0 += GX;
    const int bid = opaque_s(__builtin_amdgcn_readfirstlane(bid0));
    const int wid = tid >> 6, lane = tid & 63, wm = wid >> 1, wn = wid & 1, fr = lane & 15, fq = lane >> 4;
    const int nk = K / 64, total = mtiles * ntiles, G = GX;
    const bool xcd = (G & 7) == 0;
    const int nq = G >> 3;
    for (int st = 0;; ++st) {
        const int id = xcd ? ((st * 8 + (bid & 7)) * nq + (bid >> 3)) : (st * G + bid);
        if (st * G >= total) break;
        if (id >= total) continue;
        int mt, nt; tile_map(id, mtiles, ntiles, mt, nt);
        const int m0 = mt * 128, n0 = nt * 128;
        const bool tall = TALL && (mt == tall_mt);
        f32x4 acc[4][4], acc5[4];
#pragma unroll
        for (int i = 0; i < 4; ++i)
#pragma unroll
            for (int j = 0; j < 4; ++j) acc[i][j] = f32x4{0.f, 0.f, 0.f, 0.f};
#pragma unroll
        for (int j = 0; j < 4; ++j) acc5[j] = f32x4{0.f, 0.f, 0.f, 0.f};
        if (midk && tid < 160) {
            const float2 ss = *reinterpret_cast<const float2*>(midk + 2 * (size_t)(m0 + tid));
            reinterpret_cast<float*>(smem + 2 * G_STAGE)[tid] = sqrtf((ss.y * (1.f / 512.f) + EPSF) / (ss.x * (1.f / 512.f) + EPSF));
        }
        stage_tile<false>(A, lda, m0, 0, smem, tid, tall);
        stage_tile<true>(Bt, ldb, n0, 0, smem + G_ABYTES, tid);
        for (int kt = 0; kt < nk; ++kt) {
            asm volatile("s_waitcnt vmcnt(0)" ::: "memory");
            __syncthreads();
            if (kt + 1 < nk) {
                char* nb = smem + ((kt + 1) & 1) * G_STAGE;
                stage_tile<false>(A, lda, m0, (kt + 1) * 64, nb, tid, tall);
                stage_tile<true>(Bt, ldb, n0, (kt + 1) * 64, nb + G_ABYTES, tid);
            }
            if (midk && kt == (nk >> 1)) {
                const float* fb = reinterpret_cast<const float*>(smem + 2 * G_STAGE);
#pragma unroll
                for (int i = 0; i < 4; ++i) {
                    const float4 f4 = *reinterpret_cast<const float4*>(fb + wm * 64 + i * 16 + fq * 4);
#pragma unroll
                    for (int j = 0; j < 4; ++j) { acc[i][j][0] *= f4.x; acc[i][j][1] *= f4.y; acc[i][j][2] *= f4.z; acc[i][j][3] *= f4.w; }
                }
                if (tall) {
                    const float4 f4 = *reinterpret_cast<const float4*>(fb + 128 + wm * 16 + fq * 4);
#pragma unroll
                    for (int j = 0; j < 4; ++j) { acc5[j][0] *= f4.x; acc5[j][1] *= f4.y; acc5[j][2] *= f4.z; acc5[j][3] *= f4.w; }
                }
            }
            const char* ab = smem + (kt & 1) * G_STAGE;
            const char* bb = ab + G_ABYTES;
#pragma unroll
            for (int s2 = 0; s2 < 2; ++s2) {
                bf16x8 a[4], b[4];
#pragma unroll
                for (int i = 0; i < 4; ++i) a[i] = *reinterpret_cast<const bf16x8*>(ab + lds_byte(wm * 64 + i * 16 + fr, s2 * 32 + fq * 8));
#pragma unroll
                for (int j = 0; j < 4; ++j) b[j] = *reinterpret_cast<const bf16x8*>(bb + lds_byte(wn * 64 + j * 16 + fr, s2 * 32 + fq * 8));
#pragma unroll
                for (int i = 0; i < 4; ++i)
#pragma unroll
                    for (int j = 0; j < 4; ++j) acc[i][j] = __builtin_amdgcn_mfma_f32_16x16x32_bf16(a[i], b[j], acc[i][j], 0, 0, 0);
                if (tall) {
                    const bf16x8 a5 = *reinterpret_cast<const bf16x8*>(ab + lds_byte(128 + wm * 16 + fr, s2 * 32 + fq * 8));
#pragma unroll
                    for (int j = 0; j < 4; ++j) acc5[j] = __builtin_amdgcn_mfma_f32_16x16x32_bf16(a5, b[j], acc5[j], 0, 0, 0);
                }
            }
        }
#pragma unroll
        for (int i = 0; i < 4; ++i) epi.blk(m0 + wm * 64 + i * 16 + fq * 4, n0 + wn * 64 + fr * 4, acc[i]);
        if (tall) epi.blk(m0 + 128 + wm * 16 + fq * 4, n0 + wn * 64 + fr * 4, acc5);
        __syncthreads();
    }
}
#define EPI_ROWS __device__ __forceinline__ void blk(int m, int n, const f32x4 (&c)[4]) const { \
    row4(m + 0, n, c[0][0], c[1][0], c[2][0], c[3][0]); row4(m + 1, n, c[0][1], c[1][1], c[2][1], c[3][1]); \
    row4(m + 2, n, c[0][2], c[1][2], c[2][2], c[3][2]); row4(m + 3, n, c[0][3], c[1][3], c[2][3], c[3][3]); }
__device__ __forceinline__ uint2 pack4(float a, float b, float c, float d) { uint2 r; r.x = pack_bf16(a, b); r.y = pack_bf16(c, d); return r; }
struct EpiGateA { float* ya; const bf16_t* gab; const float* ssy;
    __device__ __forceinline__ void row4(int m, int n, float v0, float v1, float v2, float v3) const {
        const uint2 g = *reinterpret_cast<const uint2*>(gab + (size_t)m * 2048 + n);
        const float r1 = rsqrtf(ssy[2 * (size_t)m + 1] * (1.f / 512.f) + EPSF);
        *reinterpret_cast<float4*>(ya + (size_t)m * DM + n) = make_float4(bflo(g.x) * v0 * r1, bfhi(g.x) * v1 * r1, bflo(g.y) * v2 * r1, bfhi(g.y) * v3 * r1);
    } EPI_ROWS };
struct EpiGateB { const float* ya; const bf16_t* gab; bf16_t* mixb;
    __device__ __forceinline__ void row4(int m, int n, float v0, float v1, float v2, float v3) const {
        const uint2 g = *reinterpret_cast<const uint2*>(gab + (size_t)m * 2048 + 1024 + n);
        const float4 y = *reinterpret_cast<const float4*>(ya + (size_t)m * DM + n);
        *reinterpret_cast<uint2*>(mixb + (size_t)m * DM + n) = pack4(y.x + bflo(g.x) * v0, y.y + bfhi(g.x) * v1, y.z + bflo(g.y) * v2, y.w + bfhi(g.y) * v3);
    } EPI_ROWS };
struct EpiStore { float* C; int ldc; int N;
    __device__ __forceinline__ void row4(int m, int n, float v0, float v1, float v2, float v3) const { if (n < N) *reinterpret_cast<float4*>(C + (size_t)m * ldc + n) = make_float4(v0, v1, v2, v3); } EPI_ROWS };
struct EpiStoreBfCol { bf16_t* C; int ldc; const float* cs;
    __device__ __forceinline__ void row4(int m, int n, float v0, float v1, float v2, float v3) const {
        const float4 c4 = *reinterpret_cast<const float4*>(cs + n);
        *reinterpret_cast<uint2*>(C + (size_t)m * ldc + n) = pack4(v0 * c4.x, v1 * c4.y, v2 * c4.z, v3 * c4.w);
    } EPI_ROWS };
struct EpiScaleRow { float* C; int ldc; const float* sumsq;
    __device__ __forceinline__ void row4(int m, int n, float v0, float v1, float v2, float v3) const {
        const float rs = rsqrtf(sumsq[m] * (1.f / DM) + EPSF);
        *reinterpret_cast<float4*>(C + (size_t)m * ldc + n) = make_float4(v0 * rs, v1 * rs, v2 * rs, v3 * rs);
    } EPI_ROWS };
struct EpiResidRow { float* xres; bf16_t* xb; float* sumsq;
    __device__ __forceinline__ void row4(int m, int n, float v0, float v1, float v2, float v3) const {
        float4* xp = reinterpret_cast<float4*>(xres + (size_t)m * DM + n);
        float4 x = *xp;
        x.x += v0; x.y += v1; x.z += v2; x.w += v3;
        *xp = x;
        *reinterpret_cast<uint2*>(xb + (size_t)m * DM + n) = pack4(x.x, x.y, x.z, x.w);
        float ss = x.x * x.x + x.y * x.y + x.z * x.z + x.w * x.w;
        ss += __shfl_xor(ss, 1); ss += __shfl_xor(ss, 2); ss += __shfl_xor(ss, 4); ss += __shfl_xor(ss, 8);
        if ((threadIdx.x & 15) == 0) atomicAdd(sumsq + m, ss);
    } EPI_ROWS };
struct EpiQRope { bf16_t* qb; float* q; const float* rope; const float* ssq;
    __device__ __forceinline__ void row4(int m, int n, float a0, float a1, float a2, float a3) const {
        const float rq = rsqrtf(ssq[m] * (1.f / QL) + EPSF);
        const float v0 = a0 * rq, v1 = a1 * rq, v2 = a2 * rq, v3 = a3 * rq;
        const float o0 = __shfl_xor(v0, 4), o1 = __shfl_xor(v1, 4), o2 = __shfl_xor(v2, 4), o3 = __shfl_xor(v3, 4);
        const int d = n % 96;
        float r0 = v0, r1 = v1, r2 = v2, r3 = v3;
        if (d >= 64) {
            const int pi = (m < NPT) ? (m & (SEQ - 1)) : 2048;
            const int dd = d - 64, jj = dd & 15;
            const float4 cs = *reinterpret_cast<const float4*>(rope + pi * 16 + jj);
            const float4 sn = *reinterpret_cast<const float4*>(rope + 2049 * 16 + pi * 16 + jj);
            if (dd < 16) { r0 = v0 * cs.x - o0 * sn.x; r1 = v1 * cs.y - o1 * sn.y; r2 = v2 * cs.z - o2 * sn.z; r3 = v3 * cs.w - o3 * sn.w; }
            else { r0 = o0 * sn.x + v0 * cs.x; r1 = o1 * sn.y + v1 * cs.y; r2 = o2 * sn.z + v2 * cs.z; r3 = o3 * sn.w + v3 * cs.w; }
        }
        const float qsc = ATT_SCALE * 1.4426950408889634f;
        *reinterpret_cast<uint2*>(qb + (size_t)m * 768 + n) = pack4(r0 * qsc, r1 * qsc, r2 * qsc, r3 * qsc);
        if (m >= NPT) *reinterpret_cast<float4*>(q + (size_t)m * 768 + n) = make_float4(r0, r1, r2, r3);
    } EPI_ROWS };
struct EpiStoreBf { bf16_t* C; int ldc;
    __device__ __forceinline__ void row4(int m, int n, float v0, float v1, float v2, float v3) const { *reinterpret_cast<uint2*>(C + (size_t)m * ldc + n) = pack4(v0, v1, v2, v3); } EPI_ROWS };
__device__ __forceinline__ void ph_convert_plain(const float* src, bf16_t* dst, size_t n, const int GX) {
    const int tid = opaque_v((int)threadIdx.x); const int bid = opaque_s((int)blockIdx.x);
    for (size_t i = ((size_t)bid * NTHR + tid) * 4; i < n; i += (size_t)GX * NTHR * 4) {
        float4 v = *(const float4*)(src + i);
        ushort4 o; o.x = f2bf(v.x); o.y = f2bf(v.y); o.z = f2bf(v.z); o.w = f2bf(v.w);
        *(ushort4*)(dst + i) = o;
    }
}
__device__ __forceinline__ void ph_convert_w(const float* W, int K, int N, int Npad, bf16_t* Bt, char* smem, const int GX, const float* kscale = nullptr) {
    const int tid = opaque_v((int)threadIdx.x); const int bid = opaque_s((int)blockIdx.x);
    float (*t)[65] = (float (*)[65])smem;
    int tk = K / 64, tn = Npad / 64;
    for (int vb = bid; vb < tk * tn; vb += GX) {
        int k0 = (vb % tk) * 64, n0 = (vb / tk) * 64;
        for (int i = tid; i < 64 * 64; i += NTHR) {
            int kk = i >> 6, nn = i & 63;
            t[kk][nn] = (n0 + nn < N) ? W[(size_t)(k0 + kk) * N + n0 + nn] * (kscale ? kscale[k0 + kk] : 1.f) : 0.f;
        }
        __syncthreads();
        for (int i = tid; i < 64 * 64; i += NTHR) {
            int nn = i >> 6, kk = i & 63;
            Bt[(size_t)(n0 + nn) * K + k0 + kk] = f2bf(t[kk][nn]);
        }
        __syncthreads();
    }
}

__device__ __forceinline__ void ph_rope_table(const P& p) {
    const int GX = p.grid;
    const int tid_ = opaque_v((int)threadIdx.x); const int bid_ = opaque_s((int)blockIdx.x); (void)tid_; (void)bid_;
    for (int i = bid_ * NTHR + tid_; i < 2049 * 16; i += GX * NTHR) {
        int pi = i / 16, j = i % 16;
        float pos = (pi == 2048) ? 16384.f : (float)pi;
        float inv = powf(10000.f, -(float)j / 16.f);
        float ang = pos * inv;
        p.rope[i] = (float)cos((double)ang);
        p.rope[2049 * 16 + i] = (float)sin((double)ang);
    }
}
__device__ __forceinline__ void ph_copy_x(const P& p) {
    const int GX = p.grid;
    const int tid_ = opaque_v((int)threadIdx.x); const int bid_ = opaque_s((int)blockIdx.x);
    const int wid = tid_ >> 6, lane = tid_ & 63;
    for (int t = bid_ * 4 + wid; t < NT; t += GX * 4) {
        const float* src = (t < NPT) ? (p.x_prompt + (size_t)t * DM) : (p.x_sample + (size_t)(t - NPT) * DM);
        const float4* sp = reinterpret_cast<const float4*>(src + lane * 16);
        float4 v[4]; float ss = 0.f;
#pragma unroll
        for (int q4 = 0; q4 < 4; ++q4) { v[q4] = sp[q4]; ss += v[q4].x * v[q4].x + v[q4].y * v[q4].y + v[q4].z * v[q4].z + v[q4].w * v[q4].w; }
        ss = wave_sum(ss);
        float4* xp = reinterpret_cast<float4*>(p.xres + (size_t)t * DM + lane * 16);
#pragma unroll
        for (int q4 = 0; q4 < 4; ++q4) xp[q4] = v[q4];
        uint4 b0, b1;
        b0.x = pack_bf16(v[0].x, v[0].y); b0.y = pack_bf16(v[0].z, v[0].w); b0.z = pack_bf16(v[1].x, v[1].y); b0.w = pack_bf16(v[1].z, v[1].w);
        b1.x = pack_bf16(v[2].x, v[2].y); b1.y = pack_bf16(v[2].z, v[2].w); b1.z = pack_bf16(v[3].x, v[3].y); b1.w = pack_bf16(v[3].z, v[3].w);
        uint4* bp = reinterpret_cast<uint4*>(p.xb + (size_t)t * DM + lane * 16);
        bp[0] = b0; bp[1] = b1;
        if (lane == 0) p.rstd[t] = rsqrtf(ss * (1.f / DM) + EPSF);
    }
}
__device__ __forceinline__ void ph_rmsnorm(const float* in, int ldi, const float* w, float* out, int ldo, bf16_t* outb, int ldob, int D, int rows, const int GX) {
    const int tid_ = opaque_v((int)threadIdx.x); const int bid_ = opaque_s((int)blockIdx.x); (void)tid_; (void)bid_;
    VB_LOOP((rows + 3) / 4) {
        int row = vb * 4 + (tid_ >> 6);
        int lane = tid_ & 63;
        if (row < rows) {
            const float* x = in + (size_t)row * ldi;
            float s = 0.f;
            for (int c = lane; c < D; c += 64) { float v = x[c]; s += v * v; }
            s = wave_sum(s);
            float r = rsqrtf(s / (float)D + EPSF);
            for (int c = lane; c < D; c += 64) {
                float v = x[c] * r * w[c];
                if (out) out[(size_t)row * ldo + c] = v;
                if (outb) outb[(size_t)row * ldob + c] = f2bf(v);
            }
        }
    }
}
__device__ __forceinline__ void ph_ssd_seq(const P& p, int layer) {
    const int GX = p.grid;
    const int tid_ = opaque_v((int)threadIdx.x); const int bid_ = opaque_s((int)blockIdx.x); (void)tid_; (void)bid_;
    VB_LOOP(NS * 16) {
        int seq = NB + vb / 16, e = vb % 16, g = e / 8;
        int pp = tid_ >> 2, nq = tid_ & 3;
        float A = -expf(p.a_log[layer * 16 + e]);
        float Dk = p.d_skip[layer * 16 + e];
        float s[32];
        int t0, L;
        float* hout;
        if (seq < NB) {
            t0 = seq * SEQ; L = SEQ;
#pragma unroll
            for (int j = 0; j < 32; ++j) s[j] = 0.f;
            hout = p.out + O_SSMP + (((size_t)(layer * NB + seq) * 16 + e) * 64 + pp) * 128 + nq * 32;
        } else {
            int bs = seq - NB;
            t0 = NPT + bs; L = 1;
            const float* h0 = p.state_ssm + (((size_t)(layer * NS + bs) * 16 + e) * 64 + pp) * 128 + nq * 32;
#pragma unroll
            for (int j = 0; j < 32; ++j) s[j] = h0[j];
            hout = p.out + O_SSMS + (((size_t)(layer * NS + bs) * 16 + e) * 64 + pp) * 128 + nq * 32;
        }
        for (int l = 0; l < L; ++l) {
            int t = t0 + l;
            float dt = p.dt[t * 16 + e];
            float dA = expf(dt * A);
            const bf16_t* xr = p.xbcb + (size_t)t * CONVD;
            float xv = bf2f(xr[e * 64 + pp]);
            float xdt = xv * dt;
            const bf16_t* Bp = xr + 1024 + g * 128 + nq * 32;
            const bf16_t* Cp = xr + 1280 + g * 128 + nq * 32;
            float ys = 0.f;
#pragma unroll
            for (int j4 = 0; j4 < 8; ++j4) {
                float4 b, c;
                b.x = bf2f(Bp[j4 * 4]); b.y = bf2f(Bp[j4 * 4 + 1]); b.z = bf2f(Bp[j4 * 4 + 2]); b.w = bf2f(Bp[j4 * 4 + 3]);
                c.x = bf2f(Cp[j4 * 4]); c.y = bf2f(Cp[j4 * 4 + 1]); c.z = bf2f(Cp[j4 * 4 + 2]); c.w = bf2f(Cp[j4 * 4 + 3]);
                s[j4 * 4 + 0] = s[j4 * 4 + 0] * dA + xdt * b.x; ys += c.x * s[j4 * 4 + 0];
                s[j4 * 4 + 1] = s[j4 * 4 + 1] * dA + xdt * b.y; ys += c.y * s[j4 * 4 + 1];
                s[j4 * 4 + 2] = s[j4 * 4 + 2] * dA + xdt * b.z; ys += c.z * s[j4 * 4 + 2];
                s[j4 * 4 + 3] = s[j4 * 4 + 3] * dA + xdt * b.w; ys += c.w * s[j4 * 4 + 3];
            }
            ys += __shfl_xor(ys, 1);
            ys += __shfl_xor(ys, 2);
            if (nq == 0) {
                const float yg = (ys + Dk * xv) * bf2f(p.zs[(size_t)t * DM + e * 64 + pp]);
                p.ygb[(size_t)t * DM + e * 64 + pp] = f2bf(yg);
                atomicAdd(p.ssy + ((size_t)layer * TP + t) * 2 + g, yg * yg);
            }
        }
#pragma unroll
        for (int j = 0; j < 32; ++j) hout[j] = s[j];
    }
}
__device__ __forceinline__ void ph_gate_norm(const P& p, int layer) {
    const int GX = p.grid;
    const int tid_ = opaque_v((int)threadIdx.x); const int bid_ = opaque_s((int)blockIdx.x); (void)tid_; (void)bid_;
    VB_LOOP((NT * 2 + 3) / 4) {
        int w = vb * 4 + (tid_ >> 6);
        int lane = tid_ & 63;
        if (w < NT * 2) {
            int t = w >> 1, g = w & 1;
            float v[8];
            float ss = 0.f;
#pragma unroll
            for (int j = 0; j < 8; ++j) {
                int c = g * 512 + j * 64 + lane;
                float y = p.yraw[(size_t)t * DM + c];
                v[j] = y * bf2f(p.zs[(size_t)t * DM + c]);
                ss += v[j] * v[j];
            }
            ss = wave_sum(ss);
            float r = rsqrtf(ss / 512.f + EPSF);
#pragma unroll
            for (int j = 0; j < 8; ++j) {
                int c = g * 512 + j * 64 + lane;
                p.ynb[(size_t)t * DM + c] = f2bf(v[j] * r * p.ssm_norm[layer * DM + c]);
            }
        }
    }
}
__device__ __forceinline__ void ph_lat_kpe(const P& p, int layer) {
    const int GX = p.grid;
    const int tid_ = opaque_v((int)threadIdx.x); const int bid_ = opaque_s((int)blockIdx.x);
    VB_LOOP((NT + 3) / 4) {
        int t = vb * 4 + (tid_ >> 6);
        int lane = tid_ & 63;
        if (t < NT) {
            const float4 c4 = *reinterpret_cast<const float4*>(p.ckv + (size_t)t * KVL + lane * 4);
            float ss = wave_sum(c4.x * c4.x + c4.y * c4.y + c4.z * c4.z + c4.w * c4.w);
            const float r = rsqrtf(ss * (1.f / KVL) + EPSF);
            const float4 g4 = *reinterpret_cast<const float4*>(p.kv_norm + layer * KVL + lane * 4);
            const float4 l4 = make_float4(c4.x * r * g4.x, c4.y * r * g4.y, c4.z * r * g4.z, c4.w * r * g4.w);
            *reinterpret_cast<float4*>(p.lat + (size_t)t * KVL + lane * 4) = l4;
            *reinterpret_cast<uint2*>(p.latb + (size_t)t * KVL + lane * 4) = pack4(l4.x, l4.y, l4.z, l4.w);
            float* ol = (t < NPT) ? (p.out + O_LATP + ((size_t)layer * NPT + t) * KVL) : (p.out + O_LATS + ((size_t)layer * NS + (t - NPT)) * KVL);
            *reinterpret_cast<float4*>(ol + lane * 4) = l4;
            if (lane < 16) {
                int pi = (t < NPT) ? (t % SEQ) : 2048;
                const float* cs = p.rope + pi * 16;
                const float* sn = p.rope + 2049 * 16 + pi * 16;
                const float* kr = p.kr + (size_t)t * 32;
                float x1 = kr[lane], x2 = kr[16 + lane];
                float o1 = x1 * cs[lane] - x2 * sn[lane];
                float o2 = x1 * sn[lane] + x2 * cs[lane];
                p.kpe[(size_t)t * 32 + lane] = o1;
                p.kpe[(size_t)t * 32 + 16 + lane] = o2;
                p.kpeb[(size_t)t * 32 + lane] = f2bf(o1);
                p.kpeb[(size_t)t * 32 + 16 + lane] = f2bf(o2);
                float* ok = (t < NPT) ? (p.out + O_KRP + ((size_t)layer * NPT + t) * 32) : (p.out + O_KRS + ((size_t)layer * NS + (t - NPT)) * 32);
                ok[lane] = o1; ok[16 + lane] = o2;
            }
        }
    }
}

#define A_KRS 208
#define A_VRS 144
#define A_KBYTES (64 * A_KRS)
#define A_BUF (64 * A_KRS + 64 * A_VRS)
struct EpiKV { bf16_t* kn; bf16_t* vT; const float* sskv;
    __device__ __forceinline__ void blk(int m, int n, const f32x4 (&c)[4]) const {
        const int h = n >> 7, j = n & 127;
        float rk[4];
#pragma unroll
        for (int r = 0; r < 4; ++r) rk[r] = rsqrtf(sskv[m + r] * (1.f / KVL) + EPSF);
        if (j < 64) {
#pragma unroll
            for (int r = 0; r < 4; ++r) *reinterpret_cast<uint2*>(kn + (size_t)(m + r) * 512 + h * 64 + j) = pack4(c[0][r] * rk[r], c[1][r] * rk[r], c[2][r] * rk[r], c[3][r] * rk[r]);
        } else if (m < NPT) {
#pragma unroll
            for (int jj = 0; jj < 4; ++jj)
                *reinterpret_cast<uint2*>(vT + ((size_t)((m >> 11) * 8 + h) * 64 + (j - 64 + jj)) * SEQ + (m & (SEQ - 1))) = pack4(c[jj][0] * rk[0], c[jj][1] * rk[1], c[jj][2] * rk[2], c[jj][3] * rk[3]);
        }
    } };
__device__ __forceinline__ void attn_unit(const P& p, char* smem, int o, int tid) {
    const int wid = tid >> 6, lane = tid & 63, fr = lane & 15, fq = lane >> 4;
    {
        const int qblk = 15 - (o >> 6), bh = o & 63, b = bh >> 3, h = bh & 7;
        const int q0w = qblk * 128 + wid * 32;
        const size_t tok0 = (size_t)b * SEQ;
        bf16x8 qf[2][3];
#pragma unroll
        for (int qt = 0; qt < 2; ++qt)
#pragma unroll
            for (int s3 = 0; s3 < 3; ++s3)
                qf[qt][s3] = *reinterpret_cast<const bf16x8*>(p.qb + (tok0 + q0w + qt * 16 + fr) * 768 + h * 96 + s3 * 32 + fq * 8);
        f32x4 oacc[2][4];
        float mrun[2], lrun[2];
#pragma unroll
        for (int qt = 0; qt < 2; ++qt) {
            mrun[qt] = -INFINITY; lrun[qt] = 0.f;
#pragma unroll
            for (int mt = 0; mt < 4; ++mt) oacc[qt][mt] = f32x4{0.f, 0.f, 0.f, 0.f};
        }
        const int nkb = 2 * qblk + 2;
        uint4 stg0, stg1, stg2, stg3, stg4;
#define A_ISSUE(kb_) do { const size_t key0 = (size_t)(kb_) * 64; \
            { int c = tid; int row = c >> 3, ch = c & 7; stg0 = *reinterpret_cast<const uint4*>(p.kn + (tok0 + key0 + row) * 512 + h * 64 + ch * 8); } \
            { int c = tid + 256; int row = c >> 3, ch = c & 7; stg1 = *reinterpret_cast<const uint4*>(p.kn + (tok0 + key0 + row) * 512 + h * 64 + ch * 8); } \
            { int c = tid; int row = c >> 2, ch = c & 3; stg2 = *reinterpret_cast<const uint4*>(p.kpeb + (tok0 + key0 + row) * 32 + ch * 8); } \
            { int c = tid; int row = c >> 3, ch = c & 7; stg3 = *reinterpret_cast<const uint4*>(p.vT + ((size_t)(b * 8 + h) * 64 + row) * SEQ + key0 + ch * 8); } \
            { int c = tid + 256; int row = c >> 3, ch = c & 7; stg4 = *reinterpret_cast<const uint4*>(p.vT + ((size_t)(b * 8 + h) * 64 + row) * SEQ + key0 + ch * 8); } \
        } while (0)
#define A_COMMIT(buf_) do { char* buf = (buf_); \
            { int c = tid; int row = c >> 3, ch = c & 7; *reinterpret_cast<uint4*>(buf + row * A_KRS + ch * 16) = stg0; } \
            { int c = tid + 256; int row = c >> 3, ch = c & 7; *reinterpret_cast<uint4*>(buf + row * A_KRS + ch * 16) = stg1; } \
            { int c = tid; int row = c >> 2, ch = c & 3; *reinterpret_cast<uint4*>(buf + row * A_KRS + 128 + ch * 16) = stg2; } \
            { int c = tid; int row = c >> 3, ch = c & 7; *reinterpret_cast<uint4*>(buf + A_KBYTES + row * A_VRS + ch * 16) = stg3; } \
            { int c = tid + 256; int row = c >> 3, ch = c & 7; *reinterpret_cast<uint4*>(buf + A_KBYTES + row * A_VRS + ch * 16) = stg4; } \
        } while (0)
        A_ISSUE(0);
        A_COMMIT(smem);
        __syncthreads();
        for (int kb = 0; kb < nkb; ++kb) {
            const char* kbuf = smem + (kb & 1) * A_BUF;
            const char* vbuf = kbuf + A_KBYTES;
            if (kb + 1 < nkb) A_ISSUE(kb + 1);
#pragma unroll
            for (int kh = 0; kh < 2; ++kh) {
                const int k0 = kb * 64 + kh * 32;
                if (k0 <= q0w + 31) {
                    f32x4 st[2][2];
#pragma unroll
                    for (int qt = 0; qt < 2; ++qt)
#pragma unroll
                        for (int kt = 0; kt < 2; ++kt) st[qt][kt] = f32x4{0.f, 0.f, 0.f, 0.f};
#pragma unroll
                    for (int s3 = 0; s3 < 3; ++s3)
#pragma unroll
                        for (int kt = 0; kt < 2; ++kt) {
                            bf16x8 kf = *reinterpret_cast<const bf16x8*>(kbuf + (kh * 32 + kt * 16 + fr) * A_KRS + (s3 * 32 + fq * 8) * 2);
#pragma unroll
                            for (int qt = 0; qt < 2; ++qt) st[qt][kt] = __builtin_amdgcn_mfma_f32_16x16x32_bf16(kf, qf[qt][s3], st[qt][kt], 0, 0, 0);
                        }
                    const bool need_mask = (k0 + 31 > q0w);
                    bf16x8 pf[2];
#pragma unroll
                    for (int qt = 0; qt < 2; ++qt) {
                        if (need_mask) {
                            const int qi = q0w + qt * 16 + fr;
#pragma unroll
                            for (int kt = 0; kt < 2; ++kt)
#pragma unroll
                                for (int r = 0; r < 4; ++r)
                                    if (k0 + kt * 16 + fq * 4 + r > qi) st[qt][kt][r] = -INFINITY;
                        }
                        float mx = fmaxf(fmaxf(fmaxf(st[qt][0][0], st[qt][0][1]), fmaxf(st[qt][0][2], st[qt][0][3])),
                                         fmaxf(fmaxf(st[qt][1][0], st[qt][1][1]), fmaxf(st[qt][1][2], st[qt][1][3])));
                        mx = fmaxf(mx, __shfl_xor(mx, 16));
                        mx = fmaxf(mx, __shfl_xor(mx, 32));
                        const float mnew = fmaxf(mrun[qt], mx);
                        const float corr = __builtin_amdgcn_exp2f(mrun[qt] - mnew);
                        float pv[8];
                        float rs = 0.f;
#pragma unroll
                        for (int kt = 0; kt < 2; ++kt)
#pragma unroll
                            for (int r = 0; r < 4; ++r) { pv[kt * 4 + r] = __builtin_amdgcn_exp2f(st[qt][kt][r] - mnew); rs += pv[kt * 4 + r]; }
                        rs += __shfl_xor(rs, 16);
                        rs += __shfl_xor(rs, 32);
                        lrun[qt] = lrun[qt] * corr + rs;
                        mrun[qt] = mnew;
#pragma unroll
                        for (int mt = 0; mt < 4; ++mt) { oacc[qt][mt][0] *= corr; oacc[qt][mt][1] *= corr; oacc[qt][mt][2] *= corr; oacc[qt][mt][3] *= corr; }
                        uint4 pk;
                        pk.x = pack_bf16(pv[0], pv[1]); pk.y = pack_bf16(pv[2], pv[3]); pk.z = pack_bf16(pv[4], pv[5]); pk.w = pack_bf16(pv[6], pv[7]);
                        pf[qt] = __builtin_bit_cast(bf16x8, pk);
                    }
#pragma unroll
                    for (int mt = 0; mt < 4; ++mt) {
                        const char* vp = vbuf + (mt * 16 + fr) * A_VRS + (kh * 32 + fq * 4) * 2;
                        uint2 lo = *reinterpret_cast<const uint2*>(vp);
                        uint2 hi = *reinterpret_cast<const uint2*>(vp + 32);
                        uint4 vv; vv.x = lo.x; vv.y = lo.y; vv.z = hi.x; vv.w = hi.y;
                        bf16x8 vf = __builtin_bit_cast(bf16x8, vv);
#pragma unroll
                        for (int qt = 0; qt < 2; ++qt) oacc[qt][mt] = __builtin_amdgcn_mfma_f32_16x16x32_bf16(vf, pf[qt], oacc[qt][mt], 0, 0, 0);
                    }
                }
            }
            if (kb + 1 < nkb) A_COMMIT(smem + ((kb + 1) & 1) * A_BUF);
            __syncthreads();
        }
#pragma unroll
        for (int qt = 0; qt < 2; ++qt) {
            const float inv = 1.f / lrun[qt];
            bf16_t* op = p.ob + (tok0 + q0w + qt * 16 + fr) * 512 + h * 64 + fq * 4;
#pragma unroll
            for (int mt = 0; mt < 4; ++mt) {
                uint2 w;
                w.x = pack_bf16(oacc[qt][mt][0] * inv, oacc[qt][mt][1] * inv);
                w.y = pack_bf16(oacc[qt][mt][2] * inv, oacc[qt][mt][3] * inv);
                *reinterpret_cast<uint2*>(op + mt * 16) = w;
            }
        }
    }
}
__device__ __forceinline__ void ph_qlat(const P& p, int layer) {
    const int GX = p.grid;
    const int tid_ = opaque_v((int)threadIdx.x); const int bid_ = opaque_s((int)blockIdx.x); (void)tid_; (void)bid_;
    VB_LOOP(NS * 8) {
        int bs = vb / 8, h = vb % 8;
        int r = tid_;
        const float* qp = p.q + (size_t)(NPT + bs) * 768 + h * 96;
        const float* w = p.w_kvb + (size_t)layer * 256 * 1024 + (size_t)r * 1024 + h * 128;
        float s = 0.f;
        for (int d = 0; d < 64; ++d) s += qp[d] * w[d];
        p.qlat[((size_t)bs * 8 + h) * 256 + r] = s * ATT_SCALE;
    }
}
__device__ __forceinline__ void ph_mix(const P& p, int layer) {
    const int GX = p.grid;
    const int tid_ = opaque_v((int)threadIdx.x); const int bid_ = opaque_s((int)blockIdx.x); (void)tid_; (void)bid_;
    const size_t n = (size_t)NT * DM;
    for (size_t i = (size_t)bid_ * NTHR + tid_; i < n; i += (size_t)GX * NTHR) {
        int t = (int)(i / DM), c = (int)(i % DM);
        float ga = bf2f(p.gab[(size_t)t * 2048 + c]);
        float gb = bf2f(p.gab[(size_t)t * 2048 + 1024 + c]);
        p.mixb[i] = f2bf(ga * p.ya[i] + gb * p.yb[i]);
    }
}

__device__ __forceinline__ float dot2bf(unsigned a, unsigned b, float c) {
    return __builtin_amdgcn_fdot2_f32_bf16(__builtin_bit_cast(bf16x2_t, a), __builtin_bit_cast(bf16x2_t, b), c, false);
}
typedef __attribute__((ext_vector_type(2))) float f32x2;
__device__ __forceinline__ void ph_convert_fp8(const float* src, unsigned char* dst, float* inv, int rows, const float* cscale, const int GX) {
    const int tid = opaque_v((int)threadIdx.x); const int bid = opaque_s((int)blockIdx.x);
    const int wid = tid >> 6, lane = tid & 63;
    for (int r = bid * 4 + wid; r < rows; r += GX * 4) {
        const float4* sp = reinterpret_cast<const float4*>(src + (size_t)r * DM + lane * 16);
        float4 a = sp[0], b = sp[1], c = sp[2], d = sp[3];
        if (cscale) {
            const float4* cp = reinterpret_cast<const float4*>(cscale + (size_t)(r / NEXP) * DM + lane * 16);
            const float4 ca = cp[0], cb = cp[1], cc = cp[2], cd = cp[3];
            a.x *= ca.x; a.y *= ca.y; a.z *= ca.z; a.w *= ca.w; b.x *= cb.x; b.y *= cb.y; b.z *= cb.z; b.w *= cb.w;
            c.x *= cc.x; c.y *= cc.y; c.z *= cc.z; c.w *= cc.w; d.x *= cd.x; d.y *= cd.y; d.z *= cd.z; d.w *= cd.w;
        }
        float mx = fmaxf(fmaxf(fmaxf(fabsf(a.x), fabsf(a.y)), fmaxf(fabsf(a.z), fabsf(a.w))), fmaxf(fmaxf(fabsf(b.x), fabsf(b.y)), fmaxf(fabsf(b.z), fabsf(b.w))));
        mx = fmaxf(mx, fmaxf(fmaxf(fmaxf(fabsf(c.x), fabsf(c.y)), fmaxf(fabsf(c.z), fabsf(c.w))), fmaxf(fmaxf(fabsf(d.x), fabsf(d.y)), fmaxf(fabsf(d.z), fabsf(d.w)))));
        mx = fmaxf(wave_max(mx), 1e-30f);
        const float sc = 224.f / mx;
        uint4 o; int w;
        w = 0; w = __builtin_amdgcn_cvt_pk_fp8_f32(a.x * sc, a.y * sc, w, false); w = __builtin_amdgcn_cvt_pk_fp8_f32(a.z * sc, a.w * sc, w, true); o.x = (unsigned)w;
        w = 0; w = __builtin_amdgcn_cvt_pk_fp8_f32(b.x * sc, b.y * sc, w, false); w = __builtin_amdgcn_cvt_pk_fp8_f32(b.z * sc, b.w * sc, w, true); o.y = (unsigned)w;
        w = 0; w = __builtin_amdgcn_cvt_pk_fp8_f32(c.x * sc, c.y * sc, w, false); w = __builtin_amdgcn_cvt_pk_fp8_f32(c.z * sc, c.w * sc, w, true); o.z = (unsigned)w;
        w = 0; w = __builtin_amdgcn_cvt_pk_fp8_f32(d.x * sc, d.y * sc, w, false); w = __builtin_amdgcn_cvt_pk_fp8_f32(d.z * sc, d.w * sc, w, true); o.w = (unsigned)w;
        *reinterpret_cast<uint4*>(dst + (size_t)r * DM + lane * 16) = o;
        if (lane == 0) inv[r] = mx / 224.f;
    }
}
#define FP8_UNPACK16(v_, f_) do { \
    f32x2 t_; \
    t_ = __builtin_amdgcn_cvt_pk_f32_fp8((int)(v_).x, false); f_[0] = t_[0]; f_[1] = t_[1]; t_ = __builtin_amdgcn_cvt_pk_f32_fp8((int)(v_).x, true); f_[2] = t_[0]; f_[3] = t_[1]; \
    t_ = __builtin_amdgcn_cvt_pk_f32_fp8((int)(v_).y, false); f_[4] = t_[0]; f_[5] = t_[1]; t_ = __builtin_amdgcn_cvt_pk_f32_fp8((int)(v_).y, true); f_[6] = t_[0]; f_[7] = t_[1]; \
    t_ = __builtin_amdgcn_cvt_pk_f32_fp8((int)(v_).z, false); f_[8] = t_[0]; f_[9] = t_[1]; t_ = __builtin_amdgcn_cvt_pk_f32_fp8((int)(v_).z, true); f_[10] = t_[0]; f_[11] = t_[1]; \
    t_ = __builtin_amdgcn_cvt_pk_f32_fp8((int)(v_).w, false); f_[12] = t_[0]; f_[13] = t_[1]; t_ = __builtin_amdgcn_cvt_pk_f32_fp8((int)(v_).w, true); f_[14] = t_[0]; f_[15] = t_[1]; \
} while (0)
__device__ __forceinline__ void ph_peer_experts3(const P& p, int layer, bool dry = false) {
    const int GX = p.grid;
    const int tid = opaque_v((int)threadIdx.x); const int bid = opaque_s((int)blockIdx.x);
    const int wid = tid >> 6, lane = tid & 63;
    const unsigned char* U = p.u8 + (size_t)layer * NEXP * DM;
    const unsigned char* V = p.v8 + (size_t)layer * NEXP * DM;
    const float* IU = p.uinv + (size_t)layer * NEXP;
    const float* IV = p.vinv + (size_t)layer * NEXP;
    for (int t = bid * 4 + wid; t < NT; t += GX * 4) {
        float hx[16];
        {
            const uint4* hrow = reinterpret_cast<const uint4*>(p.xb + (size_t)t * DM + lane * 16);
            const uint4 h0 = hrow[0], h1 = hrow[1];
            hx[0] = bflo(h0.x); hx[1] = bfhi(h0.x); hx[2] = bflo(h0.y); hx[3] = bfhi(h0.y); hx[4] = bflo(h0.z); hx[5] = bfhi(h0.z); hx[6] = bflo(h0.w); hx[7] = bfhi(h0.w);
            hx[8] = bflo(h1.x); hx[9] = bfhi(h1.x); hx[10] = bflo(h1.y); hx[11] = bfhi(h1.y); hx[12] = bflo(h1.z); hx[13] = bfhi(h1.z); hx[14] = bflo(h1.w); hx[15] = bfhi(h1.w);
        }
        const int i0 = p.idx[(size_t)t * 128 + lane], i1 = p.idx[(size_t)t * 128 + 64 + lane];
        const float g0 = p.gate[(size_t)t * 128 + lane], g1 = p.gate[(size_t)t * 128 + 64 + lane];
        const float rs1 = rsqrtf(p.sumsq1[(size_t)layer * TP + t] * (1.f / DM) + EPSF);
        const float su0 = IU[i0] * rs1, su1 = IU[i1] * rs1;
        float w0 = 0.f, w1 = 0.f;
        uint4 nx[8];
#pragma unroll
        for (int j = 0; j < 8; ++j) nx[j] = *reinterpret_cast<const uint4*>(U + (size_t)__builtin_amdgcn_readlane(i0, j) * DM + lane * 16);
#pragma unroll 1
        for (int kk = 0; kk < 128; kk += 8) {
            uint4 cu[8];
#pragma unroll
            for (int j = 0; j < 8; ++j) cu[j] = nx[j];
            if (kk + 8 < 128) {
                const int ivn = (kk + 8 < 64) ? i0 : i1;
#pragma unroll
                for (int j = 0; j < 8; ++j) nx[j] = *reinterpret_cast<const uint4*>(U + (size_t)__builtin_amdgcn_readlane(ivn, (kk + 8 + j) & 63) * DM + lane * 16);
            }
            float sd[8];
#pragma unroll
            for (int j = 0; j < 8; ++j) {
                float f[16];
                FP8_UNPACK16(cu[j], f);
                float a = 0.f;
#pragma unroll
                for (int i = 0; i < 16; ++i) a += f[i] * hx[i];
                sd[j] = a;
            }
#pragma unroll
            for (int o = 32; o > 0; o >>= 1) {
#pragma unroll
                for (int j = 0; j < 8; ++j) sd[j] += __shfl_xor(sd[j], o);
            }
            {
                const int jl = (lane - kk) & 63;
                float xs = sd[0];
#pragma unroll
                for (int j = 1; j < 8; ++j) xs = (jl == j) ? sd[j] : xs;
                if (jl < 8) {
                    const float x = xs * ((kk < 64) ? su0 : su1);
                    const float act = 0.5f * x * (1.f + erff(x * 0.70710678118654752f));
                    if (kk < 64) w0 = g0 * act; else w1 = g1 * act;
                }
            }
        }
        w0 *= IV[i0]; w1 *= IV[i1];
        float acc[16];
#pragma unroll
        for (int i = 0; i < 16; ++i) acc[i] = 0.f;
#pragma unroll
        for (int j = 0; j < 8; ++j) nx[j] = *reinterpret_cast<const uint4*>(V + (size_t)__builtin_amdgcn_readlane(i0, j) * DM + lane * 16);
#pragma unroll 1
        for (int kk = 0; kk < 128; kk += 8) {
            uint4 cu[8];
#pragma unroll
            for (int j = 0; j < 8; ++j) cu[j] = nx[j];
            if (kk + 8 < 128) {
                const int ivn = (kk + 8 < 64) ? i0 : i1;
#pragma unroll
                for (int j = 0; j < 8; ++j) nx[j] = *reinterpret_cast<const uint4*>(V + (size_t)__builtin_amdgcn_readlane(ivn, (kk + 8 + j) & 63) * DM + lane * 16);
            }
            const float wv = (kk < 64) ? w0 : w1;
#pragma unroll
            for (int j = 0; j < 8; ++j) {
                const float w = __builtin_bit_cast(float, __builtin_amdgcn_readlane(__builtin_bit_cast(int, wv), (kk + j) & 63));
                float f[16];
                FP8_UNPACK16(cu[j], f);
#pragma unroll
                for (int i = 0; i < 16; ++i) acc[i] += w * f[i];
            }
        }
        float4* xp = reinterpret_cast<float4*>(p.xres + (size_t)t * DM + lane * 16);
        float4 xv[4]; float ss = 0.f;
#pragma unroll
        for (int q4 = 0; q4 < 4; ++q4) {
            float4 x = xp[q4];
            x.x += acc[q4 * 4 + 0]; x.y += acc[q4 * 4 + 1]; x.z += acc[q4 * 4 + 2]; x.w += acc[q4 * 4 + 3];
            xv[q4] = x; ss += x.x * x.x + x.y * x.y + x.z * x.z + x.w * x.w;
        }
        ss = wave_sum(ss);
        const float rs2 = rsqrtf(ss * (1.f / DM) + EPSF);
        if (dry) { if (rs2 == 123.456f) p.rstd[t] = rs2; }
        else if (layer + 1 < DEPTH) {
#pragma unroll
            for (int q4 = 0; q4 < 4; ++q4) xp[q4] = xv[q4];
            uint4 b0, b1;
            b0.x = pack_bf16(xv[0].x, xv[0].y); b0.y = pack_bf16(xv[0].z, xv[0].w); b0.z = pack_bf16(xv[1].x, xv[1].y); b0.w = pack_bf16(xv[1].z, xv[1].w);
            b1.x = pack_bf16(xv[2].x, xv[2].y); b1.y = pack_bf16(xv[2].z, xv[2].w); b1.z = pack_bf16(xv[3].x, xv[3].y); b1.w = pack_bf16(xv[3].z, xv[3].w);
            uint4* bp = reinterpret_cast<uint4*>(p.xb + (size_t)t * DM + lane * 16);
            bp[0] = b0; bp[1] = b1;
            if (lane == 0) p.rstd[t] = rs2;
        } else {
            const float4* np = reinterpret_cast<const float4*>(p.norm_final + lane * 16);
            float4* op = reinterpret_cast<float4*>(p.out + O_YP + (size_t)t * DM + lane * 16);
#pragma unroll
            for (int q4 = 0; q4 < 4; ++q4) {
                const float4 g = np[q4];
                float4 y; y.x = xv[q4].x * rs2 * g.x; y.y = xv[q4].y * rs2 * g.y; y.z = xv[q4].z * rs2 * g.z; y.w = xv[q4].w * rs2 * g.w;
                op[q4] = y;
            }
        }
    }
}

typedef __attribute__((ext_vector_type(4))) short s16x4;
#define S_XS 160
#define S_BS 288
#define S_HS 272
#define S_XR 0
#define S_BR (128 * S_XS)
#define S_HL (128 * S_XS + 128 * S_BS)
#define S_ACS (128 * S_XS + 128 * S_BS + 64 * S_HS)
#define S_DTL (S_ACS + 512)
#define S_WL (S_DTL + 512)
typedef __attribute__((address_space(3))) s16x4* lds_tr_ptr;
__device__ __forceinline__ bf16x8 tr_pair(const char* a0, const char* a1) {
    const s16x4 lo = __builtin_amdgcn_ds_read_tr16_b64_v4i16((lds_tr_ptr)a0);
    const s16x4 hi = __builtin_amdgcn_ds_read_tr16_b64_v4i16((lds_tr_ptr)a1);
    bf16x8 r; r[0] = lo[0]; r[1] = lo[1]; r[2] = lo[2]; r[3] = lo[3]; r[4] = hi[0]; r[5] = hi[1]; r[6] = hi[2]; r[7] = hi[3];
    return r;
}
__device__ __forceinline__ void ph_ssd_chunk(const P& p, int layer, char* smem) {
    const int GX = p.grid;
    const int tid = opaque_v((int)threadIdx.x); const int bid = opaque_s((int)blockIdx.x);
    const int wid = tid >> 6, lane = tid & 63, fr = lane & 15, fq = lane >> 4;
    float* acs = reinterpret_cast<float*>(smem + S_ACS);
    float* dtl = reinterpret_cast<float*>(smem + S_DTL);
    float* wl = reinterpret_cast<float*>(smem + S_WL);
    const int trr = fr >> 2, trc = (fr & 3) * 8;
    for (int u = bid; u < NB * 16; u += GX) {
        const int b = u >> 4, e = u & 15, g = e >> 3;
        const float A = -__expf(p.a_log[layer * 16 + e]);
        const float Dk = p.d_skip[layer * 16 + e];
        f32x4 hT[2][4];
#pragma unroll
        for (int i = 0; i < 2; ++i)
#pragma unroll
            for (int pt = 0; pt < 4; ++pt) hT[i][pt] = f32x4{0.f, 0.f, 0.f, 0.f};
#pragma unroll 1
        for (int c = 0; c < 16; ++c) {
            const size_t t0 = (size_t)b * SEQ + c * 128;
            if (wid == 0) {
                const float d0 = p.dt[(t0 + lane) * 16 + e], d1 = p.dt[(t0 + 64 + lane) * 16 + e];
                float s0 = d0 * A, s1 = d1 * A;
#pragma unroll
                for (int o = 1; o < 64; o <<= 1) {
                    float t0s = __shfl_up(s0, o), t1s = __shfl_up(s1, o);
                    if (lane >= o) { s0 += t0s; s1 += t1s; }
                }
                s1 += __shfl(s0, 63);
                const float aend = __shfl(s1, 63);
                acs[lane] = s0; acs[64 + lane] = s1; dtl[lane] = d0; dtl[64 + lane] = d1;
                wl[lane] = d0 * __expf(aend - s0); wl[64 + lane] = d1 * __expf(aend - s1);
            }
#pragma unroll
            for (int i = 0; i < 4; ++i) {
                const int id = tid + 256 * i, l = id >> 3, pc = id & 7;
                *reinterpret_cast<uint4*>(smem + S_XR + l * S_XS + pc * 16) = *reinterpret_cast<const uint4*>(p.xbcb + (t0 + l) * CONVD + e * 64 + pc * 8);
            }
#pragma unroll
            for (int i = 0; i < 8; ++i) {
                const int id = tid + 256 * i, l = id >> 4, nc = id & 15;
                *reinterpret_cast<uint4*>(smem + S_BR + l * S_BS + nc * 16) = *reinterpret_cast<const uint4*>(p.xbcb + (t0 + l) * CONVD + 1024 + g * 128 + nc * 8);
            }
#pragma unroll
            for (int i = 0; i < 2; ++i)
#pragma unroll
                for (int pt = 0; pt < 4; ++pt) {
                    uint2 w2;
                    w2.x = pack_bf16(hT[i][pt][0], hT[i][pt][1]); w2.y = pack_bf16(hT[i][pt][2], hT[i][pt][3]);
                    *reinterpret_cast<uint2*>(smem + S_HL + (pt * 16 + fr) * S_HS + (wid * 32 + i * 16 + fq * 4) * 2) = w2;
                }
            bf16x8 cf[2][4];
#pragma unroll
            for (int j = 0; j < 2; ++j)
#pragma unroll
                for (int k = 0; k < 4; ++k)
                    cf[j][k] = *reinterpret_cast<const bf16x8*>(p.xbcb + (t0 + wid * 32 + j * 16 + fr) * CONVD + 1280 + g * 128 + k * 32 + fq * 8);
            __syncthreads();
            f32x4 acc[4][2];
#pragma unroll
            for (int pt = 0; pt < 4; ++pt)
#pragma unroll
                for (int j = 0; j < 2; ++j) acc[pt][j] = f32x4{0.f, 0.f, 0.f, 0.f};
#pragma unroll
            for (int pt = 0; pt < 4; ++pt)
#pragma unroll
                for (int k = 0; k < 4; ++k) {
                    const bf16x8 hf = *reinterpret_cast<const bf16x8*>(smem + S_HL + (pt * 16 + fr) * S_HS + (k * 32 + fq * 8) * 2);
#pragma unroll
                    for (int j = 0; j < 2; ++j) acc[pt][j] = __builtin_amdgcn_mfma_f32_16x16x32_bf16(hf, cf[j][k], acc[pt][j], 0, 0, 0);
                }
            float alv[2];
#pragma unroll
            for (int j = 0; j < 2; ++j) {
                alv[j] = acs[wid * 32 + j * 16 + fr];
                const float el = __expf(alv[j]);
#pragma unroll
                for (int pt = 0; pt < 4; ++pt) { acc[pt][j][0] *= el; acc[pt][j][1] *= el; acc[pt][j][2] *= el; acc[pt][j][3] *= el; }
            }
#pragma unroll 1
            for (int ii = 0; ii <= wid; ++ii) {
                f32x4 cb[2][2];
#pragma unroll
                for (int si = 0; si < 2; ++si)
#pragma unroll
                    for (int j = 0; j < 2; ++j) cb[si][j] = f32x4{0.f, 0.f, 0.f, 0.f};
#pragma unroll
                for (int k = 0; k < 4; ++k)
#pragma unroll
                    for (int si = 0; si < 2; ++si) {
                        const bf16x8 bfr = *reinterpret_cast<const bf16x8*>(smem + S_BR + (ii * 32 + si * 16 + fr) * S_BS + (k * 32 + fq * 8) * 2);
#pragma unroll
                        for (int j = 0; j < 2; ++j) cb[si][j] = __builtin_amdgcn_mfma_f32_16x16x32_bf16(bfr, cf[j][k], cb[si][j], 0, 0, 0);
                    }
                bf16x8 mf[2];
                {
                    float as8[8], ds8[8];
#pragma unroll
                    for (int si = 0; si < 2; ++si) {
                        const float4 a4 = *reinterpret_cast<const float4*>(acs + ii * 32 + si * 16 + fq * 4);
                        const float4 d4 = *reinterpret_cast<const float4*>(dtl + ii * 32 + si * 16 + fq * 4);
                        as8[si * 4 + 0] = a4.x; as8[si * 4 + 1] = a4.y; as8[si * 4 + 2] = a4.z; as8[si * 4 + 3] = a4.w;
                        ds8[si * 4 + 0] = d4.x; ds8[si * 4 + 1] = d4.y; ds8[si * 4 + 2] = d4.z; ds8[si * 4 + 3] = d4.w;
                    }
#pragma unroll
                    for (int j = 0; j < 2; ++j) {
                        const int lidx = wid * 32 + j * 16 + fr;
                        float mv[8];
#pragma unroll
                        for (int si = 0; si < 2; ++si)
#pragma unroll
                            for (int r = 0; r < 4; ++r) {
                                const int sidx = ii * 32 + si * 16 + fq * 4 + r;
                                const float dec = __expf(fminf(alv[j] - as8[si * 4 + r], 0.f)) * ds8[si * 4 + r];
                                mv[si * 4 + r] = (lidx >= sidx) ? cb[si][j][r] * dec : 0.f;
                            }
                        uint4 pk;
                        pk.x = pack_bf16(mv[0], mv[1]); pk.y = pack_bf16(mv[2], mv[3]); pk.z = pack_bf16(mv[4], mv[5]); pk.w = pack_bf16(mv[6], mv[7]);
                        mf[j] = __builtin_bit_cast(bf16x8, pk);
                    }
                }
#pragma unroll
                for (int pt = 0; pt < 4; ++pt) {
                    const char* xa = smem + S_XR + (ii * 32 + fq * 4 + trr) * S_XS + pt * 32 + trc;
                    const bf16x8 xf = tr_pair(xa, xa + 16 * S_XS);
#pragma unroll
                    for (int j = 0; j < 2; ++j) acc[pt][j] = __builtin_amdgcn_mfma_f32_16x16x32_bf16(xf, mf[j], acc[pt][j], 0, 0, 0);
                }
            }
#pragma unroll
            for (int j = 0; j < 2; ++j) {
                const int ll = wid * 32 + j * 16 + fr;
                const size_t tl = t0 + ll;
                float ssl = 0.f;
#pragma unroll
                for (int pt = 0; pt < 4; ++pt) {
                    const uint2 xx = *reinterpret_cast<const uint2*>(smem + S_XR + ll * S_XS + (pt * 16 + fq * 4) * 2);
                    const uint2 zz = *reinterpret_cast<const uint2*>(p.zs + tl * DM + e * 64 + pt * 16 + fq * 4);
                    const float y0 = (acc[pt][j][0] + Dk * bflo(xx.x)) * bflo(zz.x), y1 = (acc[pt][j][1] + Dk * bfhi(xx.x)) * bfhi(zz.x);
                    const float y2 = (acc[pt][j][2] + Dk * bflo(xx.y)) * bflo(zz.y), y3 = (acc[pt][j][3] + Dk * bfhi(xx.y)) * bfhi(zz.y);
                    *reinterpret_cast<uint2*>(p.ygb + tl * DM + e * 64 + pt * 16 + fq * 4) = pack4(y0, y1, y2, y3);
                    ssl += y0 * y0 + y1 * y1 + y2 * y2 + y3 * y3;
                }
                ssl += __shfl_xor(ssl, 16);
                ssl += __shfl_xor(ssl, 32);
                if (fq == 0) atomicAdd(p.ssy + ((size_t)layer * TP + tl) * 2 + g, ssl);
            }
            {
                const float dec = __expf(acs[127]);
#pragma unroll
                for (int i = 0; i < 2; ++i)
#pragma unroll
                    for (int pt = 0; pt < 4; ++pt) { hT[i][pt][0] *= dec; hT[i][pt][1] *= dec; hT[i][pt][2] *= dec; hT[i][pt][3] *= dec; }
            }
#pragma unroll
            for (int k = 0; k < 4; ++k) {
                const float4 w0 = *reinterpret_cast<const float4*>(wl + k * 32 + fq * 8);
                const float4 w1 = *reinterpret_cast<const float4*>(wl + k * 32 + fq * 8 + 4);
                bf16x8 bt[2];
#pragma unroll
                for (int i = 0; i < 2; ++i) {
                    const char* ba = smem + S_BR + (k * 32 + fq * 8 + trr) * S_BS + (wid * 32 + i * 16) * 2 + trc;
                    bt[i] = tr_pair(ba, ba + 4 * S_BS);
                }
#pragma unroll
                for (int pt = 0; pt < 4; ++pt) {
                    const char* xa = smem + S_XR + (k * 32 + fq * 8 + trr) * S_XS + pt * 32 + trc;
                    const uint4 xr = __builtin_bit_cast(uint4, tr_pair(xa, xa + 4 * S_XS));
                    uint4 xs;
                    xs.x = pack_bf16(bflo(xr.x) * w0.x, bfhi(xr.x) * w0.y); xs.y = pack_bf16(bflo(xr.y) * w0.z, bfhi(xr.y) * w0.w);
                    xs.z = pack_bf16(bflo(xr.z) * w1.x, bfhi(xr.z) * w1.y); xs.w = pack_bf16(bflo(xr.w) * w1.z, bfhi(xr.w) * w1.w);
                    const bf16x8 xsf = __builtin_bit_cast(bf16x8, xs);
#pragma unroll
                    for (int i = 0; i < 2; ++i) hT[i][pt] = __builtin_amdgcn_mfma_f32_16x16x32_bf16(bt[i], xsf, hT[i][pt], 0, 0, 0);
                }
            }
            __syncthreads();
        }
#pragma unroll
        for (int i = 0; i < 2; ++i)
#pragma unroll
            for (int pt = 0; pt < 4; ++pt) {
                float4 hv; hv.x = hT[i][pt][0]; hv.y = hT[i][pt][1]; hv.z = hT[i][pt][2]; hv.w = hT[i][pt][3];
                *reinterpret_cast<float4*>(p.out + O_SSMP + (((size_t)(layer * NB + b) * 16 + e) * 64 + pt * 16 + fr) * 128 + wid * 32 + i * 16 + fq * 4) = hv;
            }
    }
}

__device__ __forceinline__ int med3i(int a, int b, int c) { return max(min(a, b), min(max(a, b), c)); }
__device__ __forceinline__ int okey(float v) { int o = __float_as_int(v); return o ^ ((o >> 31) & 0x7fffffff); }
__device__ __forceinline__ float okey_inv(int o) { return __int_as_float(o ^ ((o >> 31) & 0x7fffffff)); }
#define TK_INSERT(L_, key_) do { const int k_ = (key_); \
    L_[15] = med3i(L_[14], L_[15], k_); L_[14] = med3i(L_[13], L_[14], k_); L_[13] = med3i(L_[12], L_[13], k_); L_[12] = med3i(L_[11], L_[12], k_); \
    L_[11] = med3i(L_[10], L_[11], k_); L_[10] = med3i(L_[9], L_[10], k_); L_[9] = med3i(L_[8], L_[9], k_); L_[8] = med3i(L_[7], L_[8], k_); \
    L_[7] = med3i(L_[6], L_[7], k_); L_[6] = med3i(L_[5], L_[6], k_); L_[5] = med3i(L_[4], L_[5], k_); L_[4] = med3i(L_[3], L_[4], k_); \
    L_[3] = med3i(L_[2], L_[3], k_); L_[2] = med3i(L_[1], L_[2], k_); L_[1] = med3i(L_[0], L_[1], k_); L_[0] = max(L_[0], k_); } while (0)
#define TK_INS2(a_, b_) do { const float sv_ = V1[a_] + V2[b_]; TK_INSERT(M, (okey(sv_) & ~255) | (255 - ((a_) * 16 + (b_)))); } while (0)
__device__ __forceinline__ void ph_peer_topk2(const P& p) {
    const int GX = p.grid;
    const int tid = opaque_v((int)threadIdx.x); const int bid = opaque_s((int)blockIdx.x);
    for (int pr = bid * NTHR + tid; pr < NT * 8; pr += GX * NTHR) {
        const int t = pr >> 3, h = pr & 7;
        int L1[16], L2[16], M[16];
#pragma unroll
        for (int i = 0; i < 16; ++i) { L1[i] = (int)0x80000000; L2[i] = (int)0x80000000; M[i] = (int)0x80000000; }
        const float4* sp = reinterpret_cast<const float4*>(p.sc + (size_t)t * 2048 + h * 256);
#pragma unroll 1
        for (int k8 = 0; k8 < 4; ++k8) {
            float4 v[8];
#pragma unroll
            for (int q = 0; q < 8; ++q) v[q] = sp[k8 * 8 + q];
#pragma unroll
            for (int q = 0; q < 8; ++q) {
                const int kb = 127 - (k8 * 8 + q) * 4;
                TK_INSERT(L1, (okey(v[q].x) & ~127) | (kb - 0));
                TK_INSERT(L1, (okey(v[q].y) & ~127) | (kb - 1));
                TK_INSERT(L1, (okey(v[q].z) & ~127) | (kb - 2));
                TK_INSERT(L1, (okey(v[q].w) & ~127) | (kb - 3));
            }
        }
#pragma unroll 1
        for (int k8 = 0; k8 < 4; ++k8) {
            float4 v[8];
#pragma unroll
            for (int q = 0; q < 8; ++q) v[q] = sp[32 + k8 * 8 + q];
#pragma unroll
            for (int q = 0; q < 8; ++q) {
                const int kb = 127 - (k8 * 8 + q) * 4;
                TK_INSERT(L2, (okey(v[q].x) & ~127) | (kb - 0));
                TK_INSERT(L2, (okey(v[q].y) & ~127) | (kb - 1));
                TK_INSERT(L2, (okey(v[q].z) & ~127) | (kb - 2));
                TK_INSERT(L2, (okey(v[q].w) & ~127) | (kb - 3));
            }
        }
        float V1[16], V2[16];
#pragma unroll
        for (int i = 0; i < 16; ++i) { V1[i] = okey_inv(L1[i] & ~127); V2[i] = okey_inv(L2[i] & ~127); }
        TK_INS2(0, 0);
        TK_INS2(0, 1);
        TK_INS2(0, 2);
        TK_INS2(0, 3);
        TK_INS2(0, 4);
        TK_INS2(0, 5);
        TK_INS2(0, 6);
        TK_INS2(0, 7);
        TK_INS2(0, 8);
        TK_INS2(0, 9);
        TK_INS2(0, 10);
        TK_INS2(0, 11);
        TK_INS2(0, 12);
        TK_INS2(0, 13);
        TK_INS2(0, 14);
        TK_INS2(0, 15);
        TK_INS2(1, 0);
        TK_INS2(1, 1);
        TK_INS2(1, 2);
        TK_INS2(1, 3);
        TK_INS2(1, 4);
        TK_INS2(1, 5);
        TK_INS2(1, 6);
        TK_INS2(1, 7);
        TK_INS2(2, 0);
        TK_INS2(2, 1);
        TK_INS2(2, 2);
        TK_INS2(2, 3);
        TK_INS2(2, 4);
        TK_INS2(3, 0);
        TK_INS2(3, 1);
        TK_INS2(3, 2);
        TK_INS2(3, 3);
        TK_INS2(4, 0);
        TK_INS2(4, 1);
        TK_INS2(4, 2);
        TK_INS2(5, 0);
        TK_INS2(5, 1);
        TK_INS2(6, 0);
        TK_INS2(6, 1);
        TK_INS2(7, 0);
        TK_INS2(7, 1);
        TK_INS2(8, 0);
        TK_INS2(9, 0);
        TK_INS2(10, 0);
        TK_INS2(11, 0);
        TK_INS2(12, 0);
        TK_INS2(13, 0);
        TK_INS2(14, 0);
        TK_INS2(15, 0);
        float sv[16];
        int ex[16];
#pragma unroll
        for (int j = 0; j < 16; ++j) {
            const int c = 255 - (M[j] & 255);
            const int a = c >> 4, b = c & 15;
            int ka = L1[0], kb2 = L2[0];
            float va = V1[0], vb = V2[0];
#pragma unroll
            for (int i = 1; i < 16; ++i) {
                if (a == i) { ka = L1[i]; va = V1[i]; }
                if (b == i) { kb2 = L2[i]; vb = V2[i]; }
            }
            sv[j] = va + vb;
            ex[j] = (127 - (ka & 127)) * 128 + (127 - (kb2 & 127));
        }
        float sum = 0.f;
        float ev[16];
#pragma unroll
        for (int j = 0; j < 16; ++j) { ev[j] = __expf(sv[j] - sv[0]); sum += ev[j]; }
        const float inv = 1.f / sum;
        int* ip = p.idx + (size_t)t * 128 + h * 16;
        float* gp = p.gate + (size_t)t * 128 + h * 16;
#pragma unroll
        for (int j4 = 0; j4 < 4; ++j4) {
            *reinterpret_cast<int4*>(ip + j4 * 4) = make_int4(ex[j4 * 4], ex[j4 * 4 + 1], ex[j4 * 4 + 2], ex[j4 * 4 + 3]);
            *reinterpret_cast<float4*>(gp + j4 * 4) = make_float4(ev[j4 * 4] * inv, ev[j4 * 4 + 1] * inv, ev[j4 * 4 + 2] * inv, ev[j4 * 4 + 3] * inv);
        }
    }
}


#define D_RS 544
#define D_NCH 16
__device__ __forceinline__ uint4 pack8(const float4 a, const float4 b, float sc) {
    uint4 r; r.x = pack_bf16(a.x * sc, a.y * sc); r.y = pack_bf16(a.z * sc, a.w * sc); r.z = pack_bf16(b.x * sc, b.y * sc); r.w = pack_bf16(b.z * sc, b.w * sc); return r;
}
__device__ __forceinline__ void decode_unit(const P& p, int layer, char* smem, int u, int tid) {
    const int wid = tid >> 6, lane = tid & 63, fr = lane & 15, fq = lane >> 4;
    char* vbuf = smem + wid * (16 * D_RS);
    const float L2E = 1.4426950408889634f;
    {
        const int bs = u / D_NCH, ch = u % D_NCH;
        float* qls_f = reinterpret_cast<float*>(smem + 4 * 16 * D_RS + 9 * 64 * 16);
        {
            const float* wr = p.w_kvb + (size_t)layer * 256 * 1024 + (size_t)tid * 1024;
            const float* qrow = p.q + (size_t)(NPT + bs) * 768;
#pragma unroll 1
            for (int h = 0; h < 8; ++h) {
                float a = 0.f;
#pragma unroll
                for (int d4 = 0; d4 < 16; ++d4) {
                    const float4 w4 = *reinterpret_cast<const float4*>(wr + h * 128 + d4 * 4);
                    const float4 q4 = *reinterpret_cast<const float4*>(qrow + h * 96 + d4 * 4);
                    a += w4.x * q4.x + w4.y * q4.y + w4.z * q4.z + w4.w * q4.w;
                }
                qls_f[h * 256 + tid] = a * ATT_SCALE;
            }
        }
        __syncthreads();
        char* qls = smem + 4 * 16 * D_RS;
        {
            const int hh = fr & 7;
            const float zf = (fr < 8) ? 1.f : 0.f;
            const float* ql = qls_f + hh * 256 + fq * 8;
            const float* qr = p.q + (size_t)(NPT + bs) * 768 + hh * 96 + 64 + fq * 8;
#pragma unroll
            for (int j = 0; j < 3; ++j) {
                const int s9 = wid + 4 * j;
                if (s9 < 8) {
                    const float4 a = *reinterpret_cast<const float4*>(ql + s9 * 32), b = *reinterpret_cast<const float4*>(ql + s9 * 32 + 4);
                    *reinterpret_cast<uint4*>(qls + (s9 * 64 + lane) * 16) = pack8(a, b, L2E * zf);
                } else if (s9 == 8) {
                    const float4 a = *reinterpret_cast<const float4*>(qr), b = *reinterpret_cast<const float4*>(qr + 4);
                    *reinterpret_cast<uint4*>(qls + (s9 * 64 + lane) * 16) = pack8(a, b, ATT_SCALE * L2E * zf);
                }
            }
        }
        __syncthreads();
        f32x4 oacc[16];
#pragma unroll
        for (int dt = 0; dt < 16; ++dt) oacc[dt] = f32x4{0.f, 0.f, 0.f, 0.f};
        float mrun = -INFINITY, lrun = 0.f;
#pragma unroll 1
        for (int it = 0; it < 16; ++it) {
            const int ti = wid + 4 * it;
            const int pg = p.page_table[bs * NPAGES + ch * 8 + (ti >> 3)];
            const size_t krow = ((size_t)layer * NPOOL + pg) * PAGE + (ti & 7) * 16 + fr;
            const float* lp = p.cache_lat + krow * KVL + fq * 8;
            const float* rp = p.cache_kr + krow * 32 + fq * 8;
            bf16x8 kf[9];
            {
                float4 raw[10];
#pragma unroll
                for (int s9 = 0; s9 < 5; ++s9) { raw[2 * s9] = *reinterpret_cast<const float4*>(lp + s9 * 32); raw[2 * s9 + 1] = *reinterpret_cast<const float4*>(lp + s9 * 32 + 4); }
#pragma unroll
                for (int s9 = 0; s9 < 5; ++s9) kf[s9] = __builtin_bit_cast(bf16x8, pack8(raw[2 * s9], raw[2 * s9 + 1], 1.f));
            }
            {
                float4 raw[8];
#pragma unroll
                for (int s9 = 0; s9 < 3; ++s9) { raw[2 * s9] = *reinterpret_cast<const float4*>(lp + (5 + s9) * 32); raw[2 * s9 + 1] = *reinterpret_cast<const float4*>(lp + (5 + s9) * 32 + 4); }
                raw[6] = *reinterpret_cast<const float4*>(rp); raw[7] = *reinterpret_cast<const float4*>(rp + 4);
#pragma unroll
                for (int s9 = 0; s9 < 4; ++s9) kf[5 + s9] = __builtin_bit_cast(bf16x8, pack8(raw[2 * s9], raw[2 * s9 + 1], 1.f));
            }
            f32x4 st = f32x4{0.f, 0.f, 0.f, 0.f};
#pragma unroll
            for (int s9 = 0; s9 < 9; ++s9) st = __builtin_amdgcn_mfma_f32_16x16x32_bf16(kf[s9], *reinterpret_cast<const bf16x8*>(qls + (s9 * 64 + lane) * 16), st, 0, 0, 0);
#pragma unroll
            for (int s9 = 0; s9 < 8; ++s9) *reinterpret_cast<bf16x8*>(vbuf + fr * D_RS + (s9 * 32 + fq * 8) * 2) = kf[s9];
            float mx = fmaxf(fmaxf(st[0], st[1]), fmaxf(st[2], st[3]));
            mx = fmaxf(mx, __shfl_xor(mx, 16));
            mx = fmaxf(mx, __shfl_xor(mx, 32));
            const float mnew = fmaxf(mrun, mx);
            const float corr = __builtin_amdgcn_exp2f(mrun - mnew);
            const float p0 = __builtin_amdgcn_exp2f(st[0] - mnew), p1 = __builtin_amdgcn_exp2f(st[1] - mnew);
            const float p2 = __builtin_amdgcn_exp2f(st[2] - mnew), p3 = __builtin_amdgcn_exp2f(st[3] - mnew);
            float rs = (p0 + p1) + (p2 + p3);
            rs += __shfl_xor(rs, 16);
            rs += __shfl_xor(rs, 32);
            lrun = lrun * corr + rs;
            mrun = mnew;
#pragma unroll
            for (int dt = 0; dt < 16; ++dt) { oacc[dt][0] *= corr; oacc[dt][1] *= corr; oacc[dt][2] *= corr; oacc[dt][3] *= corr; }
            uint4 pk; pk.x = pack_bf16(p0, p1); pk.y = pack_bf16(p2, p3); pk.z = 0u; pk.w = 0u;
            const bf16x8 pf = __builtin_bit_cast(bf16x8, pk);
            const char* tb = vbuf + (fq * 4 + (fr >> 2)) * D_RS + (fr & 3) * 8;
#pragma unroll
            for (int dt = 0; dt < 16; ++dt) {
                const s16x4 lo = __builtin_amdgcn_ds_read_tr16_b64_v4i16((__attribute__((address_space(3))) s16x4*)(tb + dt * 32));
                bf16x8 vf; vf[0] = lo[0]; vf[1] = lo[1]; vf[2] = lo[2]; vf[3] = lo[3]; vf[4] = 0; vf[5] = 0; vf[6] = 0; vf[7] = 0;
                oacc[dt] = __builtin_amdgcn_mfma_f32_16x16x32_bf16(vf, pf, oacc[dt], 0, 0, 0);
            }
        }
        __syncthreads();
        float* wm = reinterpret_cast<float*>(smem + 65536);
        float* wl = wm + 64;
        float* ob = reinterpret_cast<float*>(smem);
        if (fq == 0) { wm[wid * 16 + fr] = mrun; wl[wid * 16 + fr] = lrun; }
        if (fr < 8) {
#pragma unroll
            for (int dt = 0; dt < 16; ++dt) {
                float4 v; v.x = oacc[dt][0]; v.y = oacc[dt][1]; v.z = oacc[dt][2]; v.w = oacc[dt][3];
                *reinterpret_cast<float4*>(ob + ((size_t)wid * 8 + fr) * 256 + dt * 16 + fq * 4) = v;
            }
        }
        __syncthreads();
        {
            float* pp = p.part + ((size_t)bs * D_NCH + ch) * 8 * 258;
#pragma unroll
            for (int h = 0; h < 8; ++h) {
                const float m0 = wm[h], m1 = wm[16 + h], m2 = wm[32 + h], m3 = wm[48 + h];
                const float M = fmaxf(fmaxf(m0, m1), fmaxf(m2, m3));
                const float e0 = __builtin_amdgcn_exp2f(m0 - M), e1 = __builtin_amdgcn_exp2f(m1 - M), e2 = __builtin_amdgcn_exp2f(m2 - M), e3 = __builtin_amdgcn_exp2f(m3 - M);
                const float a = ob[(0 * 8 + h) * 256 + tid] * e0 + ob[(1 * 8 + h) * 256 + tid] * e1 + ob[(2 * 8 + h) * 256 + tid] * e2 + ob[(3 * 8 + h) * 256 + tid] * e3;
                pp[h * 258 + 2 + tid] = a;
                if (tid == 0) { pp[h * 258] = M; pp[h * 258 + 1] = wl[h] * e0 + wl[16 + h] * e1 + wl[32 + h] * e2 + wl[48 + h] * e3; }
            }
        }
        __syncthreads();
    }
}
__device__ __forceinline__ void ph_attn_dec(const P& p, int layer, char* smem, unsigned* queue) {
    const int tid = opaque_v((int)threadIdx.x);
    unsigned* qslot = reinterpret_cast<unsigned*>(smem + 76000);
    for (;;) {
        __syncthreads();
        if (tid == 0) *qslot = __hip_atomic_fetch_add(queue, 1u, __ATOMIC_RELAXED, __HIP_MEMORY_SCOPE_AGENT);
        __syncthreads();
        const int o = (int)__builtin_amdgcn_readfirstlane((int)*qslot);
        if (o >= 1536) break;
        const int k3 = o / 3, r3 = o - 3 * k3;
        if (r3 == 0) decode_unit(p, layer, smem, k3, tid);
        else attn_unit(p, smem, 2 * k3 + r3 - 1, tid);
    }
}
__device__ __forceinline__ void ph_decode_comb2(const P& p, int layer, char* smem) {
    const int GX = p.grid;
    const int tid_ = opaque_v((int)threadIdx.x); const int bid_ = opaque_s((int)blockIdx.x);
    float* sw = (float*)smem;
    float* so = sw + 20;
    float* sLp = so + 256;
    VB_LOOP(NS * 8) {
        int bs = vb / 8, h = vb % 8, tid = tid_;
        const float* pb = p.part + (size_t)bs * D_NCH * 8 * 258 + h * 258;
        const float* latn = p.lat + (size_t)(NPT + bs) * KVL;
        if (tid < 64) {
            const float4 q4 = *reinterpret_cast<const float4*>(p.qlat + ((size_t)bs * 8 + h) * 256 + tid * 4);
            const float4 l4 = *reinterpret_cast<const float4*>(latn + tid * 4);
            float sn = q4.x * l4.x + q4.y * l4.y + q4.z * l4.z + q4.w * l4.w;
            if (tid < 32) sn += p.q[(size_t)(NPT + bs) * 768 + h * 96 + 64 + tid] * ATT_SCALE * p.kpe[(size_t)(NPT + bs) * 32 + tid];
            sn = wave_sum(sn) * 1.4426950408889634f;
            float m = sn;
            if (tid < D_NCH) m = fmaxf(m, pb[(size_t)tid * 8 * 258]);
            m = wave_max(m);
            float l = 0.f;
            if (tid < D_NCH) {
                float w = __builtin_amdgcn_exp2f(pb[(size_t)tid * 8 * 258] - m);
                sw[tid] = w;
                l = w * pb[(size_t)tid * 8 * 258 + 1];
            }
            const float wn = __builtin_amdgcn_exp2f(sn - m);
            if (tid == 0) { sw[D_NCH] = wn; l += wn; }
            l = wave_sum(l);
            if (tid == 0) sLp[0] = l;
        }
        __syncthreads();
        float a = sw[D_NCH] * latn[tid];
        for (int c = 0; c < D_NCH; ++c) a += sw[c] * pb[(size_t)c * 8 * 258 + 2 + tid];
        so[tid] = a / sLp[0];
        __syncthreads();
        if (tid < 64) {
            const float* w = p.w_kvb + (size_t)layer * 256 * 1024 + h * 128 + 64 + tid;
            float sacc = 0.f;
            for (int r = 0; r < 256; ++r) sacc += so[r] * w[(size_t)r * 1024];
            p.ob[(size_t)(NPT + bs) * 512 + h * 64 + tid] = f2bf(sacc);
        }
        __syncthreads();
    }
}


struct EpiInProj {
    bf16_t *gab, *zs, *xbr, *cqb, *ckvb; float *dt, *ckv, *kr, *out, *ssq, *sskv;
    const float *b_gate, *dt_bias, *rstd; int layer;
    __device__ __forceinline__ void row4(int m, int n, float a0, float a1, float a2, float a3) const {
        const float rs = rstd[m];
        const float v0 = a0 * rs, v1 = a1 * rs, v2 = a2 * rs, v3 = a3 * rs;
        if (n < 2048) {
            const float4 b4 = *reinterpret_cast<const float4*>(b_gate + layer * 2048 + n);
            *reinterpret_cast<uint2*>(gab + (size_t)m * 2048 + n) = pack4(sigmoid_f(v0 + b4.x), sigmoid_f(v1 + b4.y), sigmoid_f(v2 + b4.z), sigmoid_f(v3 + b4.w));
        } else if (n < 3072) {
            *reinterpret_cast<uint2*>(zs + (size_t)m * DM + (n - 2048)) = pack4(silu_f(v0), silu_f(v1), silu_f(v2), silu_f(v3));
        } else if (n < 4608) {
            const int c = n - 3072;
            *reinterpret_cast<uint2*>(xbr + (size_t)m * CONVD + c) = pack4(v0, v1, v2, v3);
            if (m < NPT) { const int l = m & (SEQ - 1); if (l >= SEQ - 3) *reinterpret_cast<float4*>(out + O_CONVP + ((size_t)(layer * NB + (m >> 11)) * 3 + (l - (SEQ - 3))) * CONVD + c) = make_float4(v0, v1, v2, v3); }
            else if (m < NT) *reinterpret_cast<float4*>(out + O_CONVS + ((size_t)(layer * NS + (m - NPT)) * 3 + 2) * CONVD + c) = make_float4(v0, v1, v2, v3);
        } else if (n < 4624) {
            const float4 b4 = *reinterpret_cast<const float4*>(dt_bias + layer * 16 + (n - 4608));
            const float x0 = v0 + b4.x, x1 = v1 + b4.y, x2 = v2 + b4.z, x3 = v3 + b4.w;
            *reinterpret_cast<float4*>(dt + (size_t)m * 16 + (n - 4608)) = make_float4((x0 > 20.f) ? x0 : log1pf(__expf(x0)), (x1 > 20.f) ? x1 : log1pf(__expf(x1)),
                                                                                       (x2 > 20.f) ? x2 : log1pf(__expf(x2)), (x3 > 20.f) ? x3 : log1pf(__expf(x3)));
        } else if (n < 5008) { *reinterpret_cast<uint2*>(cqb + (size_t)m * QL + (n - 4624)) = pack4(v0, v1, v2, v3); }
        else if (n < 5264) { *reinterpret_cast<float4*>(ckv + (size_t)m * KVL + (n - 5008)) = make_float4(v0, v1, v2, v3);
                             *reinterpret_cast<uint2*>(ckvb + (size_t)m * KVL + (n - 5008)) = pack4(v0, v1, v2, v3); }
        else if (n < 5296) { *reinterpret_cast<float4*>(kr + (size_t)m * 32 + (n - 5264)) = make_float4(v0, v1, v2, v3); }
        const int nb = n & ~63;
        if (nb + 64 > 4624 && nb < 5264) {
            const float s2 = v0 * v0 + v1 * v1 + v2 * v2 + v3 * v3;
            float sq = (n >= 4624 && n < 5008) ? s2 : 0.f, sk = (n >= 5008 && n < 5264) ? s2 : 0.f;
            sq += __shfl_xor(sq, 1); sq += __shfl_xor(sq, 2); sq += __shfl_xor(sq, 4); sq += __shfl_xor(sq, 8);
            sk += __shfl_xor(sk, 1); sk += __shfl_xor(sk, 2); sk += __shfl_xor(sk, 4); sk += __shfl_xor(sk, 8);
            if ((threadIdx.x & 15) == 0) {
                if (nb < 5008) atomicAdd(ssq + m, sq);
                if (nb + 64 > 5008) atomicAdd(sskv + m, sk);
            }
        }
    } EPI_ROWS };
__device__ __forceinline__ void ph_conv2(const P& p, int layer) {
    const int GX = p.grid;
    const int tid_ = opaque_v((int)threadIdx.x); const int bid_ = opaque_s((int)blockIdx.x);
    const int total = NT * (CONVD / 8);
    const float* cw = p.conv_w + (size_t)layer * 4 * CONVD;
    for (int i = bid_ * NTHR + tid_; i < total; i += GX * NTHR) {
        const int t = i / (CONVD / 8), c0 = (i % (CONVD / 8)) * 8;
        float acc[8];
        {
            const float4 b0 = *reinterpret_cast<const float4*>(p.conv_b + layer * CONVD + c0), b1 = *reinterpret_cast<const float4*>(p.conv_b + layer * CONVD + c0 + 4);
            acc[0] = b0.x; acc[1] = b0.y; acc[2] = b0.z; acc[3] = b0.w; acc[4] = b1.x; acc[5] = b1.y; acc[6] = b1.z; acc[7] = b1.w;
        }
#pragma unroll
        for (int k = 0; k < 4; ++k) {
            float xv[8];
            bool have = true;
            if (t < NPT) {
                const int l = t & (SEQ - 1);
                if (l + k - 3 >= 0) {
                    const uint4 r = *reinterpret_cast<const uint4*>(p.xbr + (size_t)(t + k - 3) * CONVD + c0);
                    xv[0] = bflo(r.x); xv[1] = bfhi(r.x); xv[2] = bflo(r.y); xv[3] = bfhi(r.y); xv[4] = bflo(r.z); xv[5] = bfhi(r.z); xv[6] = bflo(r.w); xv[7] = bfhi(r.w);
                } else have = false;
            } else {
                if (k == 3) {
                    const uint4 r = *reinterpret_cast<const uint4*>(p.xbr + (size_t)t * CONVD + c0);
                    xv[0] = bflo(r.x); xv[1] = bfhi(r.x); xv[2] = bflo(r.y); xv[3] = bfhi(r.y); xv[4] = bflo(r.z); xv[5] = bfhi(r.z); xv[6] = bflo(r.w); xv[7] = bfhi(r.w);
                } else {
                    const float* pv = p.state_conv + ((size_t)(layer * NS + (t - NPT)) * 3 + k) * CONVD + c0;
                    const float4 a = *reinterpret_cast<const float4*>(pv), b = *reinterpret_cast<const float4*>(pv + 4);
                    xv[0] = a.x; xv[1] = a.y; xv[2] = a.z; xv[3] = a.w; xv[4] = b.x; xv[5] = b.y; xv[6] = b.z; xv[7] = b.w;
                    if (k >= 1) {
                        float* oc = p.out + O_CONVS + ((size_t)(layer * NS + (t - NPT)) * 3 + (k - 1)) * CONVD + c0;
                        *reinterpret_cast<float4*>(oc) = a; *reinterpret_cast<float4*>(oc + 4) = b;
                    }
                }
            }
            if (have) {
                const float4 w0 = *reinterpret_cast<const float4*>(cw + k * CONVD + c0), w1 = *reinterpret_cast<const float4*>(cw + k * CONVD + c0 + 4);
                acc[0] += xv[0] * w0.x; acc[1] += xv[1] * w0.y; acc[2] += xv[2] * w0.z; acc[3] += xv[3] * w0.w;
                acc[4] += xv[4] * w1.x; acc[5] += xv[5] * w1.y; acc[6] += xv[6] * w1.z; acc[7] += xv[7] * w1.w;
            }
        }
        uint4 o;
        o.x = pack_bf16(silu_f(acc[0]), silu_f(acc[1])); o.y = pack_bf16(silu_f(acc[2]), silu_f(acc[3]));
        o.z = pack_bf16(silu_f(acc[4]), silu_f(acc[5])); o.w = pack_bf16(silu_f(acc[6]), silu_f(acc[7]));
        *reinterpret_cast<uint4*>(p.xbcb + (size_t)t * CONVD + c0) = o;
    }
}

__device__ __forceinline__ void bar_sync(const XcdBarrier& b0) {
    XcdBarrier b = b0;
    unsigned long long bp = (unsigned long long)b.bar; asm volatile("" : "+s"(bp)); b.bar = (unsigned*)bp;
    unsigned bx = b.x; asm volatile("" : "+s"(bx)); b.x = bx;
    xcd_barrier(b);
}
#if PROBE_BAR
#define BAR() do { bar_sync(bar); bar_sync(bar); } while (0)
#else
#define BAR() bar_sync(bar)
#endif
#define NPAD_IN 5376

__global__ void __launch_bounds__(256, 2) k_fwd(P p) {
    __shared__ uint4 xb_words;
    __shared__ __attribute__((aligned(16))) char smem[76800];
    if (threadIdx.x == 0) xb_words = make_uint4(0u, 0u, 0u, 0u);
    __syncthreads();
    XcdBarrier bar = xcd_barrier_post(p.bar, (volatile LAS unsigned*)&xb_words);

#if PROBE_TWICE
#pragma unroll 1
    for (int rep_ = 0; rep_ < 2; ++rep_) {
    if (rep_) { for (int i = blockIdx.x * NTHR + threadIdx.x; i < DEPTH * TP; i += p.grid * NTHR) p.sumsq1[i] = 0.f; BAR(); }
#endif
    ph_rope_table(p);
    ph_copy_x(p);
#pragma unroll 1
    for (int l = 0; l < DEPTH; ++l) {
        ph_convert_w(p.w_in + (size_t)l * DM * DIN, DM, DIN, NPAD_IN, p.wt_in + (size_t)l * NPAD_IN * DM, smem, p.grid, p.norm_mix + l * DM);
        ph_convert_w(p.w_ssm_proj + (size_t)l * DM * DM, DM, DM, DM, p.wt_ssm + (size_t)l * DM * DM, smem, p.grid, p.ssm_norm + l * DM);
        ph_convert_w(p.w_qb + (size_t)l * QL * 768, QL, 768, 768, p.wt_qb + (size_t)l * 768 * QL, smem, p.grid, p.q_norm + l * QL);
        ph_convert_w(p.w_kvb + (size_t)l * KVL * 1024, KVL, 1024, 1024, p.wt_kvb + (size_t)l * 1024 * KVL, smem, p.grid, p.kv_norm + l * KVL);
        ph_convert_w(p.w_mla_proj + (size_t)l * 512 * DM, 512, DM, DM, p.wt_mla + (size_t)l * DM * 512, smem, p.grid);
        ph_convert_w(p.w_out + (size_t)l * DM * DM, DM, DM, DM, p.wt_out + (size_t)l * DM * DM, smem, p.grid);
    }
    ph_convert_plain(p.peer_wq, p.wqb, (size_t)DEPTH * DM * 2048, p.grid);
    ph_convert_plain(p.peer_keys, p.keysb, (size_t)DEPTH * 16 * 128 * 128, p.grid);
#if PROBE_PRO2
#pragma unroll 1
    for (int l = 0; l < DEPTH; ++l) {
        ph_convert_w(p.w_in + (size_t)l * DM * DIN, DM, DIN, NPAD_IN, p.wt_in + (size_t)l * NPAD_IN * DM, smem, p.grid, p.norm_mix + l * DM);
        ph_convert_w(p.w_ssm_proj + (size_t)l * DM * DM, DM, DM, DM, p.wt_ssm + (size_t)l * DM * DM, smem, p.grid);
        ph_convert_w(p.w_qb + (size_t)l * QL * 768, QL, 768, 768, p.wt_qb + (size_t)l * 768 * QL, smem, p.grid);
        ph_convert_w(p.w_kvb + (size_t)l * KVL * 1024, KVL, 1024, 1024, p.wt_kvb + (size_t)l * 1024 * KVL, smem, p.grid);
        ph_convert_w(p.w_mla_proj + (size_t)l * 512 * DM, 512, DM, DM, p.wt_mla + (size_t)l * DM * 512, smem, p.grid);
        ph_convert_w(p.w_out + (size_t)l * DM * DM, DM, DM, DM, p.wt_out + (size_t)l * DM * DM, smem, p.grid);
    }
    ph_convert_plain(p.peer_wq, p.wqb, (size_t)DEPTH * DM * 2048, p.grid);
    ph_copy_x(p);
#endif
    ph_convert_fp8(p.peer_u, p.u8, p.uinv, DEPTH * NEXP, p.norm_ffn, p.grid);
    ph_convert_fp8(p.peer_v, p.v8, p.vinv, DEPTH * NEXP, nullptr, p.grid);
#if PROBE_PRO
    ph_convert_fp8(p.peer_u, p.u8, p.uinv, DEPTH * NEXP, p.norm_ffn, p.grid);
    ph_convert_fp8(p.peer_v, p.v8, p.vinv, DEPTH * NEXP, nullptr, p.grid);
#endif
    BAR();
#pragma unroll 1
    for (int c = 0; c < DEPTH * 16; ++c) {
        const int l = c >> 4, hh = c & 15;
        gemm_bf16(p.keysb + (size_t)c * 128 * 128, 128, p.wqb + (size_t)l * DM * 2048 + hh * 128, 2048, 1, 8, 128, smem,
                  EpiStoreBfCol{p.wt_pq + (size_t)l * 2048 * DM + (size_t)hh * 128 * DM, DM, p.norm_ffn + l * DM}, p.grid, (c & 7) + (c >> 3) * 64);
    }
#if PROBE_WEFF
#pragma unroll 1
    for (int c = 0; c < DEPTH * 16; ++c) {
        const int l = c >> 4, hh = c & 15;
        gemm_bf16(p.keysb + (size_t)c * 128 * 128, 128, p.wqb + (size_t)l * DM * 2048 + hh * 128, 2048, 1, 8, 128, smem,
                  EpiStoreBfCol{p.wt_pq + (size_t)l * 2048 * DM + (size_t)hh * 128 * DM, DM, p.norm_ffn + l * DM}, p.grid, (c & 7) + (c >> 3) * 64);
    }
#endif
    BAR();
#pragma unroll 1
    for (int l = 0; l < DEPTH; ++l) {
        gemm_bf16(p.xb, DM, p.wt_in + (size_t)l * NPAD_IN * DM, DM, TP / 128, NPAD_IN / 128, DM, smem,
                  EpiInProj{p.gab, p.zs, p.xbr, p.cqb, p.ckvb, p.dt, p.ckv, p.kr, p.out, p.ssq + (size_t)l * TP, p.sskv + (size_t)l * TP, p.b_gate, p.dt_bias, p.rstd, l}, p.grid);
        BAR();
        ph_conv2(p, l);
        ph_lat_kpe(p, l);
        gemm_bf16<true>(p.cqb, QL, p.wt_qb + (size_t)l * 768 * QL, QL, NPT / 128, 768 / 128, QL, smem, EpiQRope{p.qb, p.q, p.rope, p.ssq + (size_t)l * TP}, p.grid, 0, NPT / 128 - 1);
        gemm_bf16<true>(p.ckvb, KVL, p.wt_kvb + (size_t)l * 1024 * KVL, KVL, NPT / 128, 1024 / 128, KVL, smem, EpiKV{p.kn, p.vT, p.sskv + (size_t)l * TP}, p.grid, 0, NPT / 128 - 1);
        BAR();
        ph_ssd_chunk(p, l, smem);
        ph_ssd_seq(p, l);
        ph_qlat(p, l);
        ph_attn_dec(p, l, smem, p.queue + l * 64);
        BAR();
        ph_decode_comb2(p, l, smem);
        BAR();
        gemm_bf16<true>(p.ygb, DM, p.wt_ssm + (size_t)l * DM * DM, DM, NPT / 128, DM / 128, DM, smem, EpiGateA{p.ya, p.gab, p.ssy + (size_t)l * TP * 2}, p.grid, 0, NPT / 128 - 1, p.ssy + (size_t)l * TP * 2);
        gemm_bf16<true>(p.ob, 512, p.wt_mla + (size_t)l * DM * 512, 512, NPT / 128, DM / 128, 512, smem, EpiGateB{p.ya, p.gab, p.mixb}, p.grid, 0, NPT / 128 - 1);
        BAR();
        gemm_bf16<true>(p.mixb, DM, p.wt_out + (size_t)l * DM * DM, DM, NPT / 128, DM / 128, DM, smem, EpiResidRow{p.xres, p.xb, p.sumsq1 + (size_t)l * TP}, p.grid, 0, NPT / 128 - 1);
        BAR();
        gemm_bf16<true>(p.xb, DM, p.wt_pq + (size_t)l * 2048 * DM, DM, NPT / 128, 2048 / 128, DM, smem, EpiScaleRow{p.sc, 2048, p.sumsq1 + (size_t)l * TP}, p.grid, 0, NPT / 128 - 1);
#if PROBE_GEMM
        gemm_bf16<true>(p.xb, DM, p.wt_pq + (size_t)l * 2048 * DM, DM, NPT / 128, 2048 / 128, DM, smem, EpiScaleRow{p.sc, 2048, p.sumsq1 + (size_t)l * TP}, p.grid, 0, NPT / 128 - 1);
#endif
        BAR();
        ph_peer_topk2(p);
#if PROBE_TOPK
        ph_peer_topk2(p);
#endif
        BAR();
#if PROBE_EXP
        ph_peer_experts3(p, l, true);
#endif
        ph_peer_experts3(p, l);
        BAR();
    }
#if PROBE_TWICE
    }
#endif
}

static inline char* carve_b(char*& cur, size_t bytes) {
    char* r = cur;
    cur += ((bytes + 255) / 256) * 256;
    return r;
}
static inline float* carve(char*& cur, size_t nfloats) { return (float*)carve_b(cur, nfloats * 4); }
static inline bf16_t* carve_h(char*& cur, size_t n) { return (bf16_t*)carve_b(cur, n * 2); }

extern "C" void kernel_launch(void* const* d_in, const int* in_sizes, int n_in,
                              void* d_out, int out_size, void* d_ws, size_t ws_size,
                              hipStream_t stream) {
    P p{};
    p.x_prompt = (const float*)d_in[0]; p.x_sample = (const float*)d_in[1];
    p.cache_lat = (const float*)d_in[2]; p.cache_kr = (const float*)d_in[3];
    p.state_ssm = (const float*)d_in[4]; p.state_conv = (const float*)d_in[5];
    p.page_table = (const int*)d_in[6];
    p.norm_mix = (const float*)d_in[7]; p.w_in = (const float*)d_in[8]; p.b_gate = (const float*)d_in[9];
    p.conv_w = (const float*)d_in[10]; p.conv_b = (const float*)d_in[11]; p.dt_bias = (const float*)d_in[12];
    p.a_log = (const float*)d_in[13]; p.d_skip = (const float*)d_in[14]; p.ssm_norm = (const float*)d_in[15];
    p.w_ssm_proj = (const float*)d_in[16]; p.q_norm = (const float*)d_in[17]; p.w_qb = (const float*)d_in[18];
    p.kv_norm = (const float*)d_in[19]; p.w_kvb = (const float*)d_in[20]; p.w_mla_proj = (const float*)d_in[21];
    p.w_out = (const float*)d_in[22]; p.norm_ffn = (const float*)d_in[23]; p.peer_wq = (const float*)d_in[24];
    p.peer_keys = (const float*)d_in[25]; p.peer_u = (const float*)d_in[26]; p.peer_v = (const float*)d_in[27];
    p.norm_final = (const float*)d_in[28];
    p.out = (float*)d_out;
    char* cur = (char*)d_ws;
    p.bar = (unsigned*)carve(cur, XCD_BAR_WORDS);
    p.sumsq1 = carve(cur, (size_t)DEPTH * TP);
    p.queue = (unsigned*)carve(cur, 4 * DEPTH * 64);
    p.ssq = carve(cur, (size_t)DEPTH * TP);
    p.sskv = carve(cur, (size_t)DEPTH * TP);
    p.ssy = carve(cur, (size_t)DEPTH * TP * 2);
    char* zero_begin = (char*)d_ws;
    char* zero_end = cur;
    p.xres = carve(cur, (size_t)TP * DM);
    p.cq = carve(cur, (size_t)TP * QL);
    p.ckv = carve(cur, (size_t)TP * KVL);
    p.kr = carve(cur, (size_t)TP * 32);
    p.dt = carve(cur, (size_t)TP * 16);
    p.yraw = carve(cur, (size_t)TP * DM);
    p.ya = carve(cur, (size_t)TP * DM);
    p.q = carve(cur, (size_t)TP * 768);
    p.lat = carve(cur, (size_t)TP * KVL);
    p.kpe = carve(cur, (size_t)TP * 32);
    p.sc = carve(cur, (size_t)TP * 2048);
    p.gate = carve(cur, (size_t)TP * 128);
    p.part = carve(cur, (size_t)NS * 129 * 8 * 258);
    p.qlat = carve(cur, (size_t)NS * 8 * 256);
    p.rope = carve(cur, (size_t)2 * 2049 * 16);
    p.idx = (int*)carve(cur, (size_t)TP * 128);
    p.xb = carve_h(cur, (size_t)TP * DM);
    p.rstd = carve(cur, (size_t)TP);
    p.ynb = carve_h(cur, (size_t)TP * DM);
    p.qnb = carve_h(cur, (size_t)TP * QL);
    p.latb = carve_h(cur, (size_t)TP * KVL);
    p.ob = carve_h(cur, (size_t)TP * 512);
    p.mixb = carve_h(cur, (size_t)TP * DM);
    p.qb = carve_h(cur, (size_t)TP * 768);
    p.kn = carve_h(cur, (size_t)TP * 512);
    p.kpeb = carve_h(cur, (size_t)TP * 32);
    p.vT = carve_h(cur, (size_t)NB * 8 * 64 * SEQ);
    p.xbcb = carve_h(cur, (size_t)TP * CONVD);
    p.xbr = carve_h(cur, (size_t)TP * CONVD);
    p.cqb = carve_h(cur, (size_t)TP * QL);
    p.ckvb = carve_h(cur, (size_t)TP * KVL);
    p.ygb = carve_h(cur, (size_t)TP * DM);
    p.gab = carve_h(cur, (size_t)TP * 2048);
    p.zs = carve_h(cur, (size_t)TP * DM);
    p.wt_in = carve_h(cur, (size_t)DEPTH * NPAD_IN * DM);
    p.wt_ssm = carve_h(cur, (size_t)DEPTH * DM * DM);
    p.wt_qb = carve_h(cur, (size_t)DEPTH * 768 * QL);
    p.wt_kvb = carve_h(cur, (size_t)DEPTH * 1024 * KVL);
    p.wt_mla = carve_h(cur, (size_t)DEPTH * DM * 512);
    p.wt_out = carve_h(cur, (size_t)DEPTH * DM * DM);
    p.wt_pq = carve_h(cur, (size_t)DEPTH * 2048 * DM);
    p.wqb = carve_h(cur, (size_t)DEPTH * DM * 2048);
    p.keysb = carve_h(cur, (size_t)DEPTH * 16 * 128 * 128);
    p.u8 = (unsigned char*)carve_b(cur, (size_t)DEPTH * NEXP * DM);
    p.v8 = (unsigned char*)carve_b(cur, (size_t)DEPTH * NEXP * DM);
    p.uinv = carve(cur, (size_t)DEPTH * NEXP);
    p.vinv = carve(cur, (size_t)DEPTH * NEXP);

    (void)hipMemsetAsync(zero_begin, 0, (size_t)(zero_end - zero_begin), stream);

    static int grid = 0;
    if (!grid) {
        int dev = 0, cus = 0, per_cu = 0;
        (void)hipGetDevice(&dev);
        (void)hipDeviceGetAttribute(&cus, hipDeviceAttributeMultiprocessorCount, dev);
        (void)hipOccupancyMaxActiveBlocksPerMultiprocessor(&per_cu, k_fwd, 256, 0);
        if (per_cu > 2) per_cu = 2;
        if (per_cu < 1) per_cu = 1;
        grid = cus * per_cu;
    }
    p.grid = grid;
    k_fwd<<<grid, 256, 0, stream>>>(p);
}
```

```cpp
#include <hip/hip_runtime.h>
#include <stdint.h>

#define DM 1024
#define NB 8
#define SEQ 2048
#define NPT (NB * SEQ)
#define NS 32
#define NT (NPT + NS)
#define TP 16512
#define DEPTH 2
#define PAST 16384
#define PAGE 128
#define NPAGES 128
#define NPOOL 5120
#define DIN 5296
#define OFF_GA 0
#define OFF_GB 1024
#define OFF_Z 2048
#define OFF_XBC 3072
#define OFF_DT 4608
#define OFF_CQ 4624
#define OFF_CKV 5008
#define OFF_KR 5264
#define CONVD 1536
#define QL 384
#define KVL 256
#define NEXP 16384
#define EPSF 1e-6f
#define ATT_SCALE 0.10206207261596577f

#define O_YP 0
#define O_YS (O_YP + NPT * DM)
#define O_LATP (O_YS + NS * DM)
#define O_KRP (O_LATP + DEPTH * NPT * KVL)
#define O_SSMP (O_KRP + DEPTH * NPT * 32)
#define O_CONVP (O_SSMP + DEPTH * NB * 16 * 64 * 128)
#define O_LATS (O_CONVP + DEPTH * NB * 3 * CONVD)
#define O_KRS (O_LATS + DEPTH * NS * KVL)
#define O_SSMS (O_KRS + DEPTH * NS * 32)
#define O_CONVS (O_SSMS + DEPTH * NS * 16 * 64 * 128)

struct P {
    const float *x_prompt, *x_sample, *cache_lat, *cache_kr, *state_ssm, *state_conv;
    const int* page_table;
    const float *norm_mix, *w_in, *b_gate, *conv_w, *conv_b, *dt_bias, *a_log, *d_skip, *ssm_norm, *w_ssm_proj;
    const float *q_norm, *w_qb, *kv_norm, *w_kvb, *w_mla_proj, *w_out, *norm_ffn, *peer_wq, *peer_keys, *peer_u, *peer_v, *norm_final;
    float* out;
    float *xres, *h, *proj, *xbc, *dt, *yraw, *yn, *ya, *qn, *q, *lat, *kpe, *kv, *o, *yb, *mix, *pq, *sc, *gate, *part, *qlat, *rope;
    int* idx;
    unsigned* bar;
    unsigned short *hb, *ynb, *qnb, *latb, *ob, *mixb, *qb, *kn, *kpeb, *vT, *xbcb, *xbr, *gab, *zs;
    float *cq, *ckv, *kr, *rstd, *sumsq1;
    unsigned short* xb;
    unsigned* queue;
    float *ssq, *sskv, *ssy;
    unsigned short *cqb, *ckvb, *ygb;
    int grid, pad_;
    unsigned short *wt_in, *wt_ssm, *wt_qb, *wt_kvb, *wt_mla, *wt_out, *wt_pq, *wqb, *keysb;
    unsigned char *u8, *v8;
    float *uinv, *vinv;
};

#define XB_TMO      128
#define XB_XCNT(j)  (256  + 64 * (j))
#define XB_XSUB(j)  (1280 + 64 * (j))
#define XB_XGEN(j)  (2304 + 64 * (j))
#define XB_TOP      3328
#define XB_TOPGEN   3392
#define XCD_BAR_WORDS 3456
#define XB_SPIN_CAP (1u << 18)
#define LAS __attribute__((address_space(3)))

__device__ __forceinline__ unsigned xb_ld(unsigned* p)              { return __hip_atomic_load(p, __ATOMIC_RELAXED, __HIP_MEMORY_SCOPE_AGENT); }
__device__ __forceinline__ unsigned xb_add(unsigned* p, unsigned v) { return __hip_atomic_fetch_add(p, v, __ATOMIC_RELAXED, __HIP_MEMORY_SCOPE_AGENT); }
__device__ __forceinline__ unsigned xb_xcc_id() { return (unsigned)__builtin_amdgcn_s_getreg((3 << 11) | 20) & 0xFu; }
#define XB_SPIN(cond, bar) do { unsigned _sp = 0; while (cond) { __builtin_amdgcn_s_sleep(1); \
    if ((++_sp & 255u) == 0u) { if (xb_ld(&(bar)[XB_TMO])) break; if (_sp > XB_SPIN_CAP) { atomicAdd(&(bar)[XB_TMO], 1u); break; } } } } while (0)

struct XcdBarrier {
    unsigned* bar; unsigned x;
    volatile LAS unsigned* st;
};

__device__ __forceinline__ XcdBarrier xcd_barrier_post(unsigned* bar, volatile LAS unsigned* st) {
    XcdBarrier b; b.bar = bar; b.x = xb_xcc_id(); b.st = st;
    if (threadIdx.x == 0) (void)xb_add(&bar[XB_XCNT(b.x)], 1u);
    return b;
}
__device__ __forceinline__ void xcd_barrier_complete(unsigned* bar, unsigned x, unsigned& nloc, unsigned& nx) {
    const unsigned G = gridDim.x * gridDim.y * gridDim.z;
    unsigned sum, cnt, mine, sp = 0u;
    for (;;) {
        sum = 0u; cnt = 0u; mine = 0u;
#pragma unroll
        for (unsigned j = 0; j < 16; ++j) { const unsigned c = xb_ld(&bar[XB_XCNT(j)]); sum += c; cnt += (c > 0u) ? 1u : 0u; mine = (j == x) ? c : mine; }
        if (sum == G) break;
        __builtin_amdgcn_s_sleep(1);
        if ((++sp & 255u) == 0u) { if (xb_ld(&bar[XB_TMO])) break; if (sp > XB_SPIN_CAP) { atomicAdd(&bar[XB_TMO], 1u); break; } }
    }
    nloc = mine > 0u ? mine : 1u; nx = cnt > 0u ? cnt : 1u;
}

__device__ __forceinline__ void xcd_barrier(const XcdBarrier& b) {
    asm volatile("s_waitcnt vmcnt(0)" ::: "memory");
    __syncthreads();
    if (threadIdx.x == 0) {
        unsigned* bar = b.bar;
        __builtin_amdgcn_s_waitcnt(0);
        unsigned nloc = b.st[0], nx = b.st[1];
        if (nloc == 0u) { xcd_barrier_complete(bar, b.x, nloc, nx); b.st[0] = nloc; b.st[1] = nx; }
        const unsigned old = xb_add(&bar[XB_XSUB(b.x)], 1u);
        const unsigned gen = old / nloc;
        if (old + 1u == (gen + 1u) * nloc) {
            __builtin_amdgcn_fence(__ATOMIC_RELEASE, "agent");
            asm volatile("s_waitcnt vmcnt(0)" ::: "memory");
            const unsigned og = xb_add(&bar[XB_TOP], 1u);
            const unsigned tg = og / nx;
            if (og + 1u == (tg + 1u) * nx) xb_add(&bar[XB_TOPGEN], 1u);
            else XB_SPIN(xb_ld(&bar[XB_TOPGEN]) == tg, bar);
            __builtin_amdgcn_fence(__ATOMIC_ACQUIRE, "agent");
            xb_add(&bar[XB_XGEN(b.x)], 1u);
            asm volatile("s_waitcnt vmcnt(0)" ::: "memory");
        } else {
            XB_SPIN(xb_ld(&bar[XB_XGEN(b.x)]) == gen, bar);
            __builtin_amdgcn_fence(__ATOMIC_ACQUIRE, "agent");
            asm volatile("s_waitcnt vmcnt(0)" ::: "memory");
        }
    }
    __syncthreads();
}


__device__ __forceinline__ float wave_sum(float v) {
#pragma unroll
    for (int o = 32; o > 0; o >>= 1) v += __shfl_xor(v, o);
    return v;
}
__device__ __forceinline__ float wave_max(float v) {
#pragma unroll
    for (int o = 32; o > 0; o >>= 1) v = fmaxf(v, __shfl_xor(v, o));
    return v;
}
__device__ __forceinline__ float sigmoid_f(float x) { return __builtin_amdgcn_rcpf(1.f + __expf(-x)); }
__device__ __forceinline__ float silu_f(float x) { return x * sigmoid_f(x); }


__device__ __forceinline__ int opaque_v(int x) { asm volatile("" : "+v"(x)); return x; }
__device__ __forceinline__ int opaque_s(int x) { asm volatile("" : "+s"(x)); return x; }

#ifndef PROBE_GEMM
#define PROBE_GEMM 0
#endif
#ifndef PROBE_TOPK
#define PROBE_TOPK 0
#endif
#ifndef PROBE_ATTN
#define PROBE_ATTN 0
#endif
#ifndef PROBE_DEC
#define PROBE_DEC 0
#endif
#ifndef PROBE_SSD
#define PROBE_SSD 0
#endif
#ifndef PROBE_ELEM
#define PROBE_ELEM 0
#endif
#ifndef PROBE_EXP
#define PROBE_EXP 0
#endif
#ifndef PROBE_PRO2
#define PROBE_PRO2 0
#endif
#ifndef PROBE_WEFF
#define PROBE_WEFF 0
#endif
#ifndef PROBE_MISC
#define PROBE_MISC 0
#endif
#ifndef PROBE_BAR
#define PROBE_BAR 0
#endif
#ifndef PROBE_TWICE
#define PROBE_TWICE 0
#endif
#ifndef PROBE_PRO
#define PROBE_PRO 0
#endif
#define NTHR 256
#define VB_LOOP(n) for (int vb = bid_; vb < (n); vb += GX)


typedef unsigned short bf16_t;
using bf16x8 = __attribute__((ext_vector_type(8))) short;
using f32x4 = __attribute__((ext_vector_type(4))) float;
typedef __attribute__((ext_vector_type(2))) __bf16 bf16x2_t;
__device__ __forceinline__ bf16_t f2bf(float f) { __bf16 h = (__bf16)f; return __builtin_bit_cast(unsigned short, h); }
__device__ __forceinline__ unsigned pack_bf16(float a, float b) { bf16x2_t r; r[0] = (__bf16)a; r[1] = (__bf16)b; return __builtin_bit_cast(unsigned, r); }
__device__ __forceinline__ float bf2f(bf16_t h) { return __uint_as_float(((unsigned)h) << 16); }
__device__ __forceinline__ float bflo(unsigned d) { return __uint_as_float(d << 16); }
__device__ __forceinline__ float bfhi(unsigned d) { return __uint_as_float(d & 0xffff0000u); }

__device__ __forceinline__ int lds_byte(int r, int c) {
    int st = (r >> 4) * 2 + (c >> 5), rr = r & 15, cc = c & 31, ob = rr * 64 + cc * 2;
    return st * 1024 + (ob ^ (((ob >> 9) & 1) << 5));
}
__device__ __forceinline__ void stage_rc(int b, int& R, int& C) {
    int st = b / 1024, sb = b % 1024, swz = sb ^ (((sb >> 9) & 1) << 5);
    R = (st >> 1) * 16 + swz / 64; C = (st & 1) * 32 + (swz % 64) / 2;
}
template <bool PERM>
__device__ __forceinline__ void stage_tile(const bf16_t* base, int ld, int row0, int k0, char* dst, int tid, bool extra = false) {
#pragma unroll
    for (int i = 0; i < 4; ++i) {
        int b = tid * 16 + i * 4096;
        int R, C; stage_rc(b, R, C);
        if (PERM) R = (R & 64) + 4 * (R & 15) + ((R >> 4) & 3);
        const bf16_t* src = base + (size_t)(row0 + R) * ld + k0 + C;
        __builtin_amdgcn_global_load_lds((const unsigned*)src, (unsigned*)(dst + b), 16, 0, 0);
    }
    if (extra) {
        int b = tid * 16 + 16384;
        int R, C; stage_rc(b, R, C);
        const bf16_t* src = base + (size_t)(row0 + R) * ld + k0 + C;
        __builtin_amdgcn_global_load_lds((const unsigned*)src, (unsigned*)(dst + b), 16, 0, 0);
    }
}
__device__ __forceinline__ void tile_map(int id, int mtiles, int ntiles, int& mt, int& nt) {
    const int fg = mtiles >> 3, full = fg * ntiles * 8;
    if (id < full) { const int mg = id / (ntiles * 8), r = id % (ntiles * 8); nt = r >> 3; mt = mg * 8 + (r & 7); }
    else { const int rem = mtiles & 7, r = id - full; nt = r / rem; mt = fg * 8 + r % rem; }
}
#define G_ABYTES 20480
#define G_STAGE (G_ABYTES + 16384)
template <bool TALL = false, class Epi>
__device__ __forceinline__ void gemm_bf16(const bf16_t* A, int lda, const bf16_t* Bt, int ldb, int mtiles, int ntiles, int K, char* smem, Epi epi, const int GX, int vb0 = 0, int tall_mt = -1,
                                          const float* midk = nullptr) {
    const int tid = opaque_v((int)threadIdx.x);
    int bid0 = (int)blockIdx.x - vb0;
    while (bid0 < 0) bid0 += GX;
    const int bid = opaque_s(__builtin_amdgcn_readfirstlane(bid0));
    const int wid = tid >> 6, lane = tid & 63, wm = wid >> 1, wn = wid & 1, fr = lane & 15, fq = lane >> 4;
    const int nk = K / 64, total = mtiles * ntiles, G = GX;
    const bool xcd = (G & 7) == 0;
    const int nq = G >> 3;
    for (int st = 0;; ++st) {
        const int id = xcd ? ((st * 8 + (bid & 7)) * nq + (bid >> 3)) : (st * G + bid);
        if (st * G >= total) break;
        if (id >= total) continue;
        int mt, nt; tile_map(id, mtiles, ntiles, mt, nt);
        const int m0 = mt * 128, n0 = nt * 128;
        const bool tall = TALL && (mt == tall_mt);
        f32x4 acc[4][4], acc5[4];
#pragma unroll
        for (int i = 0; i < 4; ++i)
#pragma unroll
            for (int j = 0; j < 4; ++j) acc[i][j] = f32x4{0.f, 0.f, 0.f, 0.f};
#pragma unroll
        for (int j = 0; j < 4; ++j) acc5[j] = f32x4{0.f, 0.f, 0.f, 0.f};
        if (midk && tid < 160) {
            const float2 ss = *reinterpret_cast<const float2*>(midk + 2 * (size_t)(m0 + tid));
            reinterpret_cast<float*>(smem + 2 * G_STAGE)[tid] = sqrtf((ss.y * (1.f / 512.f) + EPSF) / (ss.x * (1.f / 512.f) + EPSF));
        }
        stage_tile<false>(A, lda, m0, 0, smem, tid, tall);
        stage_tile<true>(Bt, ldb, n0, 0, smem + G_ABYTES, tid);
        for (int kt = 0; kt < nk; ++kt) {
            asm volatile("s_waitcnt vmcnt(0)" ::: "memory");
            __syncthreads();
            if (kt + 1 < nk) {
                char* nb = smem + ((kt + 1) & 1) * G_STAGE;
                stage_tile<false>(A, lda, m0, (kt + 1) * 64, nb, tid, tall);
                stage_tile<true>(Bt, ldb, n0, (kt + 1) * 64, nb + G_ABYTES, tid);
            }
            if (midk && kt == (nk >> 1)) {
                const float* fb = reinterpret_cast<const float*>(smem + 2 * G_STAGE);
#pragma unroll
                for (int i = 0; i < 4; ++i) {
                    const float4 f4 = *reinterpret_cast<const float4*>(fb + wm * 64 + i * 16 + fq * 4);
#pragma unroll
                    for (int j = 0; j < 4; ++j) { acc[i][j][0] *= f4.x; acc[i][j][1] *= f4.y; acc[i][j][2] *= f4.z; acc[i][j][3] *= f4.w; }
                }
                if (tall) {
                    const float4 f4 = *reinterpret_cast<const float4*>(fb + 128 + wm * 16 + fq * 4);
#pragma unroll
                    for (int j = 0; j < 4; ++j) { acc5[j][0] *= f4.x; acc5[j][1] *= f4.y; acc5[j][2] *= f4.z; acc5[j][3] *= f4.w; }
                }
            }
            const char* ab = smem + (kt & 1) * G_STAGE;
            const char* bb = ab + G_ABYTES;
#pragma unroll
            for (int s2 = 0; s2 < 2; ++s2) {
                bf16x8 a[4], b[4];
#pragma unroll
                for (int i = 0; i < 4; ++i) a[i] = *reinterpret_cast<const bf16x8*>(ab + lds_byte(wm * 64 + i * 16 + fr, s2 * 32 + fq * 8));
#pragma unroll
                for (int j = 0; j < 4; ++j) b[j] = *reinterpret_cast<const bf16x8*>(bb + lds_byte(wn * 64 + j * 16 + fr, s2 * 32 + fq * 8));
#pragma unroll
                for (int i = 0; i < 4; ++i)
#pragma unroll
                    for (int j = 0; j < 4; ++j) acc[i][j] = __builtin_amdgcn_mfma_f32_16x16x32_bf16(a[i], b[j], acc[i][j], 0, 0, 0);
                if (tall) {
                    const bf16x8 a5 = *reinterpret_cast<const bf16x8*>(ab + lds_byte(128 + wm * 16 + fr, s2 * 32 + fq * 8));
#pragma unroll
                    for (int j = 0; j < 4; ++j) acc5[j] = __builtin_amdgcn_mfma_f32_16x16x32_bf16(a5, b[j], acc5[j], 0, 0, 0);
                }
            }
        }
#pragma unroll
        for (int i = 0; i < 4; ++i) epi.blk(m0 + wm * 64 + i * 16 + fq * 4, n0 + wn * 64 + fr * 4, acc[i]);
        if (tall) epi.blk(m0 + 128 + wm * 16 + fq * 4, n0 + wn * 64 + fr * 4, acc5);
        __syncthreads();
    }
}
#define EPI_ROWS __device__ __forceinline__ void blk(int m, int n, const f32x4 (&c)[4]) const { \
    row4(m + 0, n, c[0][0], c[1][0], c[2][0], c[3][0]); row4(m + 1, n, c[0][1], c[1][1], c[2][1], c[3][1]); \
    row4(m + 2, n, c[0][2], c[1][2], c[2][2], c[3][2]); row4(m + 3, n, c[0][3], c[1][3], c[2][3], c[3][3]); }
__device__ __forceinline__ uint2 pack4(float a, float b, float c, float d) { uint2 r; r.x = pack_bf16(a, b); r.y = pack_bf16(c, d); return r; }
struct EpiGateA { float* ya; const bf16_t* gab; const float* ssy;
    __device__ __forceinline__ void row4(int m, int n, float v0, float v1, float v2, float v3) const {
        const uint2 g = *reinterpret_cast<const uint2*>(gab + (size_t)m * 2048 + n);
        const float r1 = rsqrtf(ssy[2 * (size_t)m + 1] * (1.f / 512.f) + EPSF);
        *reinterpret_cast<float4*>(ya + (size_t)m * DM + n) = make_float4(bflo(g.x) * v0 * r1, bfhi(g.x) * v1 * r1, bflo(g.y) * v2 * r1, bfhi(g.y) * v3 * r1);
    } EPI_ROWS };
struct EpiGateB { const float* ya; const bf16_t* gab; bf16_t* mixb;
    __device__ __forceinline__ void row4(int m, int n, float v0, float v1, float v2, float v3) const {
        const uint2 g = *reinterpret_cast<const uint2*>(gab + (size_t)m * 2048 + 1024 + n);
        const float4 y = *reinterpret_cast<const float4*>(ya + (size_t)m * DM + n);
        *reinterpret_cast<uint2*>(mixb + (size_t)m * DM + n) = pack4(y.x + bflo(g.x) * v0, y.y + bfhi(g.x) * v1, y.z + bflo(g.y) * v2, y.w + bfhi(g.y) * v3);
    } EPI_ROWS };
struct EpiStore { float* C; int ldc; int N;
    __device__ __forceinline__ void row4(int m, int n, float v0, float v1, float v2, float v3) const { if (n < N) *reinterpret_cast<float4*>(C + (size_t)m * ldc + n) = make_float4(v0, v1, v2, v3); } EPI_ROWS };
struct EpiStoreBfCol { bf16_t* C; int ldc; const float* cs;
    __device__ __forceinline__ void row4(int m, int n, float v0, float v1, float v2, float v3) const {
        const float4 c4 = *reinterpret_cast<const float4*>(cs + n);
        *reinterpret_cast<uint2*>(C + (size_t)m * ldc + n) = pack4(v0 * c4.x, v1 * c4.y, v2 * c4.z, v3 * c4.w);
    } EPI_ROWS };
struct EpiScaleRow { float* C; int ldc; const float* sumsq;
    __device__ __forceinline__ void row4(int m, int n, float v0, float v1, float v2, float v3) const {
        const float rs = rsqrtf(sumsq[m] * (1.f / DM) + EPSF);
        *reinterpret_cast<float4*>(C + (size_t)m * ldc + n) = make_float4(v0 * rs, v1 * rs, v2 * rs, v3 * rs);
    } EPI_ROWS };
struct EpiResidRow { float* xres; bf16_t* xb; float* sumsq;
    __device__ __forceinline__ void row4(int m, int n, float v0, float v1, float v2, float v3) const {
        float4* xp = reinterpret_cast<float4*>(xres + (size_t)m * DM + n);
        float4 x = *xp;
        x.x += v0; x.y += v1; x.z += v2; x.w += v3;
        *xp = x;
        *reinterpret_cast<uint2*>(xb + (size_t)m * DM + n) = pack4(x.x, x.y, x.z, x.w);
        float ss = x.x * x.x + x.y * x.y + x.z * x.z + x.w * x.w;
        ss += __shfl_xor(ss, 1); ss += __shfl_xor(ss, 2); ss += __shfl_xor(ss, 4); ss += __shfl_xor(ss, 8);
        if ((opaque_v((int)threadIdx.x) & 15) == 0) atomicAdd(sumsq + m, ss);
    } EPI_ROWS };
struct EpiQRope { bf16_t* qb; float* q; const float* rope; const float* ssq;
    __device__ __forceinline__ void row4(int m, int n, float a0, float a1, float a2, float a3) const {
        const float rq = rsqrtf(ssq[m] * (1.f / QL) + EPSF);
        const float v0 = a0 * rq, v1 = a1 * rq, v2 = a2 * rq, v3 = a3 * rq;
        const float o0 = __shfl_xor(v0, 4), o1 = __shfl_xor(v1, 4), o2 = __shfl_xor(v2, 4), o3 = __shfl_xor(v3, 4);
        const int d = n % 96;
        float r0 = v0, r1 = v1, r2 = v2, r3 = v3;
        if (d >= 64) {
            const int pi = (m < NPT) ? (m & (SEQ - 1)) : 2048;
            const int dd = d - 64, jj = dd & 15;
            const float4 cs = *reinterpret_cast<const float4*>(rope + pi * 16 + jj);
            const float4 sn = *reinterpret_cast<const float4*>(rope + 2049 * 16 + pi * 16 + jj);
            if (dd < 16) { r0 = v0 * cs.x - o0 * sn.x; r1 = v1 * cs.y - o1 * sn.y; r2 = v2 * cs.z - o2 * sn.z; r3 = v3 * cs.w - o3 * sn.w; }
            else { r0 = o0 * sn.x + v0 * cs.x; r1 = o1 * sn.y + v1 * cs.y; r2 = o2 * sn.z + v2 * cs.z; r3 = o3 * sn.w + v3 * cs.w; }
        }
        const float qsc = ATT_SCALE * 1.4426950408889634f;
        *reinterpret_cast<uint2*>(qb + (size_t)m * 768 + n) = pack4(r0 * qsc, r1 * qsc, r2 * qsc, r3 * qsc);
        if (m >= NPT) *reinterpret_cast<float4*>(q + (size_t)m * 768 + n) = make_float4(r0, r1, r2, r3);
    } EPI_ROWS };
struct EpiStoreBf { bf16_t* C; int ldc;
    __device__ __forceinline__ void row4(int m, int n, float v0, float v1, float v2, float v3) const { *reinterpret_cast<uint2*>(C + (size_t)m * ldc + n) = pack4(v0, v1, v2, v3); } EPI_ROWS };
__device__ __forceinline__ void ph_convert_plain(const float* src, bf16_t* dst, size_t n, const int GX) {
    const int tid = opaque_v((int)threadIdx.x); const int bid = opaque_s((int)blockIdx.x);
    for (size_t i = ((size_t)bid * NTHR + tid) * 4; i < n; i += (size_t)GX * NTHR * 4) {
        float4 v = *(const float4*)(src + i);
        ushort4 o; o.x = f2bf(v.x); o.y = f2bf(v.y); o.z = f2bf(v.z); o.w = f2bf(v.w);
        *(ushort4*)(dst + i) = o;
    }
}
__device__ __forceinline__ void ph_convert_w(const float* W, int K, int N, int Npad, bf16_t* Bt, char* smem, const int GX, const float* kscale = nullptr) {
    const int tid = opaque_v((int)threadIdx.x); const int bid = opaque_s((int)blockIdx.x);
    float (*t)[65] = (float (*)[65])smem;
    int tk = K / 64, tn = Npad / 64;
    for (int vb = bid; vb < tk * tn; vb += GX) {
        int k0 = (vb % tk) * 64, n0 = (vb / tk) * 64;
        for (int i = tid; i < 64 * 64; i += NTHR) {
            int kk = i >> 6, nn = i & 63;
            t[kk][nn] = (n0 + nn < N) ? W[(size_t)(k0 + kk) * N + n0 + nn] * (kscale ? kscale[k0 + kk] : 1.f) : 0.f;
        }
        __syncthreads();
        for (int i = tid; i < 64 * 64; i += NTHR) {
            int nn = i >> 6, kk = i & 63;
            Bt[(size_t)(n0 + nn) * K + k0 + kk] = f2bf(t[kk][nn]);
        }
        __syncthreads();
    }
}

__device__ __forceinline__ void ph_rope_table(const P& p) {
    const int GX = p.grid;
    const int tid_ = opaque_v((int)threadIdx.x); const int bid_ = opaque_s((int)blockIdx.x); (void)tid_; (void)bid_;
    for (int i = bid_ * NTHR + tid_; i < 2049 * 16; i += GX * NTHR) {
        int pi = i / 16, j = i % 16;
        float pos = (pi == 2048) ? 16384.f : (float)pi;
        float inv = powf(10000.f, -(float)j / 16.f);
        float ang = pos * inv;
        p.rope[i] = (float)cos((double)ang);
        p.rope[2049 * 16 + i] = (float)sin((double)ang);
    }
}
__device__ __forceinline__ void ph_copy_x(const P& p) {
    const int GX = p.grid;
    const int tid_ = opaque_v((int)threadIdx.x); const int bid_ = opaque_s((int)blockIdx.x);
    const int wid = tid_ >> 6, lane = tid_ & 63;
    for (int t = bid_ * 4 + wid; t < NT; t += GX * 4) {
        const float* src = (t < NPT) ? (p.x_prompt + (size_t)t * DM) : (p.x_sample + (size_t)(t - NPT) * DM);
        const float4* sp = reinterpret_cast<const float4*>(src + lane * 16);
        float4 v[4]; float ss = 0.f;
#pragma unroll
        for (int q4 = 0; q4 < 4; ++q4) { v[q4] = sp[q4]; ss += v[q4].x * v[q4].x + v[q4].y * v[q4].y + v[q4].z * v[q4].z + v[q4].w * v[q4].w; }
        ss = wave_sum(ss);
        float4* xp = reinterpret_cast<float4*>(p.xres + (size_t)t * DM + lane * 16);
#pragma unroll
        for (int q4 = 0; q4 < 4; ++q4) xp[q4] = v[q4];
        uint4 b0, b1;
        b0.x = pack_bf16(v[0].x, v[0].y); b0.y = pack_bf16(v[0].z, v[0].w); b0.z = pack_bf16(v[1].x, v[1].y); b0.w = pack_bf16(v[1].z, v[1].w);
        b1.x = pack_bf16(v[2].x, v[2].y); b1.y = pack_bf16(v[2].z, v[2].w); b1.z = pack_bf16(v[3].x, v[3].y); b1.w = pack_bf16(v[3].z, v[3].w);
        uint4* bp = reinterpret_cast<uint4*>(p.xb + (size_t)t * DM + lane * 16);
        bp[0] = b0; bp[1] = b1;
        if (lane == 0) p.rstd[t] = rsqrtf(ss * (1.f / DM) + EPSF);
    }
}
__device__ __forceinline__ void ph_rmsnorm(const float* in, int ldi, const float* w, float* out, int ldo, bf16_t* outb, int ldob, int D, int rows, const int GX) {
    const int tid_ = opaque_v((int)threadIdx.x); const int bid_ = opaque_s((int)blockIdx.x); (void)tid_; (void)bid_;
    VB_LOOP((rows + 3) / 4) {
        int row = vb * 4 + (tid_ >> 6);
        int lane = tid_ & 63;
        if (row < rows) {
            const float* x = in + (size_t)row * ldi;
            float s = 0.f;
            for (int c = lane; c < D; c += 64) { float v = x[c]; s += v * v; }
            s = wave_sum(s);
            float r = rsqrtf(s / (float)D + EPSF);
            for (int c = lane; c < D; c += 64) {
                float v = x[c] * r * w[c];
                if (out) out[(size_t)row * ldo + c] = v;
                if (outb) outb[(size_t)row * ldob + c] = f2bf(v);
            }
        }
    }
}
__device__ __forceinline__ void ph_ssd_seq(const P& p, int layer) {
    const int GX = p.grid;
    const int tid_ = opaque_v((int)threadIdx.x); const int bid_ = opaque_s((int)blockIdx.x); (void)tid_; (void)bid_;
    VB_LOOP(NS * 16) {
        int seq = NB + vb / 16, e = vb % 16, g = e / 8;
        int pp = tid_ >> 2, nq = tid_ & 3;
        float A = -expf(p.a_log[layer * 16 + e]);
        float Dk = p.d_skip[layer * 16 + e];
        float s[32];
        int t0, L;
        float* hout;
        if (seq < NB) {
            t0 = seq * SEQ; L = SEQ;
#pragma unroll
            for (int j = 0; j < 32; ++j) s[j] = 0.f;
            hout = p.out + O_SSMP + (((size_t)(layer * NB + seq) * 16 + e) * 64 + pp) * 128 + nq * 32;
        } else {
            int bs = seq - NB;
            t0 = NPT + bs; L = 1;
            const float* h0 = p.state_ssm + (((size_t)(layer * NS + bs) * 16 + e) * 64 + pp) * 128 + nq * 32;
#pragma unroll
            for (int j = 0; j < 32; ++j) s[j] = h0[j];
            hout = p.out + O_SSMS + (((size_t)(layer * NS + bs) * 16 + e) * 64 + pp) * 128 + nq * 32;
        }
        for (int l = 0; l < L; ++l) {
            int t = t0 + l;
            float dt = p.dt[t * 16 + e];
            float dA = expf(dt * A);
            const bf16_t* xr = p.xbcb + (size_t)t * CONVD;
            float xv = bf2f(xr[e * 64 + pp]);
            float xdt = xv * dt;
            const bf16_t* Bp = xr + 1024 + g * 128 + nq * 32;
            const bf16_t* Cp = xr + 1280 + g * 128 + nq * 32;
            float ys = 0.f;
#pragma unroll
            for (int j4 = 0; j4 < 8; ++j4) {
                float4 b, c;
                b.x = bf2f(Bp[j4 * 4]); b.y = bf2f(Bp[j4 * 4 + 1]); b.z = bf2f(Bp[j4 * 4 + 2]); b.w = bf2f(Bp[j4 * 4 + 3]);
                c.x = bf2f(Cp[j4 * 4]); c.y = bf2f(Cp[j4 * 4 + 1]); c.z = bf2f(Cp[j4 * 4 + 2]); c.w = bf2f(Cp[j4 * 4 + 3]);
                s[j4 * 4 + 0] = s[j4 * 4 + 0] * dA + xdt * b.x; ys += c.x * s[j4 * 4 + 0];
                s[j4 * 4 + 1] = s[j4 * 4 + 1] * dA + xdt * b.y; ys += c.y * s[j4 * 4 + 1];
                s[j4 * 4 + 2] = s[j4 * 4 + 2] * dA + xdt * b.z; ys += c.z * s[j4 * 4 + 2];
                s[j4 * 4 + 3] = s[j4 * 4 + 3] * dA + xdt * b.w; ys += c.w * s[j4 * 4 + 3];
            }
            ys += __shfl_xor(ys, 1);
            ys += __shfl_xor(ys, 2);
            if (nq == 0) {
                const float yg = (ys + Dk * xv) * bf2f(p.zs[(size_t)t * DM + e * 64 + pp]);
                p.ygb[(size_t)t * DM + e * 64 + pp] = f2bf(yg);
                atomicAdd(p.ssy + ((size_t)layer * TP + t) * 2 + g, yg * yg);
            }
        }
#pragma unroll
        for (int j = 0; j < 32; ++j) hout[j] = s[j];
    }
}
__device__ __forceinline__ void ph_gate_norm(const P& p, int layer) {
    const int GX = p.grid;
    const int tid_ = opaque_v((int)threadIdx.x); const int bid_ = opaque_s((int)blockIdx.x); (void)tid_; (void)bid_;
    VB_LOOP((NT * 2 + 3) / 4) {
        int w = vb * 4 + (tid_ >> 6);
        int lane = tid_ & 63;
        if (w < NT * 2) {
            int t = w >> 1, g = w & 1;
            float v[8];
            float ss = 0.f;
#pragma unroll
            for (int j = 0; j < 8; ++j) {
                int c = g * 512 + j * 64 + lane;
                float y = p.yraw[(size_t)t * DM + c];
                v[j] = y * bf2f(p.zs[(size_t)t * DM + c]);
                ss += v[j] * v[j];
            }
            ss = wave_sum(ss);
            float r = rsqrtf(ss / 512.f + EPSF);
#pragma unroll
            for (int j = 0; j < 8; ++j) {
                int c = g * 512 + j * 64 + lane;
                p.ynb[(size_t)t * DM + c] = f2bf(v[j] * r * p.ssm_norm[layer * DM + c]);
            }
        }
    }
}
__device__ __forceinline__ void ph_lat_kpe(const P& p, int layer) {
    const int GX = p.grid;
    const int tid_ = opaque_v((int)threadIdx.x); const int bid_ = opaque_s((int)blockIdx.x);
    VB_LOOP((NT + 3) / 4) {
        int t = vb * 4 + (tid_ >> 6);
        int lane = tid_ & 63;
        if (t < NT) {
            const float4 c4 = *reinterpret_cast<const float4*>(p.ckv + (size_t)t * KVL + lane * 4);
            float ss = wave_sum(c4.x * c4.x + c4.y * c4.y + c4.z * c4.z + c4.w * c4.w);
            const float r = rsqrtf(ss * (1.f / KVL) + EPSF);
            const float4 g4 = *reinterpret_cast<const float4*>(p.kv_norm + layer * KVL + lane * 4);
            const float4 l4 = make_float4(c4.x * r * g4.x, c4.y * r * g4.y, c4.z * r * g4.z, c4.w * r * g4.w);
            *reinterpret_cast<float4*>(p.lat + (size_t)t * KVL + lane * 4) = l4;
            *reinterpret_cast<uint2*>(p.latb + (size_t)t * KVL + lane * 4) = pack4(l4.x, l4.y, l4.z, l4.w);
            float* ol = (t < NPT) ? (p.out + O_LATP + ((size_t)layer * NPT + t) * KVL) : (p.out + O_LATS + ((size_t)layer * NS + (t - NPT)) * KVL);
            *reinterpret_cast<float4*>(ol + lane * 4) = l4;
            if (lane < 16) {
                int pi = (t < NPT) ? (t % SEQ) : 2048;
                const float* cs = p.rope + pi * 16;
                const float* sn = p.rope + 2049 * 16 + pi * 16;
                const float* kr = p.kr + (size_t)t * 32;
                float x1 = kr[lane], x2 = kr[16 + lane];
                float o1 = x1 * cs[lane] - x2 * sn[lane];
                float o2 = x1 * sn[lane] + x2 * cs[lane];
                p.kpe[(size_t)t * 32 + lane] = o1;
                p.kpe[(size_t)t * 32 + 16 + lane] = o2;
                p.kpeb[(size_t)t * 32 + lane] = f2bf(o1);
                p.kpeb[(size_t)t * 32 + 16 + lane] = f2bf(o2);
                float* ok = (t < NPT) ? (p.out + O_KRP + ((size_t)layer * NPT + t) * 32) : (p.out + O_KRS + ((size_t)layer * NS + (t - NPT)) * 32);
                ok[lane] = o1; ok[16 + lane] = o2;
            }
        }
    }
}

#define A_KRS 208
#define A_VRS 144
#define A_KBYTES (64 * A_KRS)
#define A_BUF (64 * A_KRS + 64 * A_VRS)
struct EpiKV { bf16_t* kn; bf16_t* vT; const float* sskv;
    __device__ __forceinline__ void blk(int m, int n, const f32x4 (&c)[4]) const {
        const int h = n >> 7, j = n & 127;
        float rk[4];
#pragma unroll
        for (int r = 0; r < 4; ++r) rk[r] = rsqrtf(sskv[m + r] * (1.f / KVL) + EPSF);
        if (j < 64) {
#pragma unroll
            for (int r = 0; r < 4; ++r) *reinterpret_cast<uint2*>(kn + (size_t)(m + r) * 512 + h * 64 + j) = pack4(c[0][r] * rk[r], c[1][r] * rk[r], c[2][r] * rk[r], c[3][r] * rk[r]);
        } else if (m < NPT) {
#pragma unroll
            for (int jj = 0; jj < 4; ++jj)
                *reinterpret_cast<uint2*>(vT + ((size_t)((m >> 11) * 8 + h) * 64 + (j - 64 + jj)) * SEQ + (m & (SEQ - 1))) = pack4(c[jj][0] * rk[0], c[jj][1] * rk[1], c[jj][2] * rk[2], c[jj][3] * rk[3]);
        }
    } };
__device__ __forceinline__ void attn_unit(const P& p, char* smem, int o, int tid) {
    const int wid = tid >> 6, lane = tid & 63, fr = lane & 15, fq = lane >> 4;
    {
        const int qblk = 15 - (o >> 6), bh = o & 63, b = bh >> 3, h = bh & 7;
        const int q0w = qblk * 128 + wid * 32;
        const size_t tok0 = (size_t)b * SEQ;
        bf16x8 qf[2][3];
#pragma unroll
        for (int qt = 0; qt < 2; ++qt)
#pragma unroll
            for (int s3 = 0; s3 < 3; ++s3)
                qf[qt][s3] = *reinterpret_cast<const bf16x8*>(p.qb + (tok0 + q0w + qt * 16 + fr) * 768 + h * 96 + s3 * 32 + fq * 8);
        f32x4 oacc[2][4];
        float mrun[2], lrun[2];
#pragma unroll
        for (int qt = 0; qt < 2; ++qt) {
            mrun[qt] = -INFINITY; lrun[qt] = 0.f;
#pragma unroll
            for (int mt = 0; mt < 4; ++mt) oacc[qt][mt] = f32x4{0.f, 0.f, 0.f, 0.f};
        }
        const int nkb = 2 * qblk + 2;
        uint4 stg0, stg1, stg2, stg3, stg4;
#define A_ISSUE(kb_) do { const size_t key0 = (size_t)(kb_) * 64; \
            { int c = tid; int row = c >> 3, ch = c & 7; stg0 = *reinterpret_cast<const uint4*>(p.kn + (tok0 + key0 + row) * 512 + h * 64 + ch * 8); } \
            { int c = tid + 256; int row = c >> 3, ch = c & 7; stg1 = *reinterpret_cast<const uint4*>(p.kn + (tok0 + key0 + row) * 512 + h * 64 + ch * 8); } \
            { int c = tid; int row = c >> 2, ch = c & 3; stg2 = *reinterpret_cast<const uint4*>(p.kpeb + (tok0 + key0 + row) * 32 + ch * 8); } \
            { int c = tid; int row = c >> 3, ch = c & 7; stg3 = *reinterpret_cast<const uint4*>(p.vT + ((size_t)(b * 8 + h) * 64 + row) * SEQ + key0 + ch * 8); } \
            { int c = tid + 256; int row = c >> 3, ch = c & 7; stg4 = *reinterpret_cast<const uint4*>(p.vT + ((size_t)(b * 8 + h) * 64 + row) * SEQ + key0 + ch * 8); } \
        } while (0)
#define A_COMMIT(buf_) do { char* buf = (buf_); \
            { int c = tid; int row = c >> 3, ch = c & 7; *reinterpret_cast<uint4*>(buf + row * A_KRS + ch * 16) = stg0; } \
            { int c = tid + 256; int row = c >> 3, ch = c & 7; *reinterpret_cast<uint4*>(buf + row * A_KRS + ch * 16) = stg1; } \
            { int c = tid; int row = c >> 2, ch = c & 3; *reinterpret_cast<uint4*>(buf + row * A_KRS + 128 + ch * 16) = stg2; } \
            { int c = tid; int row = c >> 3, ch = c & 7; *reinterpret_cast<uint4*>(buf + A_KBYTES + row * A_VRS + ch * 16) = stg3; } \
            { int c = tid + 256; int row = c >> 3, ch = c & 7; *reinterpret_cast<uint4*>(buf + A_KBYTES + row * A_VRS + ch * 16) = stg4; } \
        } while (0)
        A_ISSUE(0);
        A_COMMIT(smem);
        __syncthreads();
        for (int kb = 0; kb < nkb; ++kb) {
            const char* kbuf = smem + (kb & 1) * A_BUF;
            const char* vbuf = kbuf + A_KBYTES;
            if (kb + 1 < nkb) A_ISSUE(kb + 1);
#pragma unroll
            for (int kh = 0; kh < 2; ++kh) {
                const int k0 = kb * 64 + kh * 32;
                if (k0 <= q0w + 31) {
                    f32x4 st[2][2];
#pragma unroll
                    for (int qt = 0; qt < 2; ++qt)
#pragma unroll
                        for (int kt = 0; kt < 2; ++kt) st[qt][kt] = f32x4{0.f, 0.f, 0.f, 0.f};
#pragma unroll
                    for (int s3 = 0; s3 < 3; ++s3)
#pragma unroll
                        for (int kt = 0; kt < 2; ++kt) {
                            bf16x8 kf = *reinterpret_cast<const bf16x8*>(kbuf + (kh * 32 + kt * 16 + fr) * A_KRS + (s3 * 32 + fq * 8) * 2);
#pragma unroll
                            for (int qt = 0; qt < 2; ++qt) st[qt][kt] = __builtin_amdgcn_mfma_f32_16x16x32_bf16(kf, qf[qt][s3], st[qt][kt], 0, 0, 0);
                        }
                    const bool need_mask = (k0 + 31 > q0w);
                    bf16x8 pf[2];
#pragma unroll
                    for (int qt = 0; qt < 2; ++qt) {
                        if (need_mask) {
                            const int qi = q0w + qt * 16 + fr;
#pragma unroll
                            for (int kt = 0; kt < 2; ++kt)
#pragma unroll
                                for (int r = 0; r < 4; ++r)
                                    if (k0 + kt * 16 + fq * 4 + r > qi) st[qt][kt][r] = -INFINITY;
                        }
                        float mx = fmaxf(fmaxf(fmaxf(st[qt][0][0], st[qt][0][1]), fmaxf(st[qt][0][2], st[qt][0][3])),
                                         fmaxf(fmaxf(st[qt][1][0], st[qt][1][1]), fmaxf(st[qt][1][2], st[qt][1][3])));
                        mx = fmaxf(mx, __shfl_xor(mx, 16));
                        mx = fmaxf(mx, __shfl_xor(mx, 32));
                        const float mnew = fmaxf(mrun[qt], mx);
                        const float corr = __builtin_amdgcn_exp2f(mrun[qt] - mnew);
                        float pv[8];
                        float rs = 0.f;
#pragma unroll
                        for (int kt = 0; kt < 2; ++kt)
#pragma unroll
                            for (int r = 0; r < 4; ++r) { pv[kt * 4 + r] = __builtin_amdgcn_exp2f(st[qt][kt][r] - mnew); rs += pv[kt * 4 + r]; }
                        rs += __shfl_xor(rs, 16);
                        rs += __shfl_xor(rs, 32);
                        lrun[qt] = lrun[qt] * corr + rs;
                        mrun[qt] = mnew;
#pragma unroll
                        for (int mt = 0; mt < 4; ++mt) { oacc[qt][mt][0] *= corr; oacc[qt][mt][1] *= corr; oacc[qt][mt][2] *= corr; oacc[qt][mt][3] *= corr; }
                        uint4 pk;
                        pk.x = pack_bf16(pv[0], pv[1]); pk.y = pack_bf16(pv[2], pv[3]); pk.z = pack_bf16(pv[4], pv[5]); pk.w = pack_bf16(pv[6], pv[7]);
                        pf[qt] = __builtin_bit_cast(bf16x8, pk);
                    }
#pragma unroll
                    for (int mt = 0; mt < 4; ++mt) {
                        const char* vp = vbuf + (mt * 16 + fr) * A_VRS + (kh * 32 + fq * 4) * 2;
                        uint2 lo = *reinterpret_cast<const uint2*>(vp);
                        uint2 hi = *reinterpret_cast<const uint2*>(vp + 32);
                        uint4 vv; vv.x = lo.x; vv.y = lo.y; vv.z = hi.x; vv.w = hi.y;
                        bf16x8 vf = __builtin_bit_cast(bf16x8, vv);
#pragma unroll
                        for (int qt = 0; qt < 2; ++qt) oacc[qt][mt] = __builtin_amdgcn_mfma_f32_16x16x32_bf16(vf, pf[qt], oacc[qt][mt], 0, 0, 0);
                    }
                }
            }
            if (kb + 1 < nkb) A_COMMIT(smem + ((kb + 1) & 1) * A_BUF);
            __syncthreads();
        }
#pragma unroll
        for (int qt = 0; qt < 2; ++qt) {
            const float inv = 1.f / lrun[qt];
            bf16_t* op = p.ob + (tok0 + q0w + qt * 16 + fr) * 512 + h * 64 + fq * 4;
#pragma unroll
            for (int mt = 0; mt < 4; ++mt) {
                uint2 w;
                w.x = pack_bf16(oacc[qt][mt][0] * inv, oacc[qt][mt][1] * inv);
                w.y = pack_bf16(oacc[qt][mt][2] * inv, oacc[qt][mt][3] * inv);
                *reinterpret_cast<uint2*>(op + mt * 16) = w;
            }
        }
    }
}
__device__ __forceinline__ void ph_qlat(const P& p, int layer) {
    const int GX = p.grid;
    const int tid_ = opaque_v((int)threadIdx.x); const int bid_ = opaque_s((int)blockIdx.x); (void)tid_; (void)bid_;
    VB_LOOP(NS * 8) {
        int bs = vb / 8, h = vb % 8;
        int r = tid_;
        const float* qp = p.q + (size_t)(NPT + bs) * 768 + h * 96;
        const float* w = p.w_kvb + (size_t)layer * 256 * 1024 + (size_t)r * 1024 + h * 128;
        float s = 0.f;
        for (int d = 0; d < 64; ++d) s += qp[d] * w[d];
        p.qlat[((size_t)bs * 8 + h) * 256 + r] = s * ATT_SCALE;
    }
}
__device__ __forceinline__ void ph_mix(const P& p, int layer) {
    const int GX = p.grid;
    const int tid_ = opaque_v((int)threadIdx.x); const int bid_ = opaque_s((int)blockIdx.x); (void)tid_; (void)bid_;
    const size_t n = (size_t)NT * DM;
    for (size_t i = (size_t)bid_ * NTHR + tid_; i < n; i += (size_t)GX * NTHR) {
        int t = (int)(i / DM), c = (int)(i % DM);
        float ga = bf2f(p.gab[(size_t)t * 2048 + c]);
        float gb = bf2f(p.gab[(size_t)t * 2048 + 1024 + c]);
        p.mixb[i] = f2bf(ga * p.ya[i] + gb * p.yb[i]);
    }
}

__device__ __forceinline__ float dot2bf(unsigned a, unsigned b, float c) {
    return __builtin_amdgcn_fdot2_f32_bf16(__builtin_bit_cast(bf16x2_t, a), __builtin_bit_cast(bf16x2_t, b), c, false);
}
typedef __attribute__((ext_vector_type(2))) float f32x2;
__device__ __forceinline__ void fp8_row(const float* src, unsigned char* dst, float* inv, int r, const float* cs, int lane) {
    const float4* sp = reinterpret_cast<const float4*>(src + (size_t)r * DM + lane * 16);
    float4 a = sp[0], b = sp[1], c = sp[2], d = sp[3];
    if (cs) {
        const float4* cp = reinterpret_cast<const float4*>(cs + lane * 16);
        const float4 ca = cp[0], cb = cp[1], cc = cp[2], cd = cp[3];
        a.x *= ca.x; a.y *= ca.y; a.z *= ca.z; a.w *= ca.w; b.x *= cb.x; b.y *= cb.y; b.z *= cb.z; b.w *= cb.w;
        c.x *= cc.x; c.y *= cc.y; c.z *= cc.z; c.w *= cc.w; d.x *= cd.x; d.y *= cd.y; d.z *= cd.z; d.w *= cd.w;
    }
    float mx = fmaxf(fmaxf(fmaxf(fabsf(a.x), fabsf(a.y)), fmaxf(fabsf(a.z), fabsf(a.w))), fmaxf(fmaxf(fabsf(b.x), fabsf(b.y)), fmaxf(fabsf(b.z), fabsf(b.w))));
    mx = fmaxf(mx, fmaxf(fmaxf(fmaxf(fabsf(c.x), fabsf(c.y)), fmaxf(fabsf(c.z), fabsf(c.w))), fmaxf(fmaxf(fabsf(d.x), fabsf(d.y)), fmaxf(fabsf(d.z), fabsf(d.w)))));
    mx = fmaxf(wave_max(mx), 1e-30f);
    const float sc = 224.f / mx;
    uint4 o; int w;
    w = 0; w = __builtin_amdgcn_cvt_pk_fp8_f32(a.x * sc, a.y * sc, w, false); w = __builtin_amdgcn_cvt_pk_fp8_f32(a.z * sc, a.w * sc, w, true); o.x = (unsigned)w;
    w = 0; w = __builtin_amdgcn_cvt_pk_fp8_f32(b.x * sc, b.y * sc, w, false); w = __builtin_amdgcn_cvt_pk_fp8_f32(b.z * sc, b.w * sc, w, true); o.y = (unsigned)w;
    w = 0; w = __builtin_amdgcn_cvt_pk_fp8_f32(c.x * sc, c.y * sc, w, false); w = __builtin_amdgcn_cvt_pk_fp8_f32(c.z * sc, c.w * sc, w, true); o.z = (unsigned)w;
    w = 0; w = __builtin_amdgcn_cvt_pk_fp8_f32(d.x * sc, d.y * sc, w, false); w = __builtin_amdgcn_cvt_pk_fp8_f32(d.z * sc, d.w * sc, w, true); o.w = (unsigned)w;
    *reinterpret_cast<uint4*>(dst + (size_t)r * DM + lane * 16) = o;
    if (lane == 0) inv[r] = mx / 224.f;
}
__device__ __forceinline__ void fp8_unit(const P& p, int layer, int item, int tid) {
    const int wid = tid >> 6, lane = tid & 63;
    const bool isv = item >= 256;
    const int r0 = layer * NEXP + (item & 255) * 64 + wid * 16;
    const float* src = isv ? p.peer_v : p.peer_u;
    unsigned char* dst = isv ? p.v8 : p.u8;
    float* inv = isv ? p.vinv : p.uinv;
    const float* cs = isv ? nullptr : (p.norm_ffn + (size_t)layer * DM);
#pragma unroll 4
    for (int i = 0; i < 16; ++i) fp8_row(src, dst, inv, r0 + i, cs, lane);
}
#define FP8_UNPACK16(v_, f_) do { \
    f32x2 t_; \
    t_ = __builtin_amdgcn_cvt_pk_f32_fp8((int)(v_).x, false); f_[0] = t_[0]; f_[1] = t_[1]; t_ = __builtin_amdgcn_cvt_pk_f32_fp8((int)(v_).x, true); f_[2] = t_[0]; f_[3] = t_[1]; \
    t_ = __builtin_amdgcn_cvt_pk_f32_fp8((int)(v_).y, false); f_[4] = t_[0]; f_[5] = t_[1]; t_ = __builtin_amdgcn_cvt_pk_f32_fp8((int)(v_).y, true); f_[6] = t_[0]; f_[7] = t_[1]; \
    t_ = __builtin_amdgcn_cvt_pk_f32_fp8((int)(v_).z, false); f_[8] = t_[0]; f_[9] = t_[1]; t_ = __builtin_amdgcn_cvt_pk_f32_fp8((int)(v_).z, true); f_[10] = t_[0]; f_[11] = t_[1]; \
    t_ = __builtin_amdgcn_cvt_pk_f32_fp8((int)(v_).w, false); f_[12] = t_[0]; f_[13] = t_[1]; t_ = __builtin_amdgcn_cvt_pk_f32_fp8((int)(v_).w, true); f_[14] = t_[0]; f_[15] = t_[1]; \
} while (0)
__device__ __forceinline__ void ph_peer_experts3(const P& p, int layer, char* smem) {
    const int GX = p.grid;
    const int tid = opaque_v((int)threadIdx.x); const int bid = opaque_s((int)blockIdx.x);
    const int wid = tid >> 6, lane = tid & 63;
    const unsigned char* U = p.u8 + (size_t)layer * NEXP * DM;
    const unsigned char* V = p.v8 + (size_t)layer * NEXP * DM;
    const float* IU = p.uinv + (size_t)layer * NEXP;
    const float* IV = p.vinv + (size_t)layer * NEXP;
#pragma unroll 1
    for (int pass = 0; pass < 2; ++pass) {
    const bool coop = pass != 0;
    const int tstart = coop ? (NPT + bid) : (bid * 4 + wid), tend = coop ? NT : NPT, tstride = coop ? GX : GX * 4;
    const int kb = coop ? wid * 32 : 0, ke = coop ? kb + 32 : 128;
#pragma unroll 1
    for (int t = tstart; t < tend; t += tstride) {
        float hx[16];
        {
            const uint4* hrow = reinterpret_cast<const uint4*>(p.xb + (size_t)t * DM + lane * 16);
            const uint4 h0 = hrow[0], h1 = hrow[1];
            hx[0] = bflo(h0.x); hx[1] = bfhi(h0.x); hx[2] = bflo(h0.y); hx[3] = bfhi(h0.y); hx[4] = bflo(h0.z); hx[5] = bfhi(h0.z); hx[6] = bflo(h0.w); hx[7] = bfhi(h0.w);
            hx[8] = bflo(h1.x); hx[9] = bfhi(h1.x); hx[10] = bflo(h1.y); hx[11] = bfhi(h1.y); hx[12] = bflo(h1.z); hx[13] = bfhi(h1.z); hx[14] = bflo(h1.w); hx[15] = bfhi(h1.w);
        }
        const int i0 = p.idx[(size_t)t * 128 + lane], i1 = p.idx[(size_t)t * 128 + 64 + lane];
        const float g0 = p.gate[(size_t)t * 128 + lane], g1 = p.gate[(size_t)t * 128 + 64 + lane];
        const float rs1 = rsqrtf(p.sumsq1[(size_t)layer * TP + t] * (1.f / DM) + EPSF);
        const float su0 = IU[i0] * rs1, su1 = IU[i1] * rs1;
        float w0 = 0.f, w1 = 0.f;
        uint4 nx[8];
#pragma unroll
        for (int j = 0; j < 8; ++j) nx[j] = *reinterpret_cast<const uint4*>(U + (size_t)__builtin_amdgcn_readlane((kb < 64) ? i0 : i1, (kb + j) & 63) * DM + lane * 16);
#pragma unroll 1
        for (int kk = kb; kk < ke; kk += 8) {
            uint4 cu[8];
#pragma unroll
            for (int j = 0; j < 8; ++j) cu[j] = nx[j];
            if (kk + 8 < ke) {
                const int ivn = (kk + 8 < 64) ? i0 : i1;
#pragma unroll
                for (int j = 0; j < 8; ++j) nx[j] = *reinterpret_cast<const uint4*>(U + (size_t)__builtin_amdgcn_readlane(ivn, (kk + 8 + j) & 63) * DM + lane * 16);
            }
            float sd[8];
#pragma unroll
            for (int j = 0; j < 8; ++j) {
                float f[16];
                FP8_UNPACK16(cu[j], f);
                float a = 0.f;
#pragma unroll
                for (int i = 0; i < 16; ++i) a += f[i] * hx[i];
                sd[j] = a;
            }
#pragma unroll
            for (int o = 32; o > 0; o >>= 1) {
#pragma unroll
                for (int j = 0; j < 8; ++j) sd[j] += __shfl_xor(sd[j], o);
            }
            {
                const int jl = (lane - kk) & 63;
                float xs = sd[0];
#pragma unroll
                for (int j = 1; j < 8; ++j) xs = (jl == j) ? sd[j] : xs;
                if (jl < 8) {
                    const float x = xs * ((kk < 64) ? su0 : su1);
                    const float act = 0.5f * x * (1.f + erff(x * 0.70710678118654752f));
                    if (kk < 64) w0 = g0 * act; else w1 = g1 * act;
                }
            }
        }
        w0 *= IV[i0]; w1 *= IV[i1];
        float acc[16];
#pragma unroll
        for (int i = 0; i < 16; ++i) acc[i] = 0.f;
#pragma unroll
        for (int j = 0; j < 8; ++j) nx[j] = *reinterpret_cast<const uint4*>(V + (size_t)__builtin_amdgcn_readlane((kb < 64) ? i0 : i1, (kb + j) & 63) * DM + lane * 16);
#pragma unroll 1
        for (int kk = kb; kk < ke; kk += 8) {
            uint4 cu[8];
#pragma unroll
            for (int j = 0; j < 8; ++j) cu[j] = nx[j];
            if (kk + 8 < ke) {
                const int ivn = (kk + 8 < 64) ? i0 : i1;
#pragma unroll
                for (int j = 0; j < 8; ++j) nx[j] = *reinterpret_cast<const uint4*>(V + (size_t)__builtin_amdgcn_readlane(ivn, (kk + 8 + j) & 63) * DM + lane * 16);
            }
            const float wv = (kk < 64) ? w0 : w1;
#pragma unroll
            for (int j = 0; j < 8; ++j) {
                const float w = __builtin_bit_cast(float, __builtin_amdgcn_readlane(__builtin_bit_cast(int, wv), (kk + j) & 63));
                float f[16];
                FP8_UNPACK16(cu[j], f);
#pragma unroll
                for (int i = 0; i < 16; ++i) acc[i] += w * f[i];
            }
        }
        if (coop) {
            float4* red = reinterpret_cast<float4*>(smem) + (size_t)wid * 256 + lane * 4;
#pragma unroll
            for (int q4 = 0; q4 < 4; ++q4) red[q4] = make_float4(acc[q4 * 4 + 0], acc[q4 * 4 + 1], acc[q4 * 4 + 2], acc[q4 * 4 + 3]);
            __syncthreads();
            if (wid == 0) {
#pragma unroll
                for (int w = 1; w < 4; ++w)
#pragma unroll
                    for (int q4 = 0; q4 < 4; ++q4) {
                        const float4 o = reinterpret_cast<const float4*>(smem)[(size_t)w * 256 + lane * 4 + q4];
                        acc[q4 * 4 + 0] += o.x; acc[q4 * 4 + 1] += o.y; acc[q4 * 4 + 2] += o.z; acc[q4 * 4 + 3] += o.w;
                    }
            }
            __syncthreads();
        }
        if (!coop || wid == 0) {
        float4* xp = reinterpret_cast<float4*>(p.xres + (size_t)t * DM + lane * 16);
        float4 xv[4]; float ss = 0.f;
#pragma unroll
        for (int q4 = 0; q4 < 4; ++q4) {
            float4 x = xp[q4];
            x.x += acc[q4 * 4 + 0]; x.y += acc[q4 * 4 + 1]; x.z += acc[q4 * 4 + 2]; x.w += acc[q4 * 4 + 3];
            xv[q4] = x; ss += x.x * x.x + x.y * x.y + x.z * x.z + x.w * x.w;
        }
        ss = wave_sum(ss);
        const float rs2 = rsqrtf(ss * (1.f / DM) + EPSF);
        if (layer + 1 < DEPTH) {
#pragma unroll
            for (int q4 = 0; q4 < 4; ++q4) xp[q4] = xv[q4];
            uint4 b0, b1;
            b0.x = pack_bf16(xv[0].x, xv[0].y); b0.y = pack_bf16(xv[0].z, xv[0].w); b0.z = pack_bf16(xv[1].x, xv[1].y); b0.w = pack_bf16(xv[1].z, xv[1].w);
            b1.x = pack_bf16(xv[2].x, xv[2].y); b1.y = pack_bf16(xv[2].z, xv[2].w); b1.z = pack_bf16(xv[3].x, xv[3].y); b1.w = pack_bf16(xv[3].z, xv[3].w);
            uint4* bp = reinterpret_cast<uint4*>(p.xb + (size_t)t * DM + lane * 16);
            bp[0] = b0; bp[1] = b1;
            if (lane == 0) p.rstd[t] = rs2;
        } else {
            const float4* np = reinterpret_cast<const float4*>(p.norm_final + lane * 16);
            float4* op = reinterpret_cast<float4*>(p.out + O_YP + (size_t)t * DM + lane * 16);
#pragma unroll
            for (int q4 = 0; q4 < 4; ++q4) {
                const float4 g = np[q4];
                float4 y; y.x = xv[q4].x * rs2 * g.x; y.y = xv[q4].y * rs2 * g.y; y.z = xv[q4].z * rs2 * g.z; y.w = xv[q4].w * rs2 * g.w;
                op[q4] = y;
            }
        }
        }
    }
    }
}

typedef __attribute__((ext_vector_type(4))) short s16x4;
#define S_XS 160
#define S_BS 288
#define S_HS 272
#define S_XR 0
#define S_BR (128 * S_XS)
#define S_HL (128 * S_XS + 128 * S_BS)
#define S_ACS (128 * S_XS + 128 * S_BS + 64 * S_HS)
#define S_DTL (S_ACS + 512)
#define S_WL (S_DTL + 512)
typedef __attribute__((address_space(3))) s16x4* lds_tr_ptr;
__device__ __forceinline__ bf16x8 tr_pair(const char* a0, const char* a1) {
    const s16x4 lo = __builtin_amdgcn_ds_read_tr16_b64_v4i16((lds_tr_ptr)a0);
    const s16x4 hi = __builtin_amdgcn_ds_read_tr16_b64_v4i16((lds_tr_ptr)a1);
    bf16x8 r; r[0] = lo[0]; r[1] = lo[1]; r[2] = lo[2]; r[3] = lo[3]; r[4] = hi[0]; r[5] = hi[1]; r[6] = hi[2]; r[7] = hi[3];
    return r;
}
__device__ __forceinline__ void ph_ssd_chunk(const P& p, int layer, char* smem) {
    const int GX = p.grid;
    const int tid = opaque_v((int)threadIdx.x); const int bid = opaque_s((int)blockIdx.x);
    const int wid = __builtin_amdgcn_readfirstlane(tid >> 6), lane = tid & 63, fr = lane & 15, fq = lane >> 4;
    float* acs = reinterpret_cast<float*>(smem + S_ACS);
    float* dtl = reinterpret_cast<float*>(smem + S_DTL);
    float* wl = reinterpret_cast<float*>(smem + S_WL);
    const int trr = fr >> 2, trc = (fr & 3) * 8;
    const int lt0 = wid * 16, lt1 = (7 - wid) * 16;
    for (int u = bid; u < NB * 16; u += GX) {
        const int b = u >> 4, e = u & 15, g = e >> 3;
        const float A = -__expf(p.a_log[layer * 16 + e]);
        const float Dk = p.d_skip[layer * 16 + e];
        f32x4 hT[2][4];
#pragma unroll
        for (int i = 0; i < 2; ++i)
#pragma unroll
            for (int pt = 0; pt < 4; ++pt) hT[i][pt] = f32x4{0.f, 0.f, 0.f, 0.f};
#pragma unroll 1
        for (int c = 0; c < 16; ++c) {
            const size_t t0 = (size_t)b * SEQ + c * 128;
            if (wid == 0) {
                const float d0 = p.dt[(t0 + lane) * 16 + e], d1 = p.dt[(t0 + 64 + lane) * 16 + e];
                float s0 = d0 * A, s1 = d1 * A;
#pragma unroll
                for (int o = 1; o < 64; o <<= 1) {
                    float t0s = __shfl_up(s0, o), t1s = __shfl_up(s1, o);
                    if (lane >= o) { s0 += t0s; s1 += t1s; }
                }
                s1 += __shfl(s0, 63);
                const float aend = __shfl(s1, 63);
                acs[lane] = s0; acs[64 + lane] = s1; dtl[lane] = d0; dtl[64 + lane] = d1;
                wl[lane] = d0 * __expf(aend - s0); wl[64 + lane] = d1 * __expf(aend - s1);
            }
#pragma unroll
            for (int i = 0; i < 4; ++i) {
                const int id = tid + 256 * i, l = id >> 3, pc = id & 7;
                *reinterpret_cast<uint4*>(smem + S_XR + l * S_XS + pc * 16) = *reinterpret_cast<const uint4*>(p.xbcb + (t0 + l) * CONVD + e * 64 + pc * 8);
            }
#pragma unroll
            for (int i = 0; i < 8; ++i) {
                const int id = tid + 256 * i, l = id >> 4, nc = id & 15;
                *reinterpret_cast<uint4*>(smem + S_BR + l * S_BS + nc * 16) = *reinterpret_cast<const uint4*>(p.xbcb + (t0 + l) * CONVD + 1024 + g * 128 + nc * 8);
            }
#pragma unroll
            for (int i = 0; i < 2; ++i)
#pragma unroll
                for (int pt = 0; pt < 4; ++pt) {
                    uint2 w2;
                    w2.x = pack_bf16(hT[i][pt][0], hT[i][pt][1]); w2.y = pack_bf16(hT[i][pt][2], hT[i][pt][3]);
                    *reinterpret_cast<uint2*>(smem + S_HL + (pt * 16 + fr) * S_HS + (wid * 32 + i * 16 + fq * 4) * 2) = w2;
                }
            bf16x8 cf[2][4];
#pragma unroll
            for (int j = 0; j < 2; ++j)
#pragma unroll
                for (int k = 0; k < 4; ++k)
                    cf[j][k] = *reinterpret_cast<const bf16x8*>(p.xbcb + (t0 + (j ? lt1 : lt0) + fr) * CONVD + 1280 + g * 128 + k * 32 + fq * 8);
            __syncthreads();
            f32x4 acc[4][2];
#pragma unroll
            for (int pt = 0; pt < 4; ++pt)
#pragma unroll
                for (int j = 0; j < 2; ++j) acc[pt][j] = f32x4{0.f, 0.f, 0.f, 0.f};
#pragma unroll
            for (int pt = 0; pt < 4; ++pt)
#pragma unroll
                for (int k = 0; k < 4; ++k) {
                    const bf16x8 hf = *reinterpret_cast<const bf16x8*>(smem + S_HL + (pt * 16 + fr) * S_HS + (k * 32 + fq * 8) * 2);
#pragma unroll
                    for (int j = 0; j < 2; ++j) acc[pt][j] = __builtin_amdgcn_mfma_f32_16x16x32_bf16(hf, cf[j][k], acc[pt][j], 0, 0, 0);
                }
            float alv[2];
#pragma unroll
            for (int j = 0; j < 2; ++j) {
                alv[j] = acs[(j ? lt1 : lt0) + fr];
                const float el = __expf(alv[j]);
#pragma unroll
                for (int pt = 0; pt < 4; ++pt) { acc[pt][j][0] *= el; acc[pt][j][1] *= el; acc[pt][j][2] *= el; acc[pt][j][3] *= el; }
            }
#pragma unroll 1
            for (int ii = 0; ii <= ((7 - wid) >> 1); ++ii) {
                const bool act0 = ii <= (wid >> 1);
                f32x4 cb[2][2];
#pragma unroll
                for (int si = 0; si < 2; ++si)
#pragma unroll
                    for (int j = 0; j < 2; ++j) cb[si][j] = f32x4{0.f, 0.f, 0.f, 0.f};
#pragma unroll
                for (int k = 0; k < 4; ++k)
#pragma unroll
                    for (int si = 0; si < 2; ++si) {
                        const bf16x8 bfr = *reinterpret_cast<const bf16x8*>(smem + S_BR + (ii * 32 + si * 16 + fr) * S_BS + (k * 32 + fq * 8) * 2);
                        if (act0) cb[si][0] = __builtin_amdgcn_mfma_f32_16x16x32_bf16(bfr, cf[0][k], cb[si][0], 0, 0, 0);
                        cb[si][1] = __builtin_amdgcn_mfma_f32_16x16x32_bf16(bfr, cf[1][k], cb[si][1], 0, 0, 0);
                    }
                bf16x8 mf[2];
                {
                    float as8[8], ds8[8];
#pragma unroll
                    for (int si = 0; si < 2; ++si) {
                        const float4 a4 = *reinterpret_cast<const float4*>(acs + ii * 32 + si * 16 + fq * 4);
                        const float4 d4 = *reinterpret_cast<const float4*>(dtl + ii * 32 + si * 16 + fq * 4);
                        as8[si * 4 + 0] = a4.x; as8[si * 4 + 1] = a4.y; as8[si * 4 + 2] = a4.z; as8[si * 4 + 3] = a4.w;
                        ds8[si * 4 + 0] = d4.x; ds8[si * 4 + 1] = d4.y; ds8[si * 4 + 2] = d4.z; ds8[si * 4 + 3] = d4.w;
                    }
#pragma unroll
                    for (int j = 0; j < 2; ++j) {
                        const int lidx = (j ? lt1 : lt0) + fr;
                        float mv[8];
#pragma unroll
                        for (int si = 0; si < 2; ++si)
#pragma unroll
                            for (int r = 0; r < 4; ++r) {
                                const int sidx = ii * 32 + si * 16 + fq * 4 + r;
                                const float dec = __expf(fminf(alv[j] - as8[si * 4 + r], 0.f)) * ds8[si * 4 + r];
                                mv[si * 4 + r] = (lidx >= sidx) ? cb[si][j][r] * dec : 0.f;
                            }
                        uint4 pk;
                        pk.x = pack_bf16(mv[0], mv[1]); pk.y = pack_bf16(mv[2], mv[3]); pk.z = pack_bf16(mv[4], mv[5]); pk.w = pack_bf16(mv[6], mv[7]);
                        mf[j] = __builtin_bit_cast(bf16x8, pk);
                    }
                }
#pragma unroll
                for (int pt = 0; pt < 4; ++pt) {
                    const char* xa = smem + S_XR + (ii * 32 + fq * 4 + trr) * S_XS + pt * 32 + trc;
                    const bf16x8 xf = tr_pair(xa, xa + 16 * S_XS);
                    if (act0) acc[pt][0] = __builtin_amdgcn_mfma_f32_16x16x32_bf16(xf, mf[0], acc[pt][0], 0, 0, 0);
                    acc[pt][1] = __builtin_amdgcn_mfma_f32_16x16x32_bf16(xf, mf[1], acc[pt][1], 0, 0, 0);
                }
            }
#pragma unroll
            for (int j = 0; j < 2; ++j) {
                const int ll = (j ? lt1 : lt0) + fr;
                const size_t tl = t0 + ll;
                float ssl = 0.f;
#pragma unroll
                for (int pt = 0; pt < 4; ++pt) {
                    const uint2 xx = *reinterpret_cast<const uint2*>(smem + S_XR + ll * S_XS + (pt * 16 + fq * 4) * 2);
                    const uint2 zz = *reinterpret_cast<const uint2*>(p.zs + tl * DM + e * 64 + pt * 16 + fq * 4);
                    const float y0 = (acc[pt][j][0] + Dk * bflo(xx.x)) * bflo(zz.x), y1 = (acc[pt][j][1] + Dk * bfhi(xx.x)) * bfhi(zz.x);
                    const float y2 = (acc[pt][j][2] + Dk * bflo(xx.y)) * bflo(zz.y), y3 = (acc[pt][j][3] + Dk * bfhi(xx.y)) * bfhi(zz.y);
                    *reinterpret_cast<uint2*>(p.ygb + tl * DM + e * 64 + pt * 16 + fq * 4) = pack4(y0, y1, y2, y3);
                    ssl += y0 * y0 + y1 * y1 + y2 * y2 + y3 * y3;
                }
                ssl += __shfl_xor(ssl, 16);
                ssl += __shfl_xor(ssl, 32);
                if (fq == 0) atomicAdd(p.ssy + ((size_t)layer * TP + tl) * 2 + g, ssl);
            }
            {
                const float dec = __expf(acs[127]);
#pragma unroll
                for (int i = 0; i < 2; ++i)
#pragma unroll
                    for (int pt = 0; pt < 4; ++pt) { hT[i][pt][0] *= dec; hT[i][pt][1] *= dec; hT[i][pt][2] *= dec; hT[i][pt][3] *= dec; }
            }
#pragma unroll
            for (int k = 0; k < 4; ++k) {
                const float4 w0 = *reinterpret_cast<const float4*>(wl + k * 32 + fq * 8);
                const float4 w1 = *reinterpret_cast<const float4*>(wl + k * 32 + fq * 8 + 4);
                bf16x8 bt[2];
#pragma unroll
                for (int i = 0; i < 2; ++i) {
                    const char* ba = smem + S_BR + (k * 32 + fq * 8 + trr) * S_BS + (wid * 32 + i * 16) * 2 + trc;
                    bt[i] = tr_pair(ba, ba + 4 * S_BS);
                }
#pragma unroll
                for (int pt = 0; pt < 4; ++pt) {
                    const char* xa = smem + S_XR + (k * 32 + fq * 8 + trr) * S_XS + pt * 32 + trc;
                    const uint4 xr = __builtin_bit_cast(uint4, tr_pair(xa, xa + 4 * S_XS));
                    uint4 xs;
                    xs.x = pack_bf16(bflo(xr.x) * w0.x, bfhi(xr.x) * w0.y); xs.y = pack_bf16(bflo(xr.y) * w0.z, bfhi(xr.y) * w0.w);
                    xs.z = pack_bf16(bflo(xr.z) * w1.x, bfhi(xr.z) * w1.y); xs.w = pack_bf16(bflo(xr.w) * w1.z, bfhi(xr.w) * w1.w);
                    const bf16x8 xsf = __builtin_bit_cast(bf16x8, xs);
#pragma unroll
                    for (int i = 0; i < 2; ++i) hT[i][pt] = __builtin_amdgcn_mfma_f32_16x16x32_bf16(bt[i], xsf, hT[i][pt], 0, 0, 0);
                }
            }
            __syncthreads();
        }
#pragma unroll
        for (int i = 0; i < 2; ++i)
#pragma unroll
            for (int pt = 0; pt < 4; ++pt) {
                float4 hv; hv.x = hT[i][pt][0]; hv.y = hT[i][pt][1]; hv.z = hT[i][pt][2]; hv.w = hT[i][pt][3];
                *reinterpret_cast<float4*>(p.out + O_SSMP + (((size_t)(layer * NB + b) * 16 + e) * 64 + pt * 16 + fr) * 128 + wid * 32 + i * 16 + fq * 4) = hv;
            }
    }
}

__device__ __forceinline__ int med3i(int a, int b, int c) { return max(min(a, b), min(max(a, b), c)); }
__device__ __forceinline__ int okey(float v) { int o = __float_as_int(v); return o ^ ((o >> 31) & 0x7fffffff); }
__device__ __forceinline__ float okey_inv(int o) { return __int_as_float(o ^ ((o >> 31) & 0x7fffffff)); }
#define TK_INSERT(L_, key_) do { const int k_ = (key_); \
    L_[15] = med3i(L_[14], L_[15], k_); L_[14] = med3i(L_[13], L_[14], k_); L_[13] = med3i(L_[12], L_[13], k_); L_[12] = med3i(L_[11], L_[12], k_); \
    L_[11] = med3i(L_[10], L_[11], k_); L_[10] = med3i(L_[9], L_[10], k_); L_[9] = med3i(L_[8], L_[9], k_); L_[8] = med3i(L_[7], L_[8], k_); \
    L_[7] = med3i(L_[6], L_[7], k_); L_[6] = med3i(L_[5], L_[6], k_); L_[5] = med3i(L_[4], L_[5], k_); L_[4] = med3i(L_[3], L_[4], k_); \
    L_[3] = med3i(L_[2], L_[3], k_); L_[2] = med3i(L_[1], L_[2], k_); L_[1] = med3i(L_[0], L_[1], k_); L_[0] = max(L_[0], k_); } while (0)
#define TK_INS2(a_, b_) do { const float sv_ = V1[a_] + V2[b_]; TK_INSERT(M, (okey(sv_) & ~255) | (255 - ((a_) * 16 + (b_)))); } while (0)
__device__ __forceinline__ void ph_peer_topk2(const P& p) {
    const int GX = p.grid;
    const int tid = opaque_v((int)threadIdx.x); const int bid = opaque_s((int)blockIdx.x);
    for (int pr = bid * NTHR + tid; pr < NT * 8; pr += GX * NTHR) {
        const int t = pr >> 3, h = pr & 7;
        int L1[16], L2[16], M[16];
#pragma unroll
        for (int i = 0; i < 16; ++i) { L1[i] = (int)0x80000000; L2[i] = (int)0x80000000; M[i] = (int)0x80000000; }
        const float4* sp = reinterpret_cast<const float4*>(p.sc + (size_t)t * 2048 + h * 256);
#pragma unroll 1
        for (int k8 = 0; k8 < 4; ++k8) {
            float4 v[8];
#pragma unroll
            for (int q = 0; q < 8; ++q) v[q] = sp[k8 * 8 + q];
#pragma unroll
            for (int q = 0; q < 8; ++q) {
                const int kb = 127 - (k8 * 8 + q) * 4;
                TK_INSERT(L1, (okey(v[q].x) & ~127) | (kb - 0));
                TK_INSERT(L1, (okey(v[q].y) & ~127) | (kb - 1));
                TK_INSERT(L1, (okey(v[q].z) & ~127) | (kb - 2));
                TK_INSERT(L1, (okey(v[q].w) & ~127) | (kb - 3));
            }
        }
#pragma unroll 1
        for (int k8 = 0; k8 < 4; ++k8) {
            float4 v[8];
#pragma unroll
            for (int q = 0; q < 8; ++q) v[q] = sp[32 + k8 * 8 + q];
#pragma unroll
            for (int q = 0; q < 8; ++q) {
                const int kb = 127 - (k8 * 8 + q) * 4;
                TK_INSERT(L2, (okey(v[q].x) & ~127) | (kb - 0));
                TK_INSERT(L2, (okey(v[q].y) & ~127) | (kb - 1));
                TK_INSERT(L2, (okey(v[q].z) & ~127) | (kb - 2));
                TK_INSERT(L2, (okey(v[q].w) & ~127) | (kb - 3));
            }
        }
        float V1[16], V2[16];
#pragma unroll
        for (int i = 0; i < 16; ++i) { V1[i] = okey_inv(L1[i] & ~127); V2[i] = okey_inv(L2[i] & ~127); }
        TK_INS2(0, 0);
        TK_INS2(0, 1);
        TK_INS2(0, 2);
        TK_INS2(0, 3);
        TK_INS2(0, 4);
        TK_INS2(0, 5);
        TK_INS2(0, 6);
        TK_INS2(0, 7);
        TK_INS2(0, 8);
        TK_INS2(0, 9);
        TK_INS2(0, 10);
        TK_INS2(0, 11);
        TK_INS2(0, 12);
        TK_INS2(0, 13);
        TK_INS2(0, 14);
        TK_INS2(0, 15);
        TK_INS2(1, 0);
        TK_INS2(1, 1);
        TK_INS2(1, 2);
        TK_INS2(1, 3);
        TK_INS2(1, 4);
        TK_INS2(1, 5);
        TK_INS2(1, 6);
        TK_INS2(1, 7);
        TK_INS2(2, 0);
        TK_INS2(2, 1);
        TK_INS2(2, 2);
        TK_INS2(2, 3);
        TK_INS2(2, 4);
        TK_INS2(3, 0);
        TK_INS2(3, 1);
        TK_INS2(3, 2);
        TK_INS2(3, 3);
        TK_INS2(4, 0);
        TK_INS2(4, 1);
        TK_INS2(4, 2);
        TK_INS2(5, 0);
        TK_INS2(5, 1);
        TK_INS2(6, 0);
        TK_INS2(6, 1);
        TK_INS2(7, 0);
        TK_INS2(7, 1);
        TK_INS2(8, 0);
        TK_INS2(9, 0);
        TK_INS2(10, 0);
        TK_INS2(11, 0);
        TK_INS2(12, 0);
        TK_INS2(13, 0);
        TK_INS2(14, 0);
        TK_INS2(15, 0);
        float sv[16];
        int ex[16];
#pragma unroll
        for (int j = 0; j < 16; ++j) {
            const int c = 255 - (M[j] & 255);
            const int a = c >> 4, b = c & 15;
            int ka = L1[0], kb2 = L2[0];
            float va = V1[0], vb = V2[0];
#pragma unroll
            for (int i = 1; i < 16; ++i) {
                if (a == i) { ka = L1[i]; va = V1[i]; }
                if (b == i) { kb2 = L2[i]; vb = V2[i]; }
            }
            sv[j] = va + vb;
            ex[j] = (127 - (ka & 127)) * 128 + (127 - (kb2 & 127));
        }
        float sum = 0.f;
        float ev[16];
#pragma unroll
        for (int j = 0; j < 16; ++j) { ev[j] = __expf(sv[j] - sv[0]); sum += ev[j]; }
        const float inv = 1.f / sum;
        int* ip = p.idx + (size_t)t * 128 + h * 16;
        float* gp = p.gate + (size_t)t * 128 + h * 16;
#pragma unroll
        for (int j4 = 0; j4 < 4; ++j4) {
            *reinterpret_cast<int4*>(ip + j4 * 4) = make_int4(ex[j4 * 4], ex[j4 * 4 + 1], ex[j4 * 4 + 2], ex[j4 * 4 + 3]);
            *reinterpret_cast<float4*>(gp + j4 * 4) = make_float4(ev[j4 * 4] * inv, ev[j4 * 4 + 1] * inv, ev[j4 * 4 + 2] * inv, ev[j4 * 4 + 3] * inv);
        }
    }
}


#define D_RS 544
#define D_NCH 16
__device__ __forceinline__ uint4 pack8(const float4 a, const float4 b, float sc) {
    uint4 r; r.x = pack_bf16(a.x * sc, a.y * sc); r.y = pack_bf16(a.z * sc, a.w * sc); r.z = pack_bf16(b.x * sc, b.y * sc); r.w = pack_bf16(b.z * sc, b.w * sc); return r;
}
__device__ __forceinline__ void decode_unit(const P& p, int layer, char* smem, int u, int tid) {
    const int wid = tid >> 6, lane = tid & 63, fr = lane & 15, fq = lane >> 4;
    char* vbuf = smem + wid * (16 * D_RS);
    const float L2E = 1.4426950408889634f;
    {
        const int bs = u / D_NCH, ch = u % D_NCH;
        float* qls_f = reinterpret_cast<float*>(smem + 4 * 16 * D_RS + 9 * 64 * 16);
        {
            const float* wr = p.w_kvb + (size_t)layer * 256 * 1024 + (size_t)tid * 1024;
            const float* qrow = p.q + (size_t)(NPT + bs) * 768;
#pragma unroll 1
            for (int h = 0; h < 8; ++h) {
                float a = 0.f;
#pragma unroll
                for (int d4 = 0; d4 < 16; ++d4) {
                    const float4 w4 = *reinterpret_cast<const float4*>(wr + h * 128 + d4 * 4);
                    const float4 q4 = *reinterpret_cast<const float4*>(qrow + h * 96 + d4 * 4);
                    a += w4.x * q4.x + w4.y * q4.y + w4.z * q4.z + w4.w * q4.w;
                }
                qls_f[h * 256 + tid] = a * ATT_SCALE;
            }
        }
        __syncthreads();
        char* qls = smem + 4 * 16 * D_RS;
        {
            const int hh = fr & 7;
            const float zf = (fr < 8) ? 1.f : 0.f;
            const float* ql = qls_f + hh * 256 + fq * 8;
            const float* qr = p.q + (size_t)(NPT + bs) * 768 + hh * 96 + 64 + fq * 8;
#pragma unroll
            for (int j = 0; j < 3; ++j) {
                const int s9 = wid + 4 * j;
                if (s9 < 8) {
                    const float4 a = *reinterpret_cast<const float4*>(ql + s9 * 32), b = *reinterpret_cast<const float4*>(ql + s9 * 32 + 4);
                    *reinterpret_cast<uint4*>(qls + (s9 * 64 + lane) * 16) = pack8(a, b, L2E * zf);
                } else if (s9 == 8) {
                    const float4 a = *reinterpret_cast<const float4*>(qr), b = *reinterpret_cast<const float4*>(qr + 4);
                    *reinterpret_cast<uint4*>(qls + (s9 * 64 + lane) * 16) = pack8(a, b, ATT_SCALE * L2E * zf);
                }
            }
        }
        __syncthreads();
        f32x4 oacc[16];
#pragma unroll
        for (int dt = 0; dt < 16; ++dt) oacc[dt] = f32x4{0.f, 0.f, 0.f, 0.f};
        float mrun = -INFINITY, lrun = 0.f;
#pragma unroll 1
        for (int it = 0; it < 16; ++it) {
            const int ti = wid + 4 * it;
            const int pg = p.page_table[bs * NPAGES + ch * 8 + (ti >> 3)];
            const size_t krow = ((size_t)layer * NPOOL + pg) * PAGE + (ti & 7) * 16 + fr;
            const float* lp = p.cache_lat + krow * KVL + fq * 8;
            const float* rp = p.cache_kr + krow * 32 + fq * 8;
            bf16x8 kf[9];
            {
                float4 raw[10];
#pragma unroll
                for (int s9 = 0; s9 < 5; ++s9) { raw[2 * s9] = *reinterpret_cast<const float4*>(lp + s9 * 32); raw[2 * s9 + 1] = *reinterpret_cast<const float4*>(lp + s9 * 32 + 4); }
#pragma unroll
                for (int s9 = 0; s9 < 5; ++s9) kf[s9] = __builtin_bit_cast(bf16x8, pack8(raw[2 * s9], raw[2 * s9 + 1], 1.f));
            }
            {
                float4 raw[8];
#pragma unroll
                for (int s9 = 0; s9 < 3; ++s9) { raw[2 * s9] = *reinterpret_cast<const float4*>(lp + (5 + s9) * 32); raw[2 * s9 + 1] = *reinterpret_cast<const float4*>(lp + (5 + s9) * 32 + 4); }
                raw[6] = *reinterpret_cast<const float4*>(rp); raw[7] = *reinterpret_cast<const float4*>(rp + 4);
#pragma unroll
                for (int s9 = 0; s9 < 4; ++s9) kf[5 + s9] = __builtin_bit_cast(bf16x8, pack8(raw[2 * s9], raw[2 * s9 + 1], 1.f));
            }
            f32x4 st = f32x4{0.f, 0.f, 0.f, 0.f};
#pragma unroll
            for (int s9 = 0; s9 < 9; ++s9) st = __builtin_amdgcn_mfma_f32_16x16x32_bf16(kf[s9], *reinterpret_cast<const bf16x8*>(qls + (s9 * 64 + lane) * 16), st, 0, 0, 0);
#pragma unroll
            for (int s9 = 0; s9 < 8; ++s9) *reinterpret_cast<bf16x8*>(vbuf + fr * D_RS + (s9 * 32 + fq * 8) * 2) = kf[s9];
            float mx = fmaxf(fmaxf(st[0], st[1]), fmaxf(st[2], st[3]));
            mx = fmaxf(mx, __shfl_xor(mx, 16));
            mx = fmaxf(mx, __shfl_xor(mx, 32));
            const float mnew = fmaxf(mrun, mx);
            const float corr = __builtin_amdgcn_exp2f(mrun - mnew);
            const float p0 = __builtin_amdgcn_exp2f(st[0] - mnew), p1 = __builtin_amdgcn_exp2f(st[1] - mnew);
            const float p2 = __builtin_amdgcn_exp2f(st[2] - mnew), p3 = __builtin_amdgcn_exp2f(st[3] - mnew);
            float rs = (p0 + p1) + (p2 + p3);
            rs += __shfl_xor(rs, 16);
            rs += __shfl_xor(rs, 32);
            lrun = lrun * corr + rs;
            mrun = mnew;
#pragma unroll
            for (int dt = 0; dt < 16; ++dt) { oacc[dt][0] *= corr; oacc[dt][1] *= corr; oacc[dt][2] *= corr; oacc[dt][3] *= corr; }
            uint4 pk; pk.x = pack_bf16(p0, p1); pk.y = pack_bf16(p2, p3); pk.z = 0u; pk.w = 0u;
            const bf16x8 pf = __builtin_bit_cast(bf16x8, pk);
            const char* tb = vbuf + (fq * 4 + (fr >> 2)) * D_RS + (fr & 3) * 8;
#pragma unroll
            for (int dt = 0; dt < 16; ++dt) {
                const s16x4 lo = __builtin_amdgcn_ds_read_tr16_b64_v4i16((__attribute__((address_space(3))) s16x4*)(tb + dt * 32));
                bf16x8 vf; vf[0] = lo[0]; vf[1] = lo[1]; vf[2] = lo[2]; vf[3] = lo[3]; vf[4] = 0; vf[5] = 0; vf[6] = 0; vf[7] = 0;
                oacc[dt] = __builtin_amdgcn_mfma_f32_16x16x32_bf16(vf, pf, oacc[dt], 0, 0, 0);
            }
        }
        __syncthreads();
        float* wm = reinterpret_cast<float*>(smem + 65536);
        float* wl = wm + 64;
        float* ob = reinterpret_cast<float*>(smem);
        if (fq == 0) { wm[wid * 16 + fr] = mrun; wl[wid * 16 + fr] = lrun; }
        if (fr < 8) {
#pragma unroll
            for (int dt = 0; dt < 16; ++dt) {
                float4 v; v.x = oacc[dt][0]; v.y = oacc[dt][1]; v.z = oacc[dt][2]; v.w = oacc[dt][3];
                *reinterpret_cast<float4*>(ob + ((size_t)wid * 8 + fr) * 256 + dt * 16 + fq * 4) = v;
            }
        }
        __syncthreads();
        {
            float* pp = p.part + ((size_t)bs * D_NCH + ch) * 8 * 258;
#pragma unroll
            for (int h = 0; h < 8; ++h) {
                const float m0 = wm[h], m1 = wm[16 + h], m2 = wm[32 + h], m3 = wm[48 + h];
                const float M = fmaxf(fmaxf(m0, m1), fmaxf(m2, m3));
                const float e0 = __builtin_amdgcn_exp2f(m0 - M), e1 = __builtin_amdgcn_exp2f(m1 - M), e2 = __builtin_amdgcn_exp2f(m2 - M), e3 = __builtin_amdgcn_exp2f(m3 - M);
                const float a = ob[(0 * 8 + h) * 256 + tid] * e0 + ob[(1 * 8 + h) * 256 + tid] * e1 + ob[(2 * 8 + h) * 256 + tid] * e2 + ob[(3 * 8 + h) * 256 + tid] * e3;
                pp[h * 258 + 2 + tid] = a;
                if (tid == 0) { pp[h * 258] = M; pp[h * 258 + 1] = wl[h] * e0 + wl[16 + h] * e1 + wl[32 + h] * e2 + wl[48 + h] * e3; }
            }
        }
        __syncthreads();
    }
}
__device__ __forceinline__ void ph_fp8_tail(const P& p, int layer) {
    const int GX = p.grid;
    const int tid = opaque_v((int)threadIdx.x); const int bid = opaque_s((int)blockIdx.x);
    if (GX > 256) { if (bid >= 128) for (int item = bid - 128; item < 512; item += GX - 128) fp8_unit(p, layer, item, tid); }
    else for (int item = bid; item < 512; item += GX) fp8_unit(p, layer, item, tid);
}
__device__ __forceinline__ void ph_attn_dec(const P& p, int layer, char* smem, unsigned* queue) {
    const int tid = opaque_v((int)threadIdx.x);
    unsigned* qslot = reinterpret_cast<unsigned*>(smem + 76000);
    for (;;) {
        __syncthreads();
        if (tid == 0) *qslot = __hip_atomic_fetch_add(queue, 1u, __ATOMIC_RELAXED, __HIP_MEMORY_SCOPE_AGENT);
        __syncthreads();
        const int o = (int)__builtin_amdgcn_readfirstlane((int)*qslot);
        if (o >= 1536) break;
        const int k3 = o / 3, r3 = o - 3 * k3;
        if (r3 == 0) decode_unit(p, layer, smem, k3, tid);
        else attn_unit(p, smem, 2 * k3 + r3 - 1, tid);
    }
}
__device__ __forceinline__ void ph_decode_comb2(const P& p, int layer, char* smem) {
    const int GX = p.grid;
    const int tid_ = opaque_v((int)threadIdx.x); const int bid_ = opaque_s((int)blockIdx.x);
    float* sw = (float*)smem;
    float* so = sw + 20;
    float* sLp = so + 256;
    VB_LOOP(NS * 8) {
        int bs = vb / 8, h = vb % 8, tid = tid_;
        const float* pb = p.part + (size_t)bs * D_NCH * 8 * 258 + h * 258;
        const float* latn = p.lat + (size_t)(NPT + bs) * KVL;
        if (tid < 64) {
            const float4 q4 = *reinterpret_cast<const float4*>(p.qlat + ((size_t)bs * 8 + h) * 256 + tid * 4);
            const float4 l4 = *reinterpret_cast<const float4*>(latn + tid * 4);
            float sn = q4.x * l4.x + q4.y * l4.y + q4.z * l4.z + q4.w * l4.w;
            if (tid < 32) sn += p.q[(size_t)(NPT + bs) * 768 + h * 96 + 64 + tid] * ATT_SCALE * p.kpe[(size_t)(NPT + bs) * 32 + tid];
            sn = wave_sum(sn) * 1.4426950408889634f;
            float m = sn;
            if (tid < D_NCH) m = fmaxf(m, pb[(size_t)tid * 8 * 258]);
            m = wave_max(m);
            float l = 0.f;
            if (tid < D_NCH) {
                float w = __builtin_amdgcn_exp2f(pb[(size_t)tid * 8 * 258] - m);
                sw[tid] = w;
                l = w * pb[(size_t)tid * 8 * 258 + 1];
            }
            const float wn = __builtin_amdgcn_exp2f(sn - m);
            if (tid == 0) { sw[D_NCH] = wn; l += wn; }
            l = wave_sum(l);
            if (tid == 0) sLp[0] = l;
        }
        __syncthreads();
        float a = sw[D_NCH] * latn[tid];
        for (int c = 0; c < D_NCH; ++c) a += sw[c] * pb[(size_t)c * 8 * 258 + 2 + tid];
        so[tid] = a / sLp[0];
        __syncthreads();
        if (tid < 64) {
            const float* w = p.w_kvb + (size_t)layer * 256 * 1024 + h * 128 + 64 + tid;
            float sacc = 0.f;
            for (int r = 0; r < 256; ++r) sacc += so[r] * w[(size_t)r * 1024];
            p.ob[(size_t)(NPT + bs) * 512 + h * 64 + tid] = f2bf(sacc);
        }
        __syncthreads();
    }
}


struct EpiInProj {
    bf16_t *gab, *zs, *xbr, *cqb, *ckvb; float *dt, *ckv, *kr, *out, *ssq, *sskv;
    const float *b_gate, *dt_bias, *rstd; int layer;
    __device__ __forceinline__ void row4(int m, int n, float a0, float a1, float a2, float a3) const {
        const float rs = rstd[m];
        const float v0 = a0 * rs, v1 = a1 * rs, v2 = a2 * rs, v3 = a3 * rs;
        if (n < 2048) {
            const float4 b4 = *reinterpret_cast<const float4*>(b_gate + layer * 2048 + n);
            *reinterpret_cast<uint2*>(gab + (size_t)m * 2048 + n) = pack4(sigmoid_f(v0 + b4.x), sigmoid_f(v1 + b4.y), sigmoid_f(v2 + b4.z), sigmoid_f(v3 + b4.w));
        } else if (n < 3072) {
            *reinterpret_cast<uint2*>(zs + (size_t)m * DM + (n - 2048)) = pack4(silu_f(v0), silu_f(v1), silu_f(v2), silu_f(v3));
        } else if (n < 4608) {
            const int c = n - 3072;
            *reinterpret_cast<uint2*>(xbr + (size_t)m * CONVD + c) = pack4(v0, v1, v2, v3);
            if (m < NPT) { const int l = m & (SEQ - 1); if (l >= SEQ - 3) *reinterpret_cast<float4*>(out + O_CONVP + ((size_t)(layer * NB + (m >> 11)) * 3 + (l - (SEQ - 3))) * CONVD + c) = make_float4(v0, v1, v2, v3); }
            else if (m < NT) *reinterpret_cast<float4*>(out + O_CONVS + ((size_t)(layer * NS + (m - NPT)) * 3 + 2) * CONVD + c) = make_float4(v0, v1, v2, v3);
        } else if (n < 4624) {
            const float4 b4 = *reinterpret_cast<const float4*>(dt_bias + layer * 16 + (n - 4608));
            const float x0 = v0 + b4.x, x1 = v1 + b4.y, x2 = v2 + b4.z, x3 = v3 + b4.w;
            *reinterpret_cast<float4*>(dt + (size_t)m * 16 + (n - 4608)) = make_float4((x0 > 20.f) ? x0 : log1pf(__expf(x0)), (x1 > 20.f) ? x1 : log1pf(__expf(x1)),
                                                                                       (x2 > 20.f) ? x2 : log1pf(__expf(x2)), (x3 > 20.f) ? x3 : log1pf(__expf(x3)));
        } else if (n < 5008) { *reinterpret_cast<uint2*>(cqb + (size_t)m * QL + (n - 4624)) = pack4(v0, v1, v2, v3); }
        else if (n < 5264) { *reinterpret_cast<float4*>(ckv + (size_t)m * KVL + (n - 5008)) = make_float4(v0, v1, v2, v3);
                             *reinterpret_cast<uint2*>(ckvb + (size_t)m * KVL + (n - 5008)) = pack4(v0, v1, v2, v3); }
        else if (n < 5296) { *reinterpret_cast<float4*>(kr + (size_t)m * 32 + (n - 5264)) = make_float4(v0, v1, v2, v3); }
        const int nb = n & ~63;
        if (nb + 64 > 4624 && nb < 5264) {
            const float s2 = v0 * v0 + v1 * v1 + v2 * v2 + v3 * v3;
            float sq = (n >= 4624 && n < 5008) ? s2 : 0.f, sk = (n >= 5008 && n < 5264) ? s2 : 0.f;
            sq += __shfl_xor(sq, 1); sq += __shfl_xor(sq, 2); sq += __shfl_xor(sq, 4); sq += __shfl_xor(sq, 8);
            sk += __shfl_xor(sk, 1); sk += __shfl_xor(sk, 2); sk += __shfl_xor(sk, 4); sk += __shfl_xor(sk, 8);
            if ((opaque_v((int)threadIdx.x) & 15) == 0) {
                if (nb < 5008) atomicAdd(ssq + m, sq);
                if (nb + 64 > 5008) atomicAdd(sskv + m, sk);
            }
        }
    } EPI_ROWS };
__device__ __forceinline__ void ph_conv2(const P& p, int layer) {
    const int GX = p.grid;
    const int tid_ = opaque_v((int)threadIdx.x); const int bid_ = opaque_s((int)blockIdx.x);
    const int total = NT * (CONVD / 8);
    const float* cw = p.conv_w + (size_t)layer * 4 * CONVD;
    for (int i = bid_ * NTHR + tid_; i < total; i += GX * NTHR) {
        const int t = i / (CONVD / 8), c0 = (i % (CONVD / 8)) * 8;
        float acc[8];
        {
            const float4 b0 = *reinterpret_cast<const float4*>(p.conv_b + layer * CONVD + c0), b1 = *reinterpret_cast<const float4*>(p.conv_b + layer * CONVD + c0 + 4);
            acc[0] = b0.x; acc[1] = b0.y; acc[2] = b0.z; acc[3] = b0.w; acc[4] = b1.x; acc[5] = b1.y; acc[6] = b1.z; acc[7] = b1.w;
        }
#pragma unroll
        for (int k = 0; k < 4; ++k) {
            float xv[8];
            bool have = true;
            if (t < NPT) {
                const int l = t & (SEQ - 1);
                if (l + k - 3 >= 0) {
                    const uint4 r = *reinterpret_cast<const uint4*>(p.xbr + (size_t)(t + k - 3) * CONVD + c0);
                    xv[0] = bflo(r.x); xv[1] = bfhi(r.x); xv[2] = bflo(r.y); xv[3] = bfhi(r.y); xv[4] = bflo(r.z); xv[5] = bfhi(r.z); xv[6] = bflo(r.w); xv[7] = bfhi(r.w);
                } else have = false;
            } else {
                if (k == 3) {
                    const uint4 r = *reinterpret_cast<const uint4*>(p.xbr + (size_t)t * CONVD + c0);
                    xv[0] = bflo(r.x); xv[1] = bfhi(r.x); xv[2] = bflo(r.y); xv[3] = bfhi(r.y); xv[4] = bflo(r.z); xv[5] = bfhi(r.z); xv[6] = bflo(r.w); xv[7] = bfhi(r.w);
                } else {
                    const float* pv = p.state_conv + ((size_t)(layer * NS + (t - NPT)) * 3 + k) * CONVD + c0;
                    const float4 a = *reinterpret_cast<const float4*>(pv), b = *reinterpret_cast<const float4*>(pv + 4);
                    xv[0] = a.x; xv[1] = a.y; xv[2] = a.z; xv[3] = a.w; xv[4] = b.x; xv[5] = b.y; xv[6] = b.z; xv[7] = b.w;
                    if (k >= 1) {
                        float* oc = p.out + O_CONVS + ((size_t)(layer * NS + (t - NPT)) * 3 + (k - 1)) * CONVD + c0;
                        *reinterpret_cast<float4*>(oc) = a; *reinterpret_cast<float4*>(oc + 4) = b;
                    }
                }
            }
            if (have) {
                const float4 w0 = *reinterpret_cast<const float4*>(cw + k * CONVD + c0), w1 = *reinterpret_cast<const float4*>(cw + k * CONVD + c0 + 4);
                acc[0] += xv[0] * w0.x; acc[1] += xv[1] * w0.y; acc[2] += xv[2] * w0.z; acc[3] += xv[3] * w0.w;
                acc[4] += xv[4] * w1.x; acc[5] += xv[5] * w1.y; acc[6] += xv[6] * w1.z; acc[7] += xv[7] * w1.w;
            }
        }
        uint4 o;
        o.x = pack_bf16(silu_f(acc[0]), silu_f(acc[1])); o.y = pack_bf16(silu_f(acc[2]), silu_f(acc[3]));
        o.z = pack_bf16(silu_f(acc[4]), silu_f(acc[5])); o.w = pack_bf16(silu_f(acc[6]), silu_f(acc[7]));
        *reinterpret_cast<uint4*>(p.xbcb + (size_t)t * CONVD + c0) = o;
    }
}

__device__ __forceinline__ void bar_sync(const XcdBarrier& b0) {
    XcdBarrier b = b0;
    unsigned long long bp = (unsigned long long)b.bar; asm volatile("" : "+s"(bp)); b.bar = (unsigned*)bp;
    unsigned bx = b.x; asm volatile("" : "+s"(bx)); b.x = bx;
    xcd_barrier(b);
}
#if PROBE_BAR
#define BAR() do { bar_sync(bar); bar_sync(bar); } while (0)
#else
#define BAR() bar_sync(bar)
#endif
#define NPAD_IN 5376

__global__ void __launch_bounds__(256, 2) k_fwd(P p) {
    __shared__ uint4 xb_words;
    __shared__ __attribute__((aligned(16))) char smem[76800];
    if (threadIdx.x == 0) xb_words = make_uint4(0u, 0u, 0u, 0u);
    __syncthreads();
    XcdBarrier bar = xcd_barrier_post(p.bar, (volatile LAS unsigned*)&xb_words);

#if PROBE_TWICE
#pragma unroll 1
    for (int rep_ = 0; rep_ < 2; ++rep_) {
    if (rep_) { for (int i = blockIdx.x * NTHR + threadIdx.x; i < DEPTH * TP; i += p.grid * NTHR) p.sumsq1[i] = 0.f; BAR(); }
#endif
    ph_rope_table(p);
    ph_copy_x(p);
#pragma unroll 1
    for (int l = 0; l < DEPTH; ++l) {
        ph_convert_w(p.w_in + (size_t)l * DM * DIN, DM, DIN, NPAD_IN, p.wt_in + (size_t)l * NPAD_IN * DM, smem, p.grid, p.norm_mix + l * DM);
        ph_convert_w(p.w_ssm_proj + (size_t)l * DM * DM, DM, DM, DM, p.wt_ssm + (size_t)l * DM * DM, smem, p.grid, p.ssm_norm + l * DM);
        ph_convert_w(p.w_qb + (size_t)l * QL * 768, QL, 768, 768, p.wt_qb + (size_t)l * 768 * QL, smem, p.grid, p.q_norm + l * QL);
        ph_convert_w(p.w_kvb + (size_t)l * KVL * 1024, KVL, 1024, 1024, p.wt_kvb + (size_t)l * 1024 * KVL, smem, p.grid, p.kv_norm + l * KVL);
        ph_convert_w(p.w_mla_proj + (size_t)l * 512 * DM, 512, DM, DM, p.wt_mla + (size_t)l * DM * 512, smem, p.grid);
        ph_convert_w(p.w_out + (size_t)l * DM * DM, DM, DM, DM, p.wt_out + (size_t)l * DM * DM, smem, p.grid);
    }
    ph_convert_plain(p.peer_wq, p.wqb, (size_t)DEPTH * DM * 2048, p.grid);
    ph_convert_plain(p.peer_keys, p.keysb, (size_t)DEPTH * 16 * 128 * 128, p.grid);
#if PROBE_PRO2
#pragma unroll 1
    for (int l = 0; l < DEPTH; ++l) {
        ph_convert_w(p.w_in + (size_t)l * DM * DIN, DM, DIN, NPAD_IN, p.wt_in + (size_t)l * NPAD_IN * DM, smem, p.grid, p.norm_mix + l * DM);
        ph_convert_w(p.w_ssm_proj + (size_t)l * DM * DM, DM, DM, DM, p.wt_ssm + (size_t)l * DM * DM, smem, p.grid);
        ph_convert_w(p.w_qb + (size_t)l * QL * 768, QL, 768, 768, p.wt_qb + (size_t)l * 768 * QL, smem, p.grid);
        ph_convert_w(p.w_kvb + (size_t)l * KVL * 1024, KVL, 1024, 1024, p.wt_kvb + (size_t)l * 1024 * KVL, smem, p.grid);
        ph_convert_w(p.w_mla_proj + (size_t)l * 512 * DM, 512, DM, DM, p.wt_mla + (size_t)l * DM * 512, smem, p.grid);
        ph_convert_w(p.w_out + (size_t)l * DM * DM, DM, DM, DM, p.wt_out + (size_t)l * DM * DM, smem, p.grid);
    }
    ph_convert_plain(p.peer_wq, p.wqb, (size_t)DEPTH * DM * 2048, p.grid);
    ph_copy_x(p);
#endif
    BAR();
#pragma unroll 1
    for (int c = 0; c < DEPTH * 16; ++c) {
        const int l = c >> 4, hh = c & 15;
        gemm_bf16(p.keysb + (size_t)c * 128 * 128, 128, p.wqb + (size_t)l * DM * 2048 + hh * 128, 2048, 1, 8, 128, smem,
                  EpiStoreBfCol{p.wt_pq + (size_t)l * 2048 * DM + (size_t)hh * 128 * DM, DM, p.norm_ffn + l * DM}, p.grid, (c & 7) + (c >> 3) * 64);
    }
#if PROBE_WEFF
#pragma unroll 1
    for (int c = 0; c < DEPTH * 16; ++c) {
        const int l = c >> 4, hh = c & 15;
        gemm_bf16(p.keysb + (size_t)c * 128 * 128, 128, p.wqb + (size_t)l * DM * 2048 + hh * 128, 2048, 1, 8, 128, smem,
                  EpiStoreBfCol{p.wt_pq + (size_t)l * 2048 * DM + (size_t)hh * 128 * DM, DM, p.norm_ffn + l * DM}, p.grid, (c & 7) + (c >> 3) * 64);
    }
#endif
    BAR();
#pragma unroll 1
    for (int l = 0; l < DEPTH; ++l) {
        gemm_bf16(p.xb, DM, p.wt_in + (size_t)l * NPAD_IN * DM, DM, TP / 128, NPAD_IN / 128, DM, smem,
                  EpiInProj{p.gab, p.zs, p.xbr, p.cqb, p.ckvb, p.dt, p.ckv, p.kr, p.out, p.ssq + (size_t)l * TP, p.sskv + (size_t)l * TP, p.b_gate, p.dt_bias, p.rstd, l}, p.grid);
        BAR();
        ph_conv2(p, l);
        ph_lat_kpe(p, l);
        gemm_bf16<true>(p.cqb, QL, p.wt_qb + (size_t)l * 768 * QL, QL, NPT / 128, 768 / 128, QL, smem, EpiQRope{p.qb, p.q, p.rope, p.ssq + (size_t)l * TP}, p.grid, 0, NPT / 128 - 1);
        gemm_bf16<true>(p.ckvb, KVL, p.wt_kvb + (size_t)l * 1024 * KVL, KVL, NPT / 128, 1024 / 128, KVL, smem, EpiKV{p.kn, p.vT, p.sskv + (size_t)l * TP}, p.grid, 0, NPT / 128 - 1);
        BAR();
        ph_ssd_chunk(p, l, smem);
        ph_ssd_seq(p, l);
        ph_qlat(p, l);
        ph_attn_dec(p, l, smem, p.queue + l * 64);
        ph_fp8_tail(p, l);
        BAR();
        ph_decode_comb2(p, l, smem);
        BAR();
        gemm_bf16<true>(p.ygb, DM, p.wt_ssm + (size_t)l * DM * DM, DM, NPT / 128, DM / 128, DM, smem, EpiGateA{p.ya, p.gab, p.ssy + (size_t)l * TP * 2}, p.grid, 0, NPT / 128 - 1, p.ssy + (size_t)l * TP * 2);
        gemm_bf16<true>(p.ob, 512, p.wt_mla + (size_t)l * DM * 512, 512, NPT / 128, DM / 128, 512, smem, EpiGateB{p.ya, p.gab, p.mixb}, p.grid, 0, NPT / 128 - 1);
        BAR();
        gemm_bf16<true>(p.mixb, DM, p.wt_out + (size_t)l * DM * DM, DM, NPT / 128, DM / 128, DM, smem, EpiResidRow{p.xres, p.xb, p.sumsq1 + (size_t)l * TP}, p.grid, 0, NPT / 128 - 1);
        BAR();
        gemm_bf16<true>(p.xb, DM, p.wt_pq + (size_t)l * 2048 * DM, DM, NPT / 128, 2048 / 128, DM, smem, EpiScaleRow{p.sc, 2048, p.sumsq1 + (size_t)l * TP}, p.grid, 0, NPT / 128 - 1);
#if PROBE_GEMM
        gemm_bf16<true>(p.xb, DM, p.wt_pq + (size_t)l * 2048 * DM, DM, NPT / 128, 2048 / 128, DM, smem, EpiScaleRow{p.sc, 2048, p.sumsq1 + (size_t)l * TP}, p.grid, 0, NPT / 128 - 1);
#endif
        BAR();
        ph_peer_topk2(p);
#if PROBE_TOPK
        ph_peer_topk2(p);
#endif
        BAR();
        ph_peer_experts3(p, l, smem);
        BAR();
    }
#if PROBE_TWICE
    }
#endif
}

static inline char* carve_b(char*& cur, size_t bytes) {
    char* r = cur;
    cur += ((bytes + 255) / 256) * 256;
    return r;
}
static inline float* carve(char*& cur, size_t nfloats) { return (float*)carve_b(cur, nfloats * 4); }
static inline bf16_t* carve_h(char*& cur, size_t n) { return (bf16_t*)carve_b(cur, n * 2); }

extern "C" void kernel_launch(void* const* d_in, const int* in_sizes, int n_in,
                              void* d_out, int out_size, void* d_ws, size_t ws_size,
                              hipStream_t stream) {
    P p{};
    p.x_prompt = (const float*)d_in[0]; p.x_sample = (const float*)d_in[1];
    p.cache_lat = (const float*)d_in[2]; p.cache_kr = (const float*)d_in[3];
    p.state_ssm = (const float*)d_in[4]; p.state_conv = (const float*)d_in[5];
    p.page_table = (const int*)d_in[6];
    p.norm_mix = (const float*)d_in[7]; p.w_in = (const float*)d_in[8]; p.b_gate = (const float*)d_in[9];
    p.conv_w = (const float*)d_in[10]; p.conv_b = (const float*)d_in[11]; p.dt_bias = (const float*)d_in[12];
    p.a_log = (const float*)d_in[13]; p.d_skip = (const float*)d_in[14]; p.ssm_norm = (const float*)d_in[15];
    p.w_ssm_proj = (const float*)d_in[16]; p.q_norm = (const float*)d_in[17]; p.w_qb = (const float*)d_in[18];
    p.kv_norm = (const float*)d_in[19]; p.w_kvb = (const float*)d_in[20]; p.w_mla_proj = (const float*)d_in[21];
    p.w_out = (const float*)d_in[22]; p.norm_ffn = (const float*)d_in[23]; p.peer_wq = (const float*)d_in[24];
    p.peer_keys = (const float*)d_in[25]; p.peer_u = (const float*)d_in[26]; p.peer_v = (const float*)d_in[27];
    p.norm_final = (const float*)d_in[28];
    p.out = (float*)d_out;
    char* cur = (char*)d_ws;
    p.bar = (unsigned*)carve(cur, XCD_BAR_WORDS);
    p.sumsq1 = carve(cur, (size_t)DEPTH * TP);
    p.queue = (unsigned*)carve(cur, 4 * DEPTH * 64);
    p.ssq = carve(cur, (size_t)DEPTH * TP);
    p.sskv = carve(cur, (size_t)DEPTH * TP);
    p.ssy = carve(cur, (size_t)DEPTH * TP * 2);
    char* zero_begin = (char*)d_ws;
    char* zero_end = cur;
    p.xres = carve(cur, (size_t)TP * DM);
    p.cq = carve(cur, (size_t)TP * QL);
    p.ckv = carve(cur, (size_t)TP * KVL);
    p.kr = carve(cur, (size_t)TP * 32);
    p.dt = carve(cur, (size_t)TP * 16);
    p.yraw = carve(cur, (size_t)TP * DM);
    p.ya = carve(cur, (size_t)TP * DM);
    p.q = carve(cur, (size_t)TP * 768);
    p.lat = carve(cur, (size_t)TP * KVL);
    p.kpe = carve(cur, (size_t)TP * 32);
    p.sc = carve(cur, (size_t)TP * 2048);
    p.gate = carve(cur, (size_t)TP * 128);
    p.part = carve(cur, (size_t)NS * 129 * 8 * 258);
    p.qlat = carve(cur, (size_t)NS * 8 * 256);
    p.rope = carve(cur, (size_t)2 * 2049 * 16);
    p.idx = (int*)carve(cur, (size_t)TP * 128);
    p.xb = carve_h(cur, (size_t)TP * DM);
    p.rstd = carve(cur, (size_t)TP);
    p.ynb = carve_h(cur, (size_t)TP * DM);
    p.qnb = carve_h(cur, (size_t)TP * QL);
    p.latb = carve_h(cur, (size_t)TP * KVL);
    p.ob = carve_h(cur, (size_t)TP * 512);
    p.mixb = carve_h(cur, (size_t)TP * DM);
    p.qb = carve_h(cur, (size_t)TP * 768);
    p.kn = carve_h(cur, (size_t)TP * 512);
    p.kpeb = carve_h(cur, (size_t)TP * 32);
    p.vT = carve_h(cur, (size_t)NB * 8 * 64 * SEQ);
    p.xbcb = carve_h(cur, (size_t)TP * CONVD);
    p.xbr = carve_h(cur, (size_t)TP * CONVD);
    p.cqb = carve_h(cur, (size_t)TP * QL);
    p.ckvb = carve_h(cur, (size_t)TP * KVL);
    p.ygb = carve_h(cur, (size_t)TP * DM);
    p.gab = carve_h(cur, (size_t)TP * 2048);
    p.zs = carve_h(cur, (size_t)TP * DM);
    p.wt_in = carve_h(cur, (size_t)DEPTH * NPAD_IN * DM);
    p.wt_ssm = carve_h(cur, (size_t)DEPTH * DM * DM);
    p.wt_qb = carve_h(cur, (size_t)DEPTH * 768 * QL);
    p.wt_kvb = carve_h(cur, (size_t)DEPTH * 1024 * KVL);
    p.wt_mla = carve_h(cur, (size_t)DEPTH * DM * 512);
    p.wt_out = carve_h(cur, (size_t)DEPTH * DM * DM);
    p.wt_pq = carve_h(cur, (size_t)DEPTH * 2048 * DM);
    p.wqb = carve_h(cur, (size_t)DEPTH * DM * 2048);
    p.keysb = carve_h(cur, (size_t)DEPTH * 16 * 128 * 128);
    p.u8 = (unsigned char*)carve_b(cur, (size_t)DEPTH * NEXP * DM);
    p.v8 = (unsigned char*)carve_b(cur, (size_t)DEPTH * NEXP * DM);
    p.uinv = carve(cur, (size_t)DEPTH * NEXP);
    p.vinv = carve(cur, (size_t)DEPTH * NEXP);

    (void)hipMemsetAsync(zero_begin, 0, (size_t)(zero_end - zero_begin), stream);

    static int grid = 0;
    if (!grid) {
        int dev = 0, cus = 0, per_cu = 0;
        (void)hipGetDevice(&dev);
        (void)hipDeviceGetAttribute(&cus, hipDeviceAttributeMultiprocessorCount, dev);
        (void)hipOccupancyMaxActiveBlocksPerMultiprocessor(&per_cu, k_fwd, 256, 0);
        if (per_cu > 2) per_cu = 2;
        if (per_cu < 1) per_cu = 1;
        grid = cus * per_cu;
    }
    p.grid = grid;
    k_fwd<<<grid, 256, 0, stream>>>(p);
}
```
